# Optimizing an MI355X kernel written in HIP

```python
import jax, jax.numpy as jnp
from jax import lax
import numpy as np

D_MODEL = 2048
BATCH = 8
SEQ = 4096
DEPTH = 1

MEM_TOKENS = 256

ML_HEADS = 6
ML_DQK = 128
ML_DV = 256
ML_CONV = 4
ML_CHUNK = 64
RET_HEADS = 6
RET_DQK = 128
RET_DV = 256
RET_CHUNK = 64
XA_HEADS = 4
XA_DH = 256

ROPE_BASE = 10000.0
EPS = 1e-6
N_BRANCH = 3

ML_QK = ML_HEADS * ML_DQK
ML_V = ML_HEADS * ML_DV
RET_QK = RET_HEADS * RET_DQK
RET_V = RET_HEADS * RET_DV
XA_W = XA_HEADS * XA_DH

IN_SIZES = (ML_QK, ML_QK, ML_V, ML_V, ML_V, ML_HEADS, ML_HEADS,
            RET_QK, RET_QK, RET_V, RET_V, XA_W, XA_W, N_BRANCH * D_MODEL)
N_IN = sum(IN_SIZES)

kernel_name = "hybrid_mlstm_retention_memxattn_gated"


def rmsnorm(x, g):
    xf = x.astype(jnp.float32)
    y = xf * lax.rsqrt(jnp.mean(xf * xf, axis=-1, keepdims=True) + EPS)
    return (y * g.astype(jnp.float32)).astype(x.dtype)


def head_layernorm(t, g):
    B, S, H, D = t.shape
    tf = t.astype(jnp.float32)
    mu = jnp.mean(tf, axis=-1, keepdims=True)
    var = jnp.mean(jnp.square(tf - mu), axis=-1, keepdims=True)
    y = ((tf - mu) * lax.rsqrt(var + EPS)).reshape(B, S, H * D)
    return y * g.astype(jnp.float32)


def split_heads(t, n_heads):
    B, S, W = t.shape
    return t.reshape(B, S, n_heads, W // n_heads)


def rope(t, positions):
    half = t.shape[-1] // 2
    freqs = ROPE_BASE ** (-jnp.arange(half, dtype=jnp.float32) / half)
    ang = positions.astype(jnp.float32)[..., None] * freqs
    cos = jnp.cos(ang)[:, :, None, :]
    sin = jnp.sin(ang)[:, :, None, :]
    tf = t.astype(jnp.float32)
    t1, t2 = tf[..., :half], tf[..., half:]
    return jnp.concatenate([t1 * cos - t2 * sin, t1 * sin + t2 * cos], axis=-1)


def causal_dwconv(u, w, b):
    K = w.shape[0]
    S = u.shape[1]
    up = jnp.pad(u, ((0, 0), (K - 1, 0), (0, 0)))
    y = b
    for k in range(K):
        y = y + up[:, k:k + S] * w[k]
    return y


def to_chunks(t, L):
    B, S, H, D = t.shape
    return t.reshape(B, S // L, L, H, D).transpose(1, 0, 3, 2, 4)


def from_chunks(t):
    NC, B, H, L, D = t.shape
    return t.transpose(1, 0, 3, 2, 4).reshape(B, NC * L, H, D)


def mlstm_chunkwise(q, k, v, i_pre, f_pre):
    B, S, H, Dk = q.shape
    Dv = v.shape[-1]
    L = ML_CHUNK
    NC = S // L
    qc = to_chunks(q.astype(jnp.float32) * (Dk ** -0.5), L)
    kc = to_chunks(k.astype(jnp.float32), L)
    vc = to_chunks(v.astype(jnp.float32), L)
    ic = i_pre.astype(jnp.float32).reshape(B, NC, L, H).transpose(1, 0, 3, 2)
    lfc = jax.nn.log_sigmoid(f_pre.astype(jnp.float32)).reshape(B, NC, L, H).transpose(1, 0, 3, 2)
    causal = jnp.tril(jnp.ones((L, L), dtype=bool))

    def step(carry, xs):
        C, n, m = carry
        qb, kb, vb, ib, lfb = xs
        b = jnp.cumsum(lfb, axis=-1)
        g = b[..., -1]
        log_d = jnp.where(causal, b[..., :, None] - b[..., None, :] + ib[..., None, :], -jnp.inf)
        log_inter = b + m[..., None]
        m_row = jnp.maximum(log_inter, jnp.max(log_d, axis=-1))
        d = jnp.exp(log_d - m_row[..., None])
        s = jnp.einsum('bhld,bhsd->bhls', qb, kb) * d
        inter = jnp.exp(log_inter - m_row)
        num = jnp.einsum('bhls,bhsv->bhlv', s, vb) + inter[..., None] * jnp.einsum('bhld,bhdv->bhlv', qb, C)
        den = jnp.sum(s, axis=-1) + inter * jnp.einsum('bhld,bhd->bhl', qb, n)
        den = jnp.maximum(jnp.abs(den), jnp.exp(-m_row))
        h = num / den[..., None]
        log_w = g[..., None] - b + ib
        m_new = jnp.maximum(g + m, jnp.max(log_w, axis=-1))
        w = jnp.exp(log_w - m_new[..., None])
        decay = jnp.exp(g + m - m_new)
        kw = kb * w[..., None]
        C_new = decay[..., None, None] * C + jnp.einsum('bhsd,bhsv->bhdv', kw, vb)
        n_new = decay[..., None] * n + jnp.sum(kw, axis=2)
        return (C_new, n_new, m_new), h

    init = (jnp.zeros((B, H, Dk, Dv), jnp.float32),
            jnp.zeros((B, H, Dk), jnp.float32),
            jnp.zeros((B, H), jnp.float32))
    _, hc = lax.scan(step, init, (qc, kc, vc, ic, lfc))
    return from_chunks(hc)


def retention_chunkwise(q, k, v):
    B, S, H, Dk = q.shape
    Dv = v.shape[-1]
    L = RET_CHUNK
    log_gamma = jnp.asarray(np.log(1.0 - 2.0 ** (-5.0 - np.arange(H))), dtype=jnp.float32)
    pos = jnp.arange(L, dtype=jnp.float32)
    causal = jnp.tril(jnp.ones((L, L), dtype=bool))
    intra = jnp.where(causal, jnp.exp((pos[:, None] - pos[None, :]) * log_gamma[:, None, None]), 0.0)
    q_decay = jnp.exp((pos + 1.0) * log_gamma[:, None])
    k_decay = jnp.exp((L - 1.0 - pos) * log_gamma[:, None])
    chunk_decay = jnp.exp(L * log_gamma)
    qc = to_chunks(q.astype(jnp.float32), L)
    kc = to_chunks(k.astype(jnp.float32) * (Dk ** -0.5), L)
    vc = to_chunks(v.astype(jnp.float32), L)

    def step(R, xs):
        qb, kb, vb = xs
        s = jnp.einsum('bhld,bhsd->bhls', qb, kb) * intra
        o = jnp.einsum('bhls,bhsv->bhlv', s, vb) + q_decay[..., None] * jnp.einsum('bhld,bhdv->bhlv', qb, R)
        R_new = chunk_decay[:, None, None] * R + jnp.einsum('bhsd,bhsv->bhdv', kb * k_decay[..., None], vb)
        return R_new, o

    _, oc = lax.scan(step, jnp.zeros((B, H, Dk, Dv), jnp.float32), (qc, kc, vc))
    return from_chunks(oc)


def memory_cross_attention(q, mk, mv):
    B, S, H, D = q.shape
    scores = jnp.einsum('bshd,bmhd->bhsm', q.astype(jnp.float32), mk.astype(jnp.float32)) * (D ** -0.5)
    p = jax.nn.softmax(scores, axis=-1)
    o = jnp.einsum('bhsm,bmhd->bshd', p, mv.astype(jnp.float32))
    return o.reshape(B, S, H * D)


def setup_inputs(seed: int = 0) -> dict:
    key = jax.random.key(seed)
    ks = jax.random.split(key, 17)
    f32 = jnp.float32

    def nrm(k, shape, scale):
        return jax.random.normal(k, shape, f32) * scale

    x = nrm(ks[0], (BATCH, SEQ, D_MODEL), 1.0)
    mem = nrm(ks[1], (BATCH, MEM_TOKENS, D_MODEL), 1.0)
    positions = jnp.broadcast_to(jnp.arange(SEQ, dtype=jnp.int32), (BATCH, SEQ))
    ln_g = 1.0 + nrm(ks[2], (DEPTH, D_MODEL), 0.02)
    mem_ln_g = 1.0 + nrm(ks[3], (DEPTH, D_MODEL), 0.02)
    w_in = nrm(ks[4], (DEPTH, D_MODEL, N_IN), D_MODEL ** -0.5)
    f_off = sum(IN_SIZES[:6])
    b_in = nrm(ks[5], (DEPTH, N_IN), 0.01)
    b_in = b_in.at[:, f_off:f_off + ML_HEADS].add(jnp.linspace(3.0, 6.0, ML_HEADS, dtype=f32))
    conv_w = nrm(ks[6], (DEPTH, ML_CONV, 2 * ML_QK), ML_CONV ** -0.5)
    conv_b = nrm(ks[7], (DEPTH, 2 * ML_QK), 0.01)
    ml_hnorm_g = 1.0 + nrm(ks[8], (DEPTH, ML_V), 0.02)
    ret_hnorm_g = 1.0 + nrm(ks[9], (DEPTH, RET_V), 0.02)
    w_mem_kv = nrm(ks[10], (DEPTH, D_MODEL, 2 * XA_W), D_MODEL ** -0.5)
    w_br_ml = nrm(ks[11], (DEPTH, ML_V, D_MODEL), ML_V ** -0.5)
    w_br_ret = nrm(ks[12], (DEPTH, RET_V, D_MODEL), RET_V ** -0.5)
    w_br_xa = nrm(ks[13], (DEPTH, XA_W, D_MODEL), XA_W ** -0.5)
    w_out = nrm(ks[14], (DEPTH, D_MODEL, D_MODEL), D_MODEL ** -0.5)
    final_g = 1.0 + nrm(ks[15], (D_MODEL,), 0.02)
    return {"x": x, "mem": mem, "positions": positions, "ln_g": ln_g, "mem_ln_g": mem_ln_g,
            "w_in": w_in, "b_in": b_in, "conv_w": conv_w, "conv_b": conv_b,
            "ml_hnorm_g": ml_hnorm_g, "ret_hnorm_g": ret_hnorm_g, "w_mem_kv": w_mem_kv,
            "w_br_ml": w_br_ml, "w_br_ret": w_br_ret, "w_br_xa": w_br_xa, "w_out": w_out,
            "final_g": final_g}


def reference(x, mem, positions, ln_g, mem_ln_g, w_in, b_in, conv_w, conv_b, ml_hnorm_g,
              ret_hnorm_g, w_mem_kv, w_br_ml, w_br_ret, w_br_xa, w_out, final_g):
    B, S, _ = x.shape
    split_at = np.cumsum(IN_SIZES)[:-1].tolist()
    for layer in range(DEPTH):
        h = rmsnorm(x, ln_g[layer])
        proj = h @ w_in[layer] + b_in[layer]
        (ml_q, ml_k, ml_v, ml_o, ml_z, ml_i, ml_f,
         rt_q, rt_k, rt_v, rt_z, xa_q, xa_z, gate_pre) = jnp.split(proj, split_at, axis=-1)

        qk = jax.nn.silu(causal_dwconv(jnp.concatenate([ml_q, ml_k], axis=-1), conv_w[layer], conv_b[layer]))
        ml_qc, ml_kc = jnp.split(qk, 2, axis=-1)
        ml_h = mlstm_chunkwise(split_heads(ml_qc, ML_HEADS), split_heads(ml_kc, ML_HEADS),
                               split_heads(ml_v, ML_HEADS), ml_i, ml_f)
        ml_out = (head_layernorm(ml_h, ml_hnorm_g[layer]) * jax.nn.sigmoid(ml_o.astype(jnp.float32))
                  * jax.nn.silu(ml_z.astype(jnp.float32))).astype(x.dtype)

        rq = rope(split_heads(rt_q, RET_HEADS), positions)
        rk = rope(split_heads(rt_k, RET_HEADS), positions)
        rt_h = retention_chunkwise(rq, rk, split_heads(rt_v, RET_HEADS))
        rt_out = (head_layernorm(rt_h, ret_hnorm_g[layer])
                  * jax.nn.silu(rt_z.astype(jnp.float32))).astype(x.dtype)

        mn = rmsnorm(mem, mem_ln_g[layer])
        mk, mv = jnp.split(mn @ w_mem_kv[layer], 2, axis=-1)
        xa_h = memory_cross_attention(split_heads(xa_q, XA_HEADS), split_heads(mk, XA_HEADS),
                                      split_heads(mv, XA_HEADS))
        xa_out = (xa_h * jax.nn.silu(xa_z.astype(jnp.float32))).astype(x.dtype)

        gates = jax.nn.sigmoid(gate_pre).reshape(B, S, N_BRANCH, D_MODEL)
        merged = (gates[:, :, 0] * (ml_out @ w_br_ml[layer])
                  + gates[:, :, 1] * (rt_out @ w_br_ret[layer])
                  + gates[:, :, 2] * (xa_out @ w_br_xa[layer]))
        x = x + merged @ w_out[layer]
    return rmsnorm(x, final_g)
```

```cpp
#include <hip/hip_runtime.h>
#include <hip/hip_cooperative_groups.h>
#include <cstdint>
#include <cstdio>
namespace cg = cooperative_groups;

#define LAS __attribute__((address_space(3)))
typedef unsigned short bf16_t;
typedef short bf16x8 __attribute__((ext_vector_type(8)));
typedef short s16x4 __attribute__((ext_vector_type(4)));
typedef float f32x4 __attribute__((ext_vector_type(4)));
typedef float f32x2 __attribute__((ext_vector_type(2)));
typedef unsigned u32x4 __attribute__((ext_vector_type(4)));
typedef unsigned u32x2 __attribute__((ext_vector_type(2)));
typedef int i32x4 __attribute__((ext_vector_type(4)));
typedef int i32x8 __attribute__((ext_vector_type(8)));
#define DI __device__ __forceinline__

constexpr int T = 32768, DM = 2048, SEQ = 4096, NB = 8;
constexpr int N_IN = 18956, NPAD = 19200;
constexpr int NT_P1 = 51;
constexpr int PN_GATE = 51;
constexpr int PN_KV = 75;
constexpr float EPS = 1e-6f;
constexpr int LDS_BYTES = 156 * 1024;

constexpr size_t WS_CTL = 0;
constexpr size_t WS_BAR = 4096;
constexpr size_t WS_SS = WS_BAR + 16384;
constexpr size_t WS_BIAS = WS_SS + (size_t)T * 4;
constexpr size_t WS_IF = WS_BIAS + 81920;
constexpr size_t WS_GS = WS_IF + (size_t)T * 16 * 4;
constexpr size_t GS_ARR = (size_t)48 * 4096;
constexpr size_t WS_GDEC = WS_GS + 5 * GS_ARR * 4;
constexpr size_t WS_RV = WS_GDEC + 48 * 64 * 4;
constexpr size_t WS_WIN = WS_RV + 16384;
constexpr size_t WS_WKV = WS_WIN + (size_t)NPAD * DM * 2;
constexpr size_t WS_WML = WS_WKV + (size_t)2048 * 2048 * 2;
constexpr size_t WS_WRET = WS_WML + (size_t)2048 * 1536 * 2;
constexpr size_t WS_WXA = WS_WRET + (size_t)2048 * 1536 * 2;
constexpr size_t WS_WOUT = WS_WXA + (size_t)2048 * 1024 * 2;
constexpr size_t WS_MKV = WS_WOUT + (size_t)2048 * 2048 * 2;
constexpr size_t WS_BIG = WS_MKV + (size_t)2048 * 2048 * 2;
constexpr size_t SZ15 = (size_t)T * 1536 * 2, SZ10 = (size_t)T * 1024 * 2;
constexpr size_t SZ20 = (size_t)T * 2048 * 2;
constexpr size_t WS_V1 = WS_BIG, WS_QK2 = WS_V1 + SZ15, WS_V2 = WS_QK2 + SZ15;
constexpr size_t WS_O1 = WS_V2 + SZ15, WS_Q3 = WS_O1 + SZ15;
constexpr size_t WS_Z1 = WS_Q3 + SZ10, WS_Z2 = WS_Z1 + SZ15, WS_Z3 = WS_Z2 + SZ15;
constexpr size_t WS_QK1 = WS_Z3 + SZ10;
constexpr size_t WS_H8 = WS_QK1 + SZ20;
constexpr size_t WS_END = WS_H8 + (size_t)T * DM;
constexpr size_t WS_G0 = WS_QK1, WS_G12 = WS_V1, WS_MERGED = WS_O1;
static_assert(2 * SZ20 <= 3 * SZ15 && SZ20 <= SZ15 + SZ10, "overlays");
constexpr size_t DO_H = 0, DO_MN = (size_t)T * DM * 2, DO_QKC = DO_MN + (size_t)2048 * 2048 * 2;
constexpr size_t DO_WG8 = DO_QKC + (size_t)T * 1536 * 2;
constexpr size_t DO_WO8 = DO_WG8 + (size_t)6144 * 2048;
constexpr size_t DO_WX8 = DO_WO8 + (size_t)3584 * 2048;
static_assert(DO_WX8 + (size_t)2048 * 1024 <= (size_t)T * DM * 4, "d_out scratch");
constexpr size_t DO_XA8 = DO_H;

struct Params {
    const float* x; const float* mem; const int* pos; const float* ln_g; const float* mem_ln_g; const float* w_in; const float* b_in;
    const float* conv_w; const float* conv_b; const float* ml_g; const float* ret_g; const float* w_kv; const float* w_ml; const float* w_ret;
    const float* w_xa; const float* w_out; const float* fin_g; float* out; unsigned char* ws;
};

typedef __bf16 bf16v2_t __attribute__((ext_vector_type(2)));
DI unsigned cvt_pk_bf16(float lo, float hi) { const f32x2 v = {lo, hi}; const bf16v2_t r = __builtin_convertvector(v, bf16v2_t); return __builtin_bit_cast(unsigned, r); }
DI float bf2f(unsigned short b) { return __uint_as_float((unsigned)b << 16); }
DI float bflo(unsigned u) { return __uint_as_float(u << 16); }
DI float bfhi(unsigned u) { return __uint_as_float(u & 0xffff0000u); }
DI float sigmoidf_(float v) { return __builtin_amdgcn_rcpf(1.0f + __builtin_amdgcn_exp2f(-1.4426950408889634f * v)); }
DI float siluf_(float v) { return v * __builtin_amdgcn_rcpf(1.0f + __builtin_amdgcn_exp2f(-1.4426950408889634f * v)); }
#define LBAR() do { asm volatile("s_waitcnt lgkmcnt(0)" ::: "memory"); __builtin_amdgcn_s_barrier(); asm volatile("" ::: "memory"); } while (0)
DI float wave_sum(float v) { for (int o = 32; o > 0; o >>= 1) v += __shfl_xor(v, o); return v; }
DI s16x4 tr_read(unsigned lds_addr) { s16x4 r; asm volatile("ds_read_b64_tr_b16 %0, %1\n\ts_waitcnt lgkmcnt(0)" : "=&v"(r) : "v"(lds_addr) : "memory"); return r; }
DI void tr_read8(s16x4 (&o)[8], unsigned a0, unsigned a1, unsigned a2, unsigned a3, unsigned a4, unsigned a5, unsigned a6, unsigned a7) {
    asm volatile("ds_read_b64_tr_b16 %0, %8\n\tds_read_b64_tr_b16 %1, %9\n\tds_read_b64_tr_b16 %2, %10\n\tds_read_b64_tr_b16 %3, %11\n\tds_read_b64_tr_b16 %4, %12\n\tds_read_b64_tr_b16 %5, %13\n\tds_read_b64_tr_b16 %6, %14\n\tds_read_b64_tr_b16 %7, %15\n\ts_waitcnt lgkmcnt(0)"
                 : "=&v"(o[0]), "=&v"(o[1]), "=&v"(o[2]), "=&v"(o[3]), "=&v"(o[4]), "=&v"(o[5]), "=&v"(o[6]), "=&v"(o[7])
                 : "v"(a0), "v"(a1), "v"(a2), "v"(a3), "v"(a4), "v"(a5), "v"(a6), "v"(a7) : "memory");
}
DI int opaque_tid() { int t = threadIdx.x; asm volatile("" : "+v"(t)); return t; }
#define MFMA16(a, b, c) __builtin_amdgcn_mfma_f32_16x16x32_bf16((a), (b), (c), 0, 0, 0)

namespace pg8 {
constexpr int BM = 256, BK = 64, HALF = 128, HTB = HALF * BK * 2, STAGE_BYTES = 8 * HTB, NXCD = 8, WGM = 8;
DI int lds_byte(int r, int c) { const int st = (r >> 4) * 2 + (c >> 5), rr = r & 15, cc = c & 31, ob = rr * 64 + cc * 2; return st * 1024 + (ob ^ (((ob >> 9) & 1) << 5)); }
DI void stage_rc(int b, int& R, int& C) { const int st = b / 1024, sb = b % 1024, swz = sb ^ (((sb >> 9) & 1) << 5); R = (st >> 1) * 16 + swz / 64; C = (st & 1) * 32 + (swz % 64) / 2; }
DI int perm32(int rho) { const int n = rho >> 4, i = rho & 15; return 8 * (i >> 2) + 4 * n + (i & 3); }
struct Unit { int pm, pn; };
struct Gemm { const bf16_t* A; const bf16_t* Bt; int K; int ntile = 0; int sca = 0x7F7F7F7F; };
struct Order {
    int nM, nN, nwg, G, c, pn_off, extra, pm0x, pn0x, skip_lo, skip_n, skip2_lo, skip2_n;
    DI void init(int nM_, int nN_, int G_, int c_, int pn_off_, int extra_ = 0, int pm0x_ = 0, int pn0x_ = 0) { nM = nM_; nN = nN_; nwg = nM * nN; G = G_; c = c_; pn_off = pn_off_; extra = extra_; pm0x = pm0x_; pn0x = pn0x_; skip_lo = 0; skip_n = 0; skip2_lo = 0; skip2_n = 0; }
    DI bool next(int i, Unit& u) const {
        long L = (long)i * G + c;
        if (L < nwg) {
            int wgid = (int)L; { const int q = nwg / NXCD, r = nwg % NXCD, xcd = wgid % NXCD, off = wgid / NXCD; wgid = (xcd < r ? xcd * (q + 1) : r * (q + 1) + (xcd - r) * q) + off; }
            const int nig = WGM * nN, gid = wgid / nig, fm = gid * WGM, gsz = (nM - fm) < WGM ? (nM - fm) : WGM;
            u.pm = fm + ((wgid % nig) % gsz); u.pn = pn_off + (wgid % nig) / gsz; if (skip_n && u.pn >= skip_lo) u.pn += skip_n; if (skip2_n && u.pn >= skip2_lo) u.pn += skip2_n; return true;
        }
        L -= nwg; if (L >= extra) return false;
        u.pm = pm0x + (int)(L >> 3); u.pn = pn0x + (int)(L & 7); return true;
    }
};

template <bool FP8 = false, class Epi>
DI void gemm_phase(LAS unsigned char* lds, const Gemm g, const Order& S, const Epi& E) {
    const int tid = opaque_tid(), wid = __builtin_amdgcn_readfirstlane(tid >> 6), lane = tid & 63, wr = wid >> 2, wc = wid & 3, fr = lane & 15, fq = lane >> 4;
    const int K = g.K, nt = g.ntile ? g.ntile : K / BK;
    unsigned voffA[2], voffB[2];
#pragma unroll
    for (int i = 0; i < 2; ++i) { int R, C; stage_rc(tid * 16 + i * 8192, R, C); const int Rb = (R & ~31) + perm32(R & 31);
        voffA[i] = (unsigned)(R * K + C) * 2u; voffB[i] = (unsigned)(Rb * K + C) * 2u; }
    const size_t kstep = (size_t)(BK * 2);
    const size_t hstep = (size_t)HALF * K * 2;
    const size_t tstep = 2 * hstep;
    const unsigned ldsw = (unsigned)wid * 1024u;
    const int aoff = lds_byte(wr * 64 + fr, fq * 8), boff = lds_byte(wc * 32 + fr, fq * 8);
#define PG8_SA(b, h) (((b) * 2 + (h)) * HTB)
#define PG8_SB(b, h) ((4 + (b) * 2 + (h)) * HTB)
#define PG8_STAGE(bufoff, gbase, voff) do { _Pragma("unroll") for (int _i = 0; _i < 2; ++_i) \
        __builtin_amdgcn_global_load_lds((const unsigned*)((const char*)(gbase) + (voff)[_i]), (LAS unsigned*)(lds + (bufoff) + ldsw + _i * 8192), 16, 0, 0); } while (0)
#define PG8_LD16(off) (*(const LAS i32x4*)(lds + (off)))
#define PG8_LDA(dst, b, h) do { if constexpr (FP8) { _Pragma("unroll") for (int m = 0; m < 4; ++m) dst##8[m] = __builtin_shufflevector(PG8_LD16(PG8_SA(b, h) + aoff + m * 2048), PG8_LD16(PG8_SA(b, h) + aoff + m * 2048 + 1024), 0, 1, 2, 3, 4, 5, 6, 7); } \
        else { _Pragma("unroll") for (int m = 0; m < 4; ++m) _Pragma("unroll") for (int k = 0; k < 2; ++k) dst[m][k] = *(const LAS bf16x8*)(lds + PG8_SA(b, h) + aoff + m * 2048 + k * 1024); } } while (0)
#define PG8_LDB(dst, b, h) do { if constexpr (FP8) { _Pragma("unroll") for (int n = 0; n < 2; ++n) dst##8[n] = __builtin_shufflevector(PG8_LD16(PG8_SB(b, h) + boff + n * 2048), PG8_LD16(PG8_SB(b, h) + boff + n * 2048 + 1024), 0, 1, 2, 3, 4, 5, 6, 7); } \
        else { _Pragma("unroll") for (int n = 0; n < 2; ++n) _Pragma("unroll") for (int k = 0; k < 2; ++k) dst[n][k] = *(const LAS bf16x8*)(lds + PG8_SB(b, h) + boff + n * 2048 + k * 1024); } } while (0)
#define PG8_MMA(ai, bj, At, Bt) do { __builtin_amdgcn_s_setprio(1); \
        if constexpr (FP8) { _Pragma("unroll") for (int m = 0; m < 4; ++m) _Pragma("unroll") for (int n = 0; n < 2; ++n) \
            asm volatile("v_mfma_scale_f32_16x16x128_f8f6f4 %0, %1, %2, %0, %3, %4 op_sel_hi:[0,0,0]" : "+v"(acc[ai][bj][m][n]) : "v"(Bt##8[n]), "v"(At##8[m]), "v"(sc_w), "v"(sc_1)); } \
        else { _Pragma("unroll") for (int m = 0; m < 4; ++m) _Pragma("unroll") for (int n = 0; n < 2; ++n) _Pragma("unroll") for (int k = 0; k < 2; ++k) \
            acc[ai][bj][m][n] = __builtin_amdgcn_mfma_f32_16x16x32_bf16(Bt[n][k], At[m][k], acc[ai][bj][m][n], 0, 0, 0); } \
        __builtin_amdgcn_s_setprio(0); } while (0)
#define PG8_WAIT_V(n) asm volatile("s_waitcnt vmcnt(" #n ")" ::: "memory")
#define PG8_WAIT_L(n) asm volatile("s_waitcnt lgkmcnt(" #n ")" ::: "memory")
#define PG8_BAR __builtin_amdgcn_s_barrier()
#define PG8_SCHED __builtin_amdgcn_sched_barrier(0)
    Unit cur, nxt; int ui = 0;
    if (!S.next(0, cur)) return;
    f32x4 acc[2][2][4][2];
#pragma unroll
    for (int a = 0; a < 2; ++a)
#pragma unroll
        for (int b = 0; b < 2; ++b)
#pragma unroll
            for (int m = 0; m < 4; ++m)
#pragma unroll
                for (int n = 0; n < 2; ++n) acc[a][b][m][n] = (f32x4){0.f, 0.f, 0.f, 0.f};
    bf16x8 At[4][2], B0[2][2], B1[2][2];
    const int sc_w = 0x79797979, sc_1 = g.sca;
    i32x8 At8[4], B08[2], B18[2];
    const char* cA = (const char*)g.A + (size_t)cur.pm * tstep; const char* cB = (const char*)g.Bt + (size_t)cur.pn * tstep;
    PG8_STAGE(PG8_SB(0, 0), cB, voffB); PG8_STAGE(PG8_SB(0, 1), cB + hstep, voffB); PG8_STAGE(PG8_SA(0, 0), cA, voffA); PG8_STAGE(PG8_SA(0, 1), cA + hstep, voffA);
    if (wr == 1) PG8_BAR;
    PG8_WAIT_V(2); PG8_BAR;
    PG8_STAGE(PG8_SB(1, 0), cB + kstep, voffB); PG8_STAGE(PG8_SA(1, 0), cA + kstep, voffA); PG8_STAGE(PG8_SB(1, 1), cB + hstep + kstep, voffB);
    PG8_WAIT_V(6); PG8_BAR;
    for (;;) {
        const bool has_next = S.next(ui + 1, nxt);
        const char* nA = has_next ? (const char*)g.A + (size_t)nxt.pm * tstep : cA; const char* nB = has_next ? (const char*)g.Bt + (size_t)nxt.pn * tstep : cB;
        for (int t = 0; t < nt; t += 2) {
            const bool last = (t == nt - 2);
            const char* a1 = cA + (size_t)(t + 1) * kstep;
            const char* a2 = last ? nA : cA + (size_t)(t + 2) * kstep; const char* b2 = last ? nB : cB + (size_t)(t + 2) * kstep;
            const char* a3 = a2 + kstep; const char* b3 = b2 + kstep;
            PG8_LDB(B0, 0, 0); PG8_LDB(B1, 0, 1); PG8_SCHED; PG8_LDA(At, 0, 0); PG8_STAGE(PG8_SA(1, 1), a1 + hstep, voffA);
            PG8_WAIT_V(8); PG8_WAIT_L(0); PG8_BAR; PG8_MMA(0, 0, At, B0); PG8_MMA(0, 1, At, B1); PG8_BAR; PG8_SCHED;
            PG8_LDA(At, 0, 1); PG8_STAGE(PG8_SB(0, 0), b2, voffB); PG8_STAGE(PG8_SB(0, 1), b2 + hstep, voffB); PG8_STAGE(PG8_SA(0, 0), a2, voffA);
            PG8_WAIT_V(8); PG8_WAIT_L(0); PG8_BAR; PG8_MMA(1, 0, At, B0); PG8_MMA(1, 1, At, B1); PG8_BAR; PG8_SCHED;
            PG8_LDB(B0, 1, 0); PG8_LDB(B1, 1, 1); PG8_SCHED; PG8_LDA(At, 1, 0); PG8_STAGE(PG8_SA(0, 1), a2 + hstep, voffA);
            PG8_WAIT_V(8); PG8_WAIT_L(0); PG8_BAR; PG8_MMA(0, 0, At, B0); PG8_MMA(0, 1, At, B1); PG8_BAR; PG8_SCHED;
            PG8_LDA(At, 1, 1); PG8_STAGE(PG8_SB(1, 0), b3, voffB); PG8_STAGE(PG8_SB(1, 1), b3 + hstep, voffB); PG8_STAGE(PG8_SA(1, 0), a3, voffA);
            PG8_WAIT_V(8); PG8_WAIT_L(0); PG8_BAR; PG8_MMA(1, 0, At, B0); PG8_MMA(1, 1, At, B1); PG8_BAR; PG8_SCHED;
        }
        if (wr == 0) PG8_BAR;
        if constexpr (FP8) asm volatile("s_nop 15\n\ts_nop 15" ::: "memory");
        E(acc, cur, wr, wc, fr, fq);
        if (!has_next) break;
#pragma unroll
        for (int a = 0; a < 2; ++a)
#pragma unroll
            for (int b = 0; b < 2; ++b)
#pragma unroll
                for (int m = 0; m < 4; ++m)
#pragma unroll
                    for (int n = 0; n < 2; ++n) acc[a][b][m][n] = (f32x4){0.f, 0.f, 0.f, 0.f};
        cur = nxt; cA = nA; cB = nB; ++ui;
        if (wr == 1) PG8_BAR;
    }
    PG8_WAIT_V(0);
    PG8_BAR;
#undef PG8_SA
#undef PG8_SB
#undef PG8_STAGE
#undef PG8_LDA
#undef PG8_LD16
#undef PG8_LDB
#undef PG8_MMA
#undef PG8_WAIT_V
#undef PG8_WAIT_L
#undef PG8_BAR
#undef PG8_SCHED
}
typedef f32x4 Acc[2][2][4][2];

struct EpiProj {
    unsigned char* ws; const float* bias; int shift_lo, shift;
    DI void operator()(const Acc& acc, const Unit& u, int wr, int wc, int fr, int fq) const {
        int row0 = u.pm * BM + wr * 64 + fr; const int pn = u.pn >= shift_lo ? u.pn + shift : u.pn;
        bf16_t* base; int ldc, ct; const float* bp = bias + pn * BM;
        if (u.pm >= 128) { base = (bf16_t*)(ws + WS_MKV); ldc = 2048; ct = pn - PN_KV; row0 -= T; bp = nullptr; }
        else if (pn < 6) { base = (bf16_t*)(ws + WS_QK1); ldc = 1536; ct = pn; }
        else if (pn < 12) { base = (bf16_t*)(ws + WS_V1); ldc = 1536; ct = pn - 6; }
        else if (pn < 18) { base = (bf16_t*)(ws + WS_QK2); ldc = 1536; ct = pn - 12; }
        else if (pn < 24) { base = (bf16_t*)(ws + WS_V2); ldc = 1536; ct = pn - 18; }
        else if (pn < 30) { base = (bf16_t*)(ws + WS_O1); ldc = 1536; ct = pn - 24; }
        else if (pn < 34) { base = (bf16_t*)(ws + WS_Q3); ldc = 1024; ct = pn - 30; }
        else if (pn < 40) { base = (bf16_t*)(ws + WS_Z1); ldc = 1536; ct = pn - 34; }
        else if (pn < 46) { base = (bf16_t*)(ws + WS_Z2); ldc = 1536; ct = pn - 40; }
        else if (pn < 50) { base = (bf16_t*)(ws + WS_Z3); ldc = 1024; ct = pn - 46; }
        else {
            if (wc == 0 && fq < 2) {
                float* IFp = (float*)(ws + WS_IF);
                const f32x4 b0 = *(const f32x4*)(bp + 8 * fq), b1 = *(const f32x4*)(bp + 8 * fq + 4);
#pragma unroll
                for (int ai = 0; ai < 2; ++ai)
#pragma unroll
                    for (int m = 0; m < 4; ++m) { float* rp = IFp + (size_t)(row0 + ai * HALF + m * 16) * 16 + 8 * fq;
                        *(f32x4*)rp = acc[ai][0][m][0] + b0; *(f32x4*)(rp + 4) = acc[ai][0][m][1] + b1; }
            }
            return;
        }
        const int col0 = ct * BM + wc * 32 + 8 * fq, bc0 = wc * 32 + 8 * fq;
        f32x4 bv[2][2];
#pragma unroll
        for (int bj = 0; bj < 2; ++bj)
#pragma unroll
            for (int n = 0; n < 2; ++n) bv[bj][n] = bp ? *(const f32x4*)(bp + bc0 + bj * HALF + 4 * n) : (f32x4){0.f, 0.f, 0.f, 0.f};
#pragma unroll
        for (int ai = 0; ai < 2; ++ai)
#pragma unroll
            for (int m = 0; m < 4; ++m) { bf16_t* rowp = base + (size_t)(row0 + ai * HALF + m * 16) * ldc + col0;
#pragma unroll
                for (int bj = 0; bj < 2; ++bj) { const f32x4 v0 = acc[ai][bj][m][0] + bv[bj][0], v1 = acc[ai][bj][m][1] + bv[bj][1];
                    u32x4 w; w.x = cvt_pk_bf16(v0[0], v0[1]); w.y = cvt_pk_bf16(v0[2], v0[3]); w.z = cvt_pk_bf16(v1[0], v1[1]); w.w = cvt_pk_bf16(v1[2], v1[3]);
                    *(u32x4*)(rowp + bj * HALF) = w; } }
    }
};
struct EpiGate {
    unsigned char* ws; const float* bias;
    DI void operator()(const Acc& acc, const Unit& u, int wr, int wc, int fr, int fq) const {
        const int row0 = u.pm * BM + wr * 64 + fr; const float* bp = bias + (PN_GATE + u.pn) * BM + wc * 32 + 8 * fq;
        const int ct = u.pn, gi = ct >> 3; bf16_t* G = (bf16_t*)(ws + (gi == 0 ? WS_G0 : WS_G12 + (size_t)(gi - 1) * SZ20));
        const int col0 = (ct & 7) * BM + wc * 32 + 8 * fq;
        f32x4 bv[2][2];
#pragma unroll
        for (int bj = 0; bj < 2; ++bj)
#pragma unroll
            for (int n = 0; n < 2; ++n) bv[bj][n] = *(const f32x4*)(bp + bj * HALF + 4 * n);
#pragma unroll
        for (int ai = 0; ai < 2; ++ai)
#pragma unroll
            for (int m = 0; m < 4; ++m) { bf16_t* rowp = G + (size_t)(row0 + ai * HALF + m * 16) * 2048 + col0;
#pragma unroll
                for (int bj = 0; bj < 2; ++bj) { f32x4 v0 = acc[ai][bj][m][0] + bv[bj][0], v1 = acc[ai][bj][m][1] + bv[bj][1];
#pragma unroll
                    for (int e = 0; e < 4; ++e) { v0[e] = sigmoidf_(v0[e]); v1[e] = sigmoidf_(v1[e]); }
                    u32x4 w; w.x = cvt_pk_bf16(v0[0], v0[1]); w.y = cvt_pk_bf16(v0[2], v0[3]); w.z = cvt_pk_bf16(v1[0], v1[1]); w.w = cvt_pk_bf16(v1[2], v1[3]);
                    *(u32x4*)(rowp + bj * HALF) = w; } }
    }
};
struct EpiMerge {
    bf16_t* merged; const bf16_t* G; int gi;
    DI void operator()(const Acc& acc, const Unit& u, int wr, int wc, int fr, int fq) const {
        const int row0 = u.pm * BM + wr * 64 + fr, col0 = u.pn * BM + wc * 32 + 8 * fq;
#pragma unroll
        for (int ai = 0; ai < 2; ++ai)
#pragma unroll
            for (int m = 0; m < 4; ++m) { const size_t r = (size_t)(row0 + ai * HALF + m * 16);
#pragma unroll
                for (int bj = 0; bj < 2; ++bj) {
                    const u32x4 gv = *(const u32x4*)(G + r * 2048 + col0 + bj * HALF);
                    bf16_t* mp = merged + r * 2048 + col0 + bj * HALF;
                    const f32x4 a0 = acc[ai][bj][m][0], a1 = acc[ai][bj][m][1];
                    float o[8] = {a0[0] * bflo(gv.x), a0[1] * bfhi(gv.x), a0[2] * bflo(gv.y), a0[3] * bfhi(gv.y), a1[0] * bflo(gv.z), a1[1] * bfhi(gv.z), a1[2] * bflo(gv.w), a1[3] * bfhi(gv.w)};
                    if (gi > 0) { const u32x4 pv = __builtin_nontemporal_load((const u32x4*)mp);
                        o[0] += bflo(pv.x); o[1] += bfhi(pv.x); o[2] += bflo(pv.y); o[3] += bfhi(pv.y); o[4] += bflo(pv.z); o[5] += bfhi(pv.z); o[6] += bflo(pv.w); o[7] += bfhi(pv.w); }
                    u32x4 w; w.x = cvt_pk_bf16(o[0], o[1]); w.y = cvt_pk_bf16(o[2], o[3]); w.z = cvt_pk_bf16(o[4], o[5]); w.w = cvt_pk_bf16(o[6], o[7]);
                    *(u32x4*)mp = w; } }
    }
};
struct EpiOut {
    bf16_t* D;
    DI void operator()(const Acc& acc, const Unit& u, int wr, int wc, int fr, int fq) const {
        const int row0 = u.pm * BM + wr * 64 + fr, col0 = u.pn * BM + wc * 32 + 8 * fq;
#pragma unroll
        for (int ai = 0; ai < 2; ++ai)
#pragma unroll
            for (int m = 0; m < 4; ++m) { bf16_t* rowp = D + (size_t)(row0 + ai * HALF + m * 16) * 2048 + col0;
#pragma unroll
                for (int bj = 0; bj < 2; ++bj) { const f32x4 v0 = acc[ai][bj][m][0], v1 = acc[ai][bj][m][1];
                    u32x4 w; w.x = cvt_pk_bf16(v0[0], v0[1]); w.y = cvt_pk_bf16(v0[2], v0[3]); w.z = cvt_pk_bf16(v1[0], v1[1]); w.w = cvt_pk_bf16(v1[2], v1[3]);
                    *(u32x4*)(rowp + bj * HALF) = w; } }
    }
};
}

DI int src_col_of(int n) {
    if (n < 3072) return n;
    if (n < 4608) return n - 3072 + 6156;
    if (n < 6144) return n - 4608 + 7692;
    if (n < 7680) return n - 6144 + 3072;
    if (n < 8704) return n - 7680 + 10764;
    if (n < 10240) return n - 8704 + 4608;
    if (n < 11776) return n - 10240 + 9228;
    if (n < 12800) return n - 11776 + 11788;
    if (n < 12812) return n - 12800 + 6144;
    if (n < 13056) return -1;
    return n - 13056 + 12812;
}
struct TpItem { const float* W; bf16_t* WT; unsigned char* W8; int Nsrc, K, n0, k0, remap, n8; };
DI bool tp_decode(const Params& P, int it, TpItem& t) {
    constexpr int I_IN = 300 * 8, I_KV = 32 * 8, I_ML = 32 * 6, I_RET = 32 * 6, I_XA = 32 * 4, I_OUT = 32 * 8;
    unsigned char* ws = P.ws; int r = it; t.remap = 0; t.W8 = nullptr; t.n8 = 0;
    if (r < I_IN) { t.W = P.w_in; t.WT = (bf16_t*)(ws + WS_WIN); t.Nsrc = N_IN; t.K = 2048; t.n0 = (r >> 3) * 64; t.k0 = (r & 7) * 256; t.remap = 1;
        if (t.n0 >= 6144 && t.n0 < 8704) { t.W8 = (unsigned char*)P.out + DO_WO8; t.n8 = t.n0 - 6144; }
        else if (t.n0 >= 11776 && t.n0 < 12800) { t.W8 = (unsigned char*)P.out + DO_WO8; t.n8 = t.n0 - 11776 + 2560; }
        else if (t.n0 >= 13056) { t.W8 = (unsigned char*)P.out + DO_WG8; t.n8 = t.n0 - 13056; }
        return true; } r -= I_IN;
    if (r < I_KV) { t.W = P.w_kv; t.WT = (bf16_t*)(ws + WS_WKV); t.Nsrc = 2048; t.K = 2048; t.n0 = (r >> 3) * 64; t.k0 = (r & 7) * 256; return true; } r -= I_KV;
    if (r < I_ML) { t.W = P.w_ml; t.WT = (bf16_t*)(ws + WS_WML); t.Nsrc = 2048; t.K = 1536; t.n0 = (r / 6) * 64; t.k0 = (r % 6) * 256; return true; } r -= I_ML;
    if (r < I_RET) { t.W = P.w_ret; t.WT = (bf16_t*)(ws + WS_WRET); t.Nsrc = 2048; t.K = 1536; t.n0 = (r / 6) * 64; t.k0 = (r % 6) * 256; return true; } r -= I_RET;
    if (r < I_XA) { t.W = P.w_xa; t.WT = (bf16_t*)(ws + WS_WXA); t.Nsrc = 2048; t.K = 1024; t.n0 = (r >> 2) * 64; t.k0 = (r & 3) * 256; t.W8 = (unsigned char*)P.out + DO_WX8; t.n8 = t.n0; return true; } r -= I_XA;
    if (r < I_OUT) { t.W = P.w_out; t.WT = (bf16_t*)(ws + WS_WOUT); t.Nsrc = 2048; t.K = 2048; t.n0 = (r >> 3) * 64; t.k0 = (r & 7) * 256; return true; }
    return false;
}
DI void tp_load(const TpItem& t, int tid, f32x4 (&v)[8]) {
    const int nq = tid & 15, kk0 = tid >> 4; const int src = t.remap ? src_col_of(t.n0 + 4 * nq) : (t.n0 + 4 * nq);
#pragma unroll
    for (int i = 0; i < 8; ++i) v[i] = src >= 0 ? *(const f32x4*)(t.W + (size_t)(t.k0 + kk0 + 32 * i) * t.Nsrc + src) : (f32x4){0.f, 0.f, 0.f, 0.f};
}
DI void p0_transposes(const Params& P, LAS unsigned char* lds) {
    const int tid = opaque_tid(), G = gridDim.x, bx = blockIdx.x, nq = tid & 15, kk0 = tid >> 4;
    LAS bf16_t* tile = (LAS bf16_t*)lds;
    TpItem cur, nxt; f32x4 v[8];
    int it = bx; bool have = tp_decode(P, it, cur);
    if (have) tp_load(cur, tid, v);
    while (have) {
        if (cur.W8) {
#pragma unroll
            for (int i = 0; i < 8; ++i) { const int kk = kk0 + 32 * i; unsigned q = 0u;
                q = __builtin_amdgcn_cvt_pk_fp8_f32(v[i][0] * 64.f, v[i][1] * 64.f, q, false); q = __builtin_amdgcn_cvt_pk_fp8_f32(v[i][2] * 64.f, v[i][3] * 64.f, q, true);
#pragma unroll
                for (int e = 0; e < 4; ++e) *(LAS unsigned char*)(lds + (4 * nq + e) * 272 + kk) = (unsigned char)(q >> (8 * e)); }
        } else {
#pragma unroll
            for (int i = 0; i < 8; ++i) { const int kk = kk0 + 32 * i;
#pragma unroll
                for (int e = 0; e < 4; ++e) tile[(4 * nq + e) * 264 + kk] = (bf16_t)(cvt_pk_bf16(v[i][e], 0.f) & 0xffffu); }
        }
        __syncthreads();
        it += G; const bool hn = tp_decode(P, it, nxt);
        if (hn) tp_load(nxt, tid, v);
        if (cur.W8) {
#pragma unroll
            for (int j = 0; j < 2; ++j) { const int p = tid + 512 * j, n2 = p >> 4, kq = p & 15; const u32x4 tv = *(const LAS u32x4*)(lds + n2 * 272 + kq * 16); *(u32x4*)(cur.W8 + (size_t)(cur.n8 + n2) * cur.K + cur.k0 + 16 * kq) = tv; }
        } else {
#pragma unroll
            for (int j = 0; j < 4; ++j) { const int p = tid + 512 * j, n2 = p >> 5, kq = p & 31; const u32x4 tv = *(const LAS u32x4*)(lds + n2 * 528 + kq * 16); *(u32x4*)(cur.WT + (size_t)(cur.n0 + n2) * cur.K + cur.k0 + 8 * kq) = tv; }
        }
        __syncthreads();
        cur = nxt; have = hn;
    }
}
DI void rms_row(const float* xr, const float* g, bf16_t* o, unsigned char* o8, int lane) {
    f32x4 v[8]; float s = 0.f;
#pragma unroll
    for (int i = 0; i < 8; ++i) { v[i] = *(const f32x4*)(xr + 4 * (lane + 64 * i)); s += v[i][0] * v[i][0] + v[i][1] * v[i][1] + v[i][2] * v[i][2] + v[i][3] * v[i][3]; }
    s = wave_sum(s); const float sc = rsqrtf(s * (1.0f / 2048.0f) + EPS);
#pragma unroll
    for (int i = 0; i < 8; ++i) { const f32x4 gg = *(const f32x4*)(g + 4 * (lane + 64 * i)); const f32x4 y = v[i] * sc * gg;
        u32x2 w; w.x = cvt_pk_bf16(y[0], y[1]); w.y = cvt_pk_bf16(y[2], y[3]); *(u32x2*)(o + 4 * (lane + 64 * i)) = w;
        if (o8) { unsigned q = 0u; q = __builtin_amdgcn_cvt_pk_fp8_f32(y[0], y[1], q, false); q = __builtin_amdgcn_cvt_pk_fp8_f32(y[2], y[3], q, true); *(unsigned*)(o8 + 4 * (lane + 64 * i)) = q; } }
}
DI void p0_prologue(const Params& P, LAS unsigned char* lds) {
    const int tid = opaque_tid(), lane = tid & 63, wave = tid >> 6, G = gridDim.x, bx = blockIdx.x;
    unsigned char* ws = P.ws;
    if (bx == 0 && tid < 64) ((unsigned*)(ws + WS_CTL))[tid] = 0u;
    if (bx == 0) for (int i = tid; i < 3456; i += 512) ((unsigned*)(ws + WS_BAR))[i] = 0u;
    for (int i = bx * 512 + tid; i < T; i += G * 512) ((float*)(ws + WS_SS))[i] = 0.f;
    for (int i = bx * 512 + tid; i < NPAD; i += G * 512) { const int s = src_col_of(i); ((float*)(ws + WS_BIAS))[i] = s >= 0 ? P.b_in[s] : 0.f; }
    bf16_t* H = (bf16_t*)((unsigned char*)P.out + DO_H);
    for (int r = bx * 8 + wave; r < T + 2048; r += G * 8) {
        if (r < T) rms_row(P.x + (size_t)r * DM, P.ln_g, H + (size_t)r * DM, ws + WS_H8 + (size_t)r * DM, lane);
        else rms_row(P.mem + (size_t)(r - T) * DM, P.mem_ln_g, H + (size_t)r * DM, nullptr, lane);
    }
    p0_transposes(P, lds);
}

DI float logsigmoidf_(float v) { return fminf(v, 0.f) - log1pf(expf(-fabsf(v))); }
DI void p2_gates_wg(const Params& P, int bh, LAS unsigned char* lds) {
    const int tid = opaque_tid(), lane = tid & 63, wave = tid >> 6;
    unsigned char* ws = P.ws; const int b = bh / 6, h = bh % 6;
    const float* IFp = (const float*)(ws + WS_IF) + (size_t)b * SEQ * 16;
    float* A1 = (float*)(ws + WS_GS) + (size_t)bh * SEQ; float* IB = A1 + GS_ARR; float* INTER = IB + GS_ARR; float* EDEN = INTER + GS_ARR; float* W = EDEN + GS_ARR;
    float* DEC = (float*)(ws + WS_GDEC) + bh * 64;
    LAS f32x2* AB = (LAS f32x2*)lds;
    float iv[8], fv[8], bbv[8], ibv[8], mxv[8], gv[8], mxa[8];
#pragma unroll
    for (int k = 0; k < 8; ++k) { const int t = (wave * 8 + k) * 64 + lane; iv[k] = IFp[(size_t)t * 16 + h]; fv[k] = IFp[(size_t)t * 16 + 6 + h]; }
#pragma unroll
    for (int k = 0; k < 8; ++k) {
        float bb = logsigmoidf_(fv[k]);
#pragma unroll
        for (int o = 1; o < 64; o <<= 1) { const float u = __shfl_up(bb, o); if (lane >= o) bb += u; }
        const float g = __shfl(bb, 63), ib = iv[k] - bb;
        float mx = ib;
#pragma unroll
        for (int o = 1; o < 64; o <<= 1) { const float u = __shfl_up(mx, o); if (lane >= o) mx = fmaxf(mx, u); }
        const float mxall = __shfl(mx, 63);
        bbv[k] = bb; ibv[k] = ib; mxv[k] = mx; gv[k] = g; mxa[k] = mxall;
        if (lane == 0) AB[wave * 8 + k] = (f32x2){g, g + mxall};
        __builtin_amdgcn_sched_barrier(0);
    }
    __syncthreads();
    float m = 0.f;
    for (int c = 0; c < wave * 8; ++c) { const f32x2 ab = AB[c]; m = fmaxf(m + ab.x, ab.y); }
#pragma unroll
    for (int k = 0; k < 8; ++k) {
        const int c = wave * 8 + k, t = c * 64 + lane;
        const float log_inter = bbv[k] + m, m_row = fmaxf(log_inter, bbv[k] + mxv[k]);
        const float m_new = fmaxf(gv[k] + m, gv[k] + mxa[k]);
        A1[t] = bbv[k] - m_row; IB[t] = ibv[k]; INTER[t] = expf(log_inter - m_row); EDEN[t] = expf(-m_row); W[t] = expf(gv[k] + ibv[k] - m_new);
        if (lane == 0) DEC[c] = expf(gv[k] + m - m_new);
        m = m_new;
        __builtin_amdgcn_sched_barrier(0);
    }
    __syncthreads();
}
DI void p2_prep(const Params& P, LAS unsigned char* lds) {
    const int tid = opaque_tid(), lane = tid & 63, wave = tid >> 6, G = gridDim.x, bx = blockIdx.x;
    unsigned char* ws = P.ws;
    for (int it = bx; it < 48; it += G) p2_gates_wg(P, it, lds);
    if (bx == (G > 48 ? 48 : 0) && tid < 6 * 64) {
        const int h = tid >> 6, l = tid & 63; const float lg = logf(1.0f - exp2f(-5.0f - (float)h));
        float* RV = (float*)(ws + WS_RV) + h * 5 * 64;
        RV[l] = (float)l * lg; RV[64 + l] = -(float)l * lg; RV[128 + l] = expf((float)(l + 1) * lg); RV[192 + l] = 1.0f; RV[256 + l] = expf((float)(63 - l) * lg);
        if (l == 0) ((float*)(ws + WS_RV))[6 * 5 * 64 + h] = expf(64.0f * lg);
    }
    const bf16_t* QK1 = (const bf16_t*)(ws + WS_QK1); bf16_t* QKC = (bf16_t*)((unsigned char*)P.out + DO_QKC);
    for (int idx = bx * 512 + tid; idx < (T / 16) * 192; idx += G * 512) {
        const int rb = idx / 192, cgp = idx % 192, r0 = rb * 16, c0 = cgp * 8;
        float w[4][8], bz[8], u[3][8];
#pragma unroll
        for (int k = 0; k < 4; ++k) { const f32x4 a = *(const f32x4*)(P.conv_w + k * 1536 + c0), b = *(const f32x4*)(P.conv_w + k * 1536 + c0 + 4);
            w[k][0] = a[0]; w[k][1] = a[1]; w[k][2] = a[2]; w[k][3] = a[3]; w[k][4] = b[0]; w[k][5] = b[1]; w[k][6] = b[2]; w[k][7] = b[3]; }
        { const f32x4 a = *(const f32x4*)(P.conv_b + c0), b = *(const f32x4*)(P.conv_b + c0 + 4); bz[0] = a[0]; bz[1] = a[1]; bz[2] = a[2]; bz[3] = a[3]; bz[4] = b[0]; bz[5] = b[1]; bz[6] = b[2]; bz[7] = b[3]; }
        const bool hist = (r0 & (SEQ - 1)) != 0;
#pragma unroll
        for (int k = 0; k < 3; ++k) {
            u32x4 v = (u32x4){0u, 0u, 0u, 0u}; if (hist) v = *(const u32x4*)(QK1 + (size_t)(r0 - 3 + k) * 1536 + c0);
            u[k][0] = bflo(v.x); u[k][1] = bfhi(v.x); u[k][2] = bflo(v.y); u[k][3] = bfhi(v.y); u[k][4] = bflo(v.z); u[k][5] = bfhi(v.z); u[k][6] = bflo(v.w); u[k][7] = bfhi(v.w); }
        const float sc = c0 < 768 ? 0.08838834764831845f : 1.0f;
        for (int rh = 0; rh < 16; rh += 8) {
        u32x4 rows[8];
#pragma unroll
        for (int r = 0; r < 8; ++r) rows[r] = *(const u32x4*)(QK1 + (size_t)(r0 + rh + r) * 1536 + c0);
#pragma unroll
        for (int rr = 0; rr < 8; ++rr) { const int r = rh + rr;
            const u32x4 v = rows[rr];
            const float cu[8] = {bflo(v.x), bfhi(v.x), bflo(v.y), bfhi(v.y), bflo(v.z), bfhi(v.z), bflo(v.w), bfhi(v.w)};
            float y[8];
#pragma unroll
            for (int e = 0; e < 8; ++e) { const float a = bz[e] + w[0][e] * u[0][e] + w[1][e] * u[1][e] + w[2][e] * u[2][e] + w[3][e] * cu[e]; y[e] = siluf_(a) * sc; u[0][e] = u[1][e]; u[1][e] = u[2][e]; u[2][e] = cu[e]; }
            u32x4 o; o.x = cvt_pk_bf16(y[0], y[1]); o.y = cvt_pk_bf16(y[2], y[3]); o.z = cvt_pk_bf16(y[4], y[5]); o.w = cvt_pk_bf16(y[6], y[7]);
            *(u32x4*)(QKC + (size_t)(r0 + r) * 1536 + c0) = o;
        }
        }
    }
    bf16_t* QK2 = (bf16_t*)(ws + WS_QK2);
    for (int idx = bx * 512 + tid; idx < T * 8; idx += G * 512) {
        const int tok = idx >> 3, dg = idx & 7; const float pos = (float)P.pos[tok];
        float cs[8], sn[8];
#pragma unroll
        for (int j = 0; j < 8; ++j) { const float fr = exp2f(-(float)(dg * 8 + j) * (13.287712379549449f / 64.0f)); const float ang = pos * fr;
            double rev = (double)ang * 0.15915494309189535; rev -= rint(rev); const float rf = (float)rev;
            sn[j] = __builtin_amdgcn_sinf(rf); cs[j] = __builtin_amdgcn_cosf(rf); }
        for (int hg = 0; hg < 4; ++hg) {
            u32x4 la[3], lb[3];
#pragma unroll
            for (int k = 0; k < 3; ++k) { const bf16_t* p = QK2 + (size_t)tok * 1536 + (hg * 3 + k) * 128 + dg * 8; la[k] = *(const u32x4*)p; lb[k] = *(const u32x4*)(p + 64); }
#pragma unroll
            for (int k = 0; k < 3; ++k) {
                bf16_t* p = QK2 + (size_t)tok * 1536 + (hg * 3 + k) * 128 + dg * 8; const float sc = hg >= 2 ? 0.08838834764831845f : 1.0f;
                const u32x4 a = la[k], b = lb[k];
                const float t1[8] = {bflo(a.x), bfhi(a.x), bflo(a.y), bfhi(a.y), bflo(a.z), bfhi(a.z), bflo(a.w), bfhi(a.w)};
                const float t2[8] = {bflo(b.x), bfhi(b.x), bflo(b.y), bfhi(b.y), bflo(b.z), bfhi(b.z), bflo(b.w), bfhi(b.w)};
                float o1[8], o2[8];
#pragma unroll
                for (int j = 0; j < 8; ++j) { o1[j] = (t1[j] * cs[j] - t2[j] * sn[j]) * sc; o2[j] = (t1[j] * sn[j] + t2[j] * cs[j]) * sc; }
                u32x4 x1, x2; x1.x = cvt_pk_bf16(o1[0], o1[1]); x1.y = cvt_pk_bf16(o1[2], o1[3]); x1.z = cvt_pk_bf16(o1[4], o1[5]); x1.w = cvt_pk_bf16(o1[6], o1[7]);
                x2.x = cvt_pk_bf16(o2[0], o2[1]); x2.y = cvt_pk_bf16(o2[2], o2[3]); x2.z = cvt_pk_bf16(o2[4], o2[5]); x2.w = cvt_pk_bf16(o2[6], o2[7]);
                *(u32x4*)p = x1; *(u32x4*)(p + 64) = x2;
            }
        }
    }
}

constexpr int SQ_P = 272, SV_P = 528, ST_P = 144;
constexpr int SC_STAGE = 64 * SQ_P * 2 + 64 * SV_P;
constexpr int SC_ST = 2 * SC_STAGE;
constexpr int SC_NV = SC_ST + 64 * ST_P;
constexpr int SC_RDEN = SC_NV + 512;
constexpr int SC_LNP = SC_RDEN + 256;
constexpr int SC_VEC = SC_LNP + 4096;
constexpr int SC_GAIN = SC_VEC + 2560;
constexpr int SC_END = SC_GAIN + 1024;
static_assert(SC_END <= LDS_BYTES, "scan LDS");

DI void scan_item(const Params& P, LAS unsigned char* lds, int item) {
    const int tid = opaque_tid(), lane = tid & 63, w = __builtin_amdgcn_readfirstlane(tid >> 6), r = lane & 15, g = lane >> 4, q4 = r >> 2, p4 = r & 3;
    unsigned char* ws = P.ws;
    const bool is_ml = item < 48; const int bh = is_ml ? item : item - 48, b = bh / 6, h = bh % 6;
    const bf16_t* Qg = (is_ml ? (const bf16_t*)((unsigned char*)P.out + DO_QKC) : (const bf16_t*)(ws + WS_QK2)) + (size_t)b * SEQ * 1536 + h * 128;
    const bf16_t* Kg = Qg + 768;
    bf16_t* Vg = (bf16_t*)(ws + (is_ml ? WS_V1 : WS_V2)) + (size_t)b * SEQ * 1536 + h * 256;
    const float* vbase; const float* vDEC; int cstr, dstr; size_t vstr;
    if (is_ml) { vbase = (const float*)(ws + WS_GS) + (size_t)bh * SEQ; vstr = GS_ARR; vDEC = (const float*)(ws + WS_GDEC) + bh * 64; cstr = 64; dstr = 1; }
    else { vbase = (const float*)(ws + WS_RV) + h * 320; vstr = 64; vDEC = (const float*)(ws + WS_RV) + 6 * 320 + h; cstr = 0; dstr = 0; }
    const float* vptr = vbase + (size_t)(tid >> 6) * vstr + (tid & 63);
    const unsigned ldsb = (unsigned)(size_t)lds;
    f32x4 Cacc[8][2];
#pragma unroll
    for (int i = 0; i < 8; ++i) { Cacc[i][0] = (f32x4){0.f, 0.f, 0.f, 0.f}; Cacc[i][1] = (f32x4){0.f, 0.f, 0.f, 0.f}; }
    if (tid < 128) ((LAS float*)(lds + SC_NV))[tid] = 0.f;
    if (tid < 64) ((LAS float*)(lds + SC_RDEN))[tid] = 1.0f;
    u32x4 pq[2], pk[2], pv[4];
    unsigned qoff = (unsigned)(tid >> 4) * 3072u + (unsigned)(tid & 15) * 16u, voff = (unsigned)(tid >> 5) * 3072u + (unsigned)(tid & 31) * 16u, zoff = (unsigned)r * 3072u + (unsigned)(32 * w + 8 * g) * 2u;
#define SC_LOAD(c) do { const size_t cb = (size_t)(c) * 64 * 3072; const char* qb_ = (const char*)Qg + cb; const char* kb_ = (const char*)Kg + cb; const char* vb_ = (const char*)Vg + cb; \
        _Pragma("unroll") for (int i = 0; i < 2; ++i) { pq[i] = *(const u32x4*)(qb_ + (qoff + i * 98304u)); pk[i] = *(const u32x4*)(kb_ + (qoff + i * 98304u)); } \
        _Pragma("unroll") for (int i = 0; i < 4; ++i) { pv[i] = *(const u32x4*)(vb_ + (voff + i * 49152u)); } } while (0)
#define SC_STORE(st) do { LAS unsigned char* sb = lds + (st) * SC_STAGE; \
        _Pragma("unroll") for (int i = 0; i < 2; ++i) { const int pp = tid + 512 * i, row = pp >> 4, ch = pp & 15; *(LAS u32x4*)(sb + row * SQ_P + ch * 16) = pq[i]; *(LAS u32x4*)(sb + 64 * SQ_P + row * SQ_P + ch * 16) = pk[i]; } \
        _Pragma("unroll") for (int i = 0; i < 4; ++i) { const int pp = tid + 512 * i, row = pp >> 5, ch = pp & 31; *(LAS u32x4*)(sb + 128 * SQ_P + row * SV_P + ch * 16) = pv[i]; } } while (0)
    SC_LOAD(0); SC_STORE(0);
    if (tid < 320) ((LAS float*)(lds + SC_VEC))[tid] = vptr[0];
    __syncthreads();

    for (int c = 0; c < 64; ++c) {
        const int cur = c & 1;
        asm volatile("" : "+v"(qoff), "+v"(voff), "+v"(zoff));
        LAS unsigned char* Qs = lds + cur * SC_STAGE; LAS unsigned char* Ks = Qs + 64 * SQ_P; LAS unsigned char* Vs = Qs + 128 * SQ_P;
        const unsigned KsA = ldsb + cur * SC_STAGE + 64 * SQ_P, VsA = ldsb + cur * SC_STAGE + 128 * SQ_P;
        const LAS float* cA1 = (const LAS float*)(lds + SC_VEC + cur * 1280); const LAS float* cIB = cA1 + 64; const LAS float* cINT = cA1 + 128; const LAS float* cEDEN = cA1 + 192; const LAS float* cW = cA1 + 256;
        const float decay = vDEC[c * dstr];
        {
            const int mb = w >> 1, l = 16 * mb + r; const float a1 = cA1[l];
            bf16x8 qf[4];
#pragma unroll
            for (int ks = 0; ks < 4; ++ks) qf[ks] = *(const LAS bf16x8*)(Qs + l * SQ_P + (32 * ks + 8 * g) * 2);
#pragma unroll
            for (int nn = 0; nn < 2; ++nn) {
                const int nb = 2 * (w & 1) + nn; u32x2 o = (u32x2){0u, 0u};
                if (nb <= mb) {
                    f32x4 s = (f32x4){0.f, 0.f, 0.f, 0.f};
#pragma unroll
                    for (int ks = 0; ks < 4; ++ks) { const bf16x8 kf = *(const LAS bf16x8*)(Ks + (16 * nb + r) * SQ_P + (32 * ks + 8 * g) * 2); s = MFMA16(kf, qf[ks], s); }
                    const f32x4 ib = *(const LAS f32x4*)(cIB + 16 * nb + 4 * g);
                    float d[4];
#pragma unroll
                    for (int j = 0; j < 4; ++j) { const int sidx = 16 * nb + 4 * g + j; d[j] = (sidx <= l) ? s[j] * __expf(a1 + ib[j]) : 0.f; }
                    o.x = cvt_pk_bf16(d[0], d[1]); o.y = cvt_pk_bf16(d[2], d[3]);
                }
                *(LAS u32x2*)(lds + SC_ST + l * ST_P + (16 * nb + 4 * g) * 2) = o;
            }
        }
        LBAR();
        if (is_ml) {
            const int l = tid >> 3, part = tid & 7;
            const u32x4 sv = *(const LAS u32x4*)(lds + SC_ST + l * ST_P + part * 16);
            float ssum = bflo(sv.x) + bfhi(sv.x) + bflo(sv.y) + bfhi(sv.y) + bflo(sv.z) + bfhi(sv.z) + bflo(sv.w) + bfhi(sv.w);
            const u32x4 q0 = *(const LAS u32x4*)(Qs + l * SQ_P + part * 32), q1 = *(const LAS u32x4*)(Qs + l * SQ_P + part * 32 + 16);
            const LAS f32x4* nv = (const LAS f32x4*)(lds + SC_NV + part * 64);
            const f32x4 n0 = nv[0], n1 = nv[1], n2 = nv[2], n3 = nv[3];
            float qn = bflo(q0.x) * n0[0] + bfhi(q0.x) * n0[1] + bflo(q0.y) * n0[2] + bfhi(q0.y) * n0[3] + bflo(q0.z) * n1[0] + bfhi(q0.z) * n1[1] + bflo(q0.w) * n1[2] + bfhi(q0.w) * n1[3]
                     + bflo(q1.x) * n2[0] + bfhi(q1.x) * n2[1] + bflo(q1.y) * n2[2] + bfhi(q1.y) * n2[3] + bflo(q1.z) * n3[0] + bfhi(q1.z) * n3[1] + bflo(q1.w) * n3[2] + bfhi(q1.w) * n3[3];
            float val = ssum + cINT[l] * qn;
            val += __shfl_xor(val, 1); val += __shfl_xor(val, 2); val += __shfl_xor(val, 4);
            if (part == 0) ((LAS float*)(lds + SC_RDEN))[l] = 1.0f / fmaxf(fabsf(val), cEDEN[l]);
        }
        __builtin_amdgcn_sched_barrier(0);
        LBAR();
        bf16x8 vf[2][2];
        unsigned vtb = VsA + (8 * g + q4) * SV_P + (32 * w + 8 * p4) * 2; asm volatile("" : "+v"(vtb));
        unsigned ktb = KsA + (8 * g + q4) * SQ_P + (4 * p4) * 2; asm volatile("" : "+v"(ktb));
        { s16x4 t8[8];
          tr_read8(t8, vtb, vtb + 4 * SV_P, vtb + 32 * SV_P, vtb + 36 * SV_P, vtb + 8, vtb + 8 + 4 * SV_P, vtb + 8 + 32 * SV_P, vtb + 8 + 36 * SV_P);
          vf[0][0] = __builtin_shufflevector(t8[0], t8[1], 0, 1, 2, 3, 4, 5, 6, 7); vf[0][1] = __builtin_shufflevector(t8[2], t8[3], 0, 1, 2, 3, 4, 5, 6, 7);
          vf[1][0] = __builtin_shufflevector(t8[4], t8[5], 0, 1, 2, 3, 4, 5, 6, 7); vf[1][1] = __builtin_shufflevector(t8[6], t8[7], 0, 1, 2, 3, 4, 5, 6, 7); }
        f32x4 hi_[4][2], hx_[4][2];
#pragma unroll
        for (int mb = 0; mb < 4; ++mb)
#pragma unroll
            for (int vt = 0; vt < 2; ++vt) { hi_[mb][vt] = (f32x4){0.f, 0.f, 0.f, 0.f}; hx_[mb][vt] = (f32x4){0.f, 0.f, 0.f, 0.f}; }
#pragma unroll
        for (int mb = 0; mb < 4; ++mb)
#pragma unroll
            for (int ks = 0; ks < 2; ++ks) {
                if (ks == 1 && mb < 2) continue;
                const bf16x8 sf = *(const LAS bf16x8*)(lds + SC_ST + (16 * mb + r) * ST_P + (32 * ks + 8 * g) * 2);
                hi_[mb][0] = MFMA16(vf[0][ks], sf, hi_[mb][0]); hi_[mb][1] = MFMA16(vf[1][ks], sf, hi_[mb][1]);
            }
#pragma unroll
        for (int p = 0; p < 4; ++p) {
            bf16x8 cf[2];
#pragma unroll
            for (int vt = 0; vt < 2; ++vt) { u32x4 t; const f32x4 c0 = Cacc[2 * p][vt], c1 = Cacc[2 * p + 1][vt];
                t.x = cvt_pk_bf16(c0[0], c0[1]); t.y = cvt_pk_bf16(c0[2], c0[3]); t.z = cvt_pk_bf16(c1[0], c1[1]); t.w = cvt_pk_bf16(c1[2], c1[3]); cf[vt] = __builtin_bit_cast(bf16x8, t); }
#pragma unroll
            for (int mb = 0; mb < 4; ++mb) {
                const u32x2 qa = *(const LAS u32x2*)(Qs + (16 * mb + r) * SQ_P + (32 * p + 4 * g) * 2), qb = *(const LAS u32x2*)(Qs + (16 * mb + r) * SQ_P + (32 * p + 16 + 4 * g) * 2);
                u32x4 t; t.x = qa.x; t.y = qa.y; t.z = qb.x; t.w = qb.y; const bf16x8 qf2 = __builtin_bit_cast(bf16x8, t);
                hx_[mb][0] = MFMA16(cf[0], qf2, hx_[mb][0]); hx_[mb][1] = MFMA16(cf[1], qf2, hx_[mb][1]);
            }
            __builtin_amdgcn_sched_barrier(0);
        }
#pragma unroll
        for (int mb = 0; mb < 4; ++mb) { const int l = 16 * mb + r; const float it = cINT[l], rd = ((const LAS float*)(lds + SC_RDEN))[l];
            float v[8];
#pragma unroll
            for (int vt = 0; vt < 2; ++vt)
#pragma unroll
                for (int j = 0; j < 4; ++j) v[4 * vt + j] = (hi_[mb][vt][j] + it * hx_[mb][vt][j]) * rd;
            u32x4 st; st.x = cvt_pk_bf16(v[0], v[1]); st.y = cvt_pk_bf16(v[2], v[3]); st.z = cvt_pk_bf16(v[4], v[5]); st.w = cvt_pk_bf16(v[6], v[7]);
            *(u32x4*)((char*)Vg + (size_t)c * 64 * 3072 + (zoff + mb * 49152u)) = st;
        }
        {
            bf16x8 vw[2][2];
#pragma unroll
            for (int ks = 0; ks < 2; ++ks) { const f32x4 w0 = *(const LAS f32x4*)(cW + 32 * ks + 8 * g), w1 = *(const LAS f32x4*)(cW + 32 * ks + 8 * g + 4);
#pragma unroll
                for (int vt = 0; vt < 2; ++vt) { const u32x4 t = __builtin_bit_cast(u32x4, vf[vt][ks]); u32x4 o;
                    o.x = cvt_pk_bf16(bflo(t.x) * w0[0], bfhi(t.x) * w0[1]); o.y = cvt_pk_bf16(bflo(t.y) * w0[2], bfhi(t.y) * w0[3]);
                    o.z = cvt_pk_bf16(bflo(t.z) * w1[0], bfhi(t.z) * w1[1]); o.w = cvt_pk_bf16(bflo(t.w) * w1[2], bfhi(t.w) * w1[3]); vw[vt][ks] = __builtin_bit_cast(bf16x8, o); } }
#pragma unroll
            for (int dp = 0; dp < 4; ++dp) {
                s16x4 t8[8]; const unsigned kb0 = ktb + (32 * dp) * 2, kb1 = kb0 + 32;
                tr_read8(t8, kb0, kb0 + 4 * SQ_P, kb0 + 32 * SQ_P, kb0 + 36 * SQ_P, kb1, kb1 + 4 * SQ_P, kb1 + 32 * SQ_P, kb1 + 36 * SQ_P);
#pragma unroll
                for (int dd = 0; dd < 2; ++dd) { const int db = 2 * dp + dd;
                    Cacc[db][0] = Cacc[db][0] * decay; Cacc[db][1] = Cacc[db][1] * decay;
#pragma unroll
                    for (int ks = 0; ks < 2; ++ks) {
                        const bf16x8 kf = __builtin_shufflevector(t8[4 * dd + 2 * ks], t8[4 * dd + 2 * ks + 1], 0, 1, 2, 3, 4, 5, 6, 7);
                        Cacc[db][0] = MFMA16(kf, vw[0][ks], Cacc[db][0]); Cacc[db][1] = MFMA16(kf, vw[1][ks], Cacc[db][1]);
                    } }
            }
        }
        __builtin_amdgcn_sched_barrier(0);
        float vpre = 0.f;
        if (c + 1 < 64) { SC_LOAD(c + 1); if (tid < 320) vpre = vptr[(c + 1) * cstr]; }
        __builtin_amdgcn_sched_barrier(0);
        if (is_ml) {
            const int d = tid >> 2, part = tid & 3; float s = 0.f;
#pragma unroll
            for (int j = 0; j < 16; ++j) { const int sidx = 16 * part + j; s += cW[sidx] * bf2f(*(const LAS bf16_t*)(Ks + sidx * SQ_P + d * 2)); }
            s += __shfl_xor(s, 1); s += __shfl_xor(s, 2);
            if (part == 0) { LAS float* np = (LAS float*)(lds + SC_NV) + d; *np = decay * (*np) + s; }
        }
        if (c + 1 < 64) { SC_STORE(cur ^ 1); if (tid < 320) ((LAS float*)(lds + SC_VEC + (cur ^ 1) * 1280))[tid] = vpre; }
        LBAR();
    }
#undef SC_LOAD
#undef SC_STORE
}


DI void p3b_gate(const Params& P) {
    const int tid = opaque_tid(), lane = tid & 63, sub = lane >> 4, li = lane & 15, G = gridDim.x, bx = blockIdx.x;
    unsigned char* ws = P.ws;
    const int nw = T * 6 * 2 / 4;
    for (int wv = bx * 8 + (tid >> 6); wv < nw; wv += G * 8) {
        int pair = wv * 4 + sub; const int br = pair >= T * 6; pair -= br * T * 6; const int t = pair / 6, h = pair - t * 6;
        const size_t off = (size_t)t * 1536 + h * 256 + li * 16;
        const bf16_t* hp = (const bf16_t*)(ws + (br ? WS_V2 : WS_V1)) + off; bf16_t* zp = (bf16_t*)(ws + (br ? WS_Z2 : WS_Z1)) + off; const bf16_t* op = (const bf16_t*)(ws + WS_O1) + off;
        const float* gp = (br ? P.ret_g : P.ml_g) + h * 256 + li * 16;
        const u32x4 h0 = *(const u32x4*)hp, h1 = *(const u32x4*)(hp + 8), z0 = *(const u32x4*)zp, z1 = *(const u32x4*)(zp + 8);
        u32x4 o0 = (u32x4){0u, 0u, 0u, 0u}, o1 = o0; if (!br) { o0 = *(const u32x4*)op; o1 = *(const u32x4*)(op + 8); }
        const unsigned hh[8] = {h0.x, h0.y, h0.z, h0.w, h1.x, h1.y, h1.z, h1.w}, zz[8] = {z0.x, z0.y, z0.z, z0.w, z1.x, z1.y, z1.z, z1.w}, oo[8] = {o0.x, o0.y, o0.z, o0.w, o1.x, o1.y, o1.z, o1.w};
        float hv[16], s1 = 0.f, s2 = 0.f;
#pragma unroll
        for (int e = 0; e < 16; ++e) { hv[e] = (e & 1) ? bfhi(hh[e >> 1]) : bflo(hh[e >> 1]); s1 += hv[e]; s2 += hv[e] * hv[e]; }
#pragma unroll
        for (int o = 1; o < 16; o <<= 1) { s1 += __shfl_xor(s1, o); s2 += __shfl_xor(s2, o); }
        const float mean = s1 * (1.0f / 256.0f), var = fmaxf(s2 * (1.0f / 256.0f) - mean * mean, 0.f), rstd = rsqrtf(var + EPS);
        float y[16];
#pragma unroll
        for (int q = 0; q < 4; ++q) { const f32x4 gg = *(const f32x4*)(gp + 4 * q);
#pragma unroll
            for (int j = 0; j < 4; ++j) { const int e = 4 * q + j; const float z = (e & 1) ? bfhi(zz[e >> 1]) : bflo(zz[e >> 1]); float v = (hv[e] - mean) * rstd * gg[j] * siluf_(z);
                if (!br) { const float o = (e & 1) ? bfhi(oo[e >> 1]) : bflo(oo[e >> 1]); v *= sigmoidf_(o); } y[e] = v; } }
        u32x4 a, c2; a.x = cvt_pk_bf16(y[0], y[1]); a.y = cvt_pk_bf16(y[2], y[3]); a.z = cvt_pk_bf16(y[4], y[5]); a.w = cvt_pk_bf16(y[6], y[7]);
        c2.x = cvt_pk_bf16(y[8], y[9]); c2.y = cvt_pk_bf16(y[10], y[11]); c2.z = cvt_pk_bf16(y[12], y[13]); c2.w = cvt_pk_bf16(y[14], y[15]);
        *(u32x4*)zp = a; *(u32x4*)(zp + 8) = c2;
    }
}

constexpr int AK_P = 528;
constexpr int AV_P = 544;
static_assert(256 * AV_P <= LDS_BYTES - 16, "attn LDS");
DI void attn_unit(const Params& P, LAS unsigned char* lds, int unit) {
    const int tid = opaque_tid(), lane = tid & 63, w = __builtin_amdgcn_readfirstlane(tid >> 6), r = lane & 15, g = lane >> 4, q4 = r >> 2, p4 = r & 3;
    unsigned char* ws = P.ws;
    const int b = unit >> 6, hh = (unit >> 4) & 3, qb = unit & 15;
    const size_t trow = (size_t)b * SEQ + qb * 256 + 32 * w + r;
    const bf16_t* Qp = (const bf16_t*)(ws + WS_Q3) + trow * 1024 + hh * 256;
    bf16_t* Zp = (bf16_t*)(ws + WS_Z3) + trow * 1024 + hh * 256;
    const bf16_t* Kp = (const bf16_t*)(ws + WS_MKV) + (size_t)b * 256 * 2048 + hh * 256;
    const bf16_t* Vp = Kp + 1024;
    const unsigned ldsb = (unsigned)(size_t)lds;
#pragma unroll
    for (int i = 0; i < 16; ++i) { const int pp = tid + 512 * i, row = pp >> 5, ch = pp & 31; *(LAS u32x4*)(lds + row * AK_P + ch * 16) = *(const u32x4*)(Kp + (size_t)row * 2048 + ch * 8); }
    __syncthreads();
    bf16x8 pf[2][8]; float rs[2];
#pragma unroll
    for (int mb = 0; mb < 2; ++mb) {
        bf16x8 qf[8];
#pragma unroll
        for (int ks = 0; ks < 8; ++ks) qf[ks] = *(const bf16x8*)(Qp + (size_t)mb * 16 * 1024 + 32 * ks + 8 * g);
        f32x4 s[16];
#pragma unroll
        for (int nb = 0; nb < 16; ++nb) { s[nb] = (f32x4){0.f, 0.f, 0.f, 0.f};
#pragma unroll
            for (int ks = 0; ks < 8; ++ks) { const bf16x8 kf = *(const LAS bf16x8*)(lds + (16 * nb + r) * AK_P + (32 * ks + 8 * g) * 2); s[nb] = MFMA16(kf, qf[ks], s[nb]); } __builtin_amdgcn_sched_barrier(0); }
        float mx = -3.0e38f;
#pragma unroll
        for (int nb = 0; nb < 16; ++nb) mx = fmaxf(mx, fmaxf(fmaxf(s[nb][0], s[nb][1]), fmaxf(s[nb][2], s[nb][3])));
        mx = fmaxf(mx, __shfl_xor(mx, 16)); mx = fmaxf(mx, __shfl_xor(mx, 32));
        const float sc = 0.0625f * 1.4426950408889634f; float sum = 0.f;
#pragma unroll
        for (int nb = 0; nb < 16; ++nb)
#pragma unroll
            for (int j = 0; j < 4; ++j) { const float e = __builtin_amdgcn_exp2f((s[nb][j] - mx) * sc); s[nb][j] = e; sum += e; }
        sum += __shfl_xor(sum, 16); sum += __shfl_xor(sum, 32);
        rs[mb] = 1.0f / sum;
#pragma unroll
        for (int kk = 0; kk < 8; ++kk) { u32x4 t; t.x = cvt_pk_bf16(s[2 * kk][0], s[2 * kk][1]); t.y = cvt_pk_bf16(s[2 * kk][2], s[2 * kk][3]); t.z = cvt_pk_bf16(s[2 * kk + 1][0], s[2 * kk + 1][1]); t.w = cvt_pk_bf16(s[2 * kk + 1][2], s[2 * kk + 1][3]); pf[mb][kk] = __builtin_bit_cast(bf16x8, t); }
        __builtin_amdgcn_sched_barrier(0);
    }
    __syncthreads();
#pragma unroll
    for (int i = 0; i < 16; ++i) { const int pp = tid + 512 * i, row = pp >> 5, ch = pp & 31; *(LAS u32x4*)(lds + row * AV_P + ch * 16) = *(const u32x4*)(Vp + (size_t)row * 2048 + ch * 8); }
    __syncthreads();
#pragma unroll
    for (int VG = 0; VG < 4; ++VG) {
        unsigned vb = ldsb + (4 * g + q4) * AV_P + (4 * p4) * 2; asm volatile("" : "+v"(vb));
        bf16_t* zp = Zp + 64 * VG + 4 * g;
        u32x2 zl[2][4];
#pragma unroll
        for (int mb = 0; mb < 2; ++mb)
#pragma unroll
            for (int vq = 0; vq < 4; ++vq) zl[mb][vq] = *(const u32x2*)(zp + (size_t)mb * 16 * 1024 + 16 * vq);
        f32x4 o[2][4];
#pragma unroll
        for (int vq = 0; vq < 4; ++vq) { o[0][vq] = (f32x4){0.f, 0.f, 0.f, 0.f}; o[1][vq] = (f32x4){0.f, 0.f, 0.f, 0.f};
#pragma unroll
            for (int kh = 0; kh < 2; ++kh) {
                s16x4 t8[8]; const unsigned a0 = vb + (128 * kh) * AV_P + (64 * VG + 16 * vq) * 2;
                tr_read8(t8, a0, a0 + 16 * AV_P, a0 + 32 * AV_P, a0 + 48 * AV_P, a0 + 64 * AV_P, a0 + 80 * AV_P, a0 + 96 * AV_P, a0 + 112 * AV_P);
#pragma unroll
                for (int k2 = 0; k2 < 4; ++k2) { const bf16x8 vfr = __builtin_shufflevector(t8[2 * k2], t8[2 * k2 + 1], 0, 1, 2, 3, 4, 5, 6, 7);
                    o[0][vq] = MFMA16(vfr, pf[0][4 * kh + k2], o[0][vq]); o[1][vq] = MFMA16(vfr, pf[1][4 * kh + k2], o[1][vq]); }
            } }
#pragma unroll
        for (int mb = 0; mb < 2; ++mb)
#pragma unroll
            for (int vq = 0; vq < 4; ++vq) {
                const u32x2 zz = zl[mb][vq]; const f32x4 ov = o[mb][vq];
                const float y0 = ov[0] * rs[mb] * siluf_(bflo(zz.x)), y1 = ov[1] * rs[mb] * siluf_(bfhi(zz.x)), y2 = ov[2] * rs[mb] * siluf_(bflo(zz.y)), y3 = ov[3] * rs[mb] * siluf_(bfhi(zz.y));
                unsigned st = 0u; st = __builtin_amdgcn_cvt_pk_fp8_f32(y0 * 16.f, y1 * 16.f, st, false); st = __builtin_amdgcn_cvt_pk_fp8_f32(y2 * 16.f, y3 * 16.f, st, true);
                *(unsigned*)((unsigned char*)P.out + DO_XA8 + (trow + 16 * mb) * 1024 + hh * 256 + 64 * VG + 4 * g + 16 * vq) = st;
            }
    }
    __syncthreads();
}

#define XB_TMO      128
#define XB_XCNT(j)  (256  + 64 * (j))
#define XB_XSUB(j)  (1280 + 64 * (j))
#define XB_XGEN(j)  (2304 + 64 * (j))
#define XB_TOP      3328
#define XB_TOPGEN   3392
#define XCD_BAR_WORDS 3456
#define XB_SPIN_CAP (1u << 18)
DI unsigned xb_ld(unsigned* p)              { return __hip_atomic_load(p, __ATOMIC_RELAXED, __HIP_MEMORY_SCOPE_AGENT); }
DI unsigned xb_add(unsigned* p, unsigned v) { return __hip_atomic_fetch_add(p, v, __ATOMIC_RELAXED, __HIP_MEMORY_SCOPE_AGENT); }
DI unsigned xb_xcc_id() { return (unsigned)__builtin_amdgcn_s_getreg((3 << 11) | 20) & 0xFu; }
#define XB_SPIN(cond, bar) do { unsigned _sp = 0; while (cond) { __builtin_amdgcn_s_sleep(1); \
    if ((++_sp & 255u) == 0u) { if (xb_ld(&(bar)[XB_TMO])) break; if (_sp > XB_SPIN_CAP) { atomicAdd(&(bar)[XB_TMO], 1u); break; } } } } while (0)
struct XcdBarrier { unsigned* bar; unsigned x; volatile LAS unsigned* st; };
DI XcdBarrier xcd_barrier_post(unsigned* bar, volatile LAS unsigned* st) {
    XcdBarrier b; b.bar = bar; b.x = xb_xcc_id(); b.st = st;
    if (threadIdx.x == 0) (void)xb_add(&bar[XB_XCNT(b.x)], 1u);
    return b;
}
DI void xcd_barrier_complete(unsigned* bar, unsigned x, unsigned& nloc, unsigned& nx) {
    const unsigned G = gridDim.x * gridDim.y * gridDim.z;
    unsigned sum, cnt, mine, sp = 0u;
    for (;;) {
        sum = 0u; cnt = 0u; mine = 0u;
#pragma unroll
        for (unsigned j = 0; j < 16; ++j) { const unsigned c = xb_ld(&bar[XB_XCNT(j)]); sum += c; cnt += (c > 0u) ? 1u : 0u; mine = (j == x) ? c : mine; }
        if (sum == G) break;
        __builtin_amdgcn_s_sleep(1);
        if ((++sp & 255u) == 0u) { if (xb_ld(&bar[XB_TMO])) break; if (sp > XB_SPIN_CAP) { atomicAdd(&bar[XB_TMO], 1u); break; } }
    }
    nloc = mine > 0u ? mine : 1u; nx = cnt > 0u ? cnt : 1u;
}
DI void xcd_barrier(const XcdBarrier& b) {
    asm volatile("s_waitcnt vmcnt(0)" ::: "memory");
    __syncthreads();
    if (threadIdx.x == 0) {
        unsigned* bar = b.bar;
        __builtin_amdgcn_s_waitcnt(0);
        unsigned nloc = b.st[0], nx = b.st[1];
        if (nloc == 0u) { xcd_barrier_complete(bar, b.x, nloc, nx); b.st[0] = nloc; b.st[1] = nx; }
        const unsigned old = xb_add(&bar[XB_XSUB(b.x)], 1u);
        const unsigned gen = old / nloc;
        if (old + 1u == (gen + 1u) * nloc) {
            __builtin_amdgcn_fence(__ATOMIC_RELEASE, "agent");
            asm volatile("s_waitcnt vmcnt(0)" ::: "memory");
            const unsigned og = xb_add(&bar[XB_TOP], 1u);
            const unsigned tg = og / nx;
            if (og + 1u == (tg + 1u) * nx) xb_add(&bar[XB_TOPGEN], 1u);
            else XB_SPIN(xb_ld(&bar[XB_TOPGEN]) == tg, bar);
            __builtin_amdgcn_fence(__ATOMIC_ACQUIRE, "agent");
            xb_add(&bar[XB_XGEN(b.x)], 1u);
            asm volatile("s_waitcnt vmcnt(0)" ::: "memory");
        } else {
            XB_SPIN(xb_ld(&bar[XB_XGEN(b.x)]) == gen, bar);
            __builtin_amdgcn_fence(__ATOMIC_ACQUIRE, "agent");
            asm volatile("s_waitcnt vmcnt(0)" ::: "memory");
        }
    }
    __syncthreads();
}

__global__ void __launch_bounds__(512) fwd_megakernel(Params P) {
    extern __shared__ __attribute__((aligned(16))) unsigned char smem[];
    LAS unsigned char* lds = (LAS unsigned char*)smem;
    cg::grid_group grid = cg::this_grid();
    unsigned char* ws = P.ws;
    const int G = gridDim.x, bx = blockIdx.x, tid = threadIdx.x;
    bf16_t* H = (bf16_t*)((unsigned char*)P.out + DO_H);

    if (tid < 4) ((LAS unsigned*)(lds + LDS_BYTES - 32))[tid] = 0u;
    __syncthreads();
#ifndef NO_P0
    p0_prologue(P, lds);
#endif
    grid.sync();
    const XcdBarrier xb = xcd_barrier_post((unsigned*)(ws + WS_BAR), (volatile LAS unsigned*)(lds + LDS_BYTES - 32));
    {
        { pg8::Gemm g{H, (const bf16_t*)(ws + WS_WIN), 2048}; pg8::Order S; S.init(128, NT_P1 - 14, G, bx, 0, 64, 128, PN_KV); S.skip_lo = 24; S.skip_n = 10; S.skip2_lo = 46; S.skip2_n = 4;
          pg8::EpiProj E{ws, (const float*)(ws + WS_BIAS), 1 << 20, 0};
          pg8::gemm_phase(lds, g, S, E); }
        { pg8::Gemm g{(const bf16_t*)(ws + WS_H8), (const bf16_t*)((unsigned char*)P.out + DO_WO8 - (size_t)24 * 256 * 2048), 1024}; pg8::Order S; S.init(128, 14, G, bx, 24);
          pg8::EpiProj E{ws, (const float*)(ws + WS_BIAS), 34, 12};
          pg8::gemm_phase<true>(lds, g, S, E); }
    }
    xcd_barrier(xb);
#ifndef NO_P2
    p2_prep(P, lds);
#endif
    xcd_barrier(xb);
    {
#ifndef NO_SCAN
        for (int it = bx; it < 96; it += G) scan_item(P, lds, it);
#endif
        if (bx >= 96 && G > 96) {
            pg8::Gemm g{(const bf16_t*)(ws + WS_H8), (const bf16_t*)((unsigned char*)P.out + DO_WG8), 1024}; pg8::Order S; S.init(128, 8, G - 96, bx - 96, 0);
            pg8::EpiGate E{ws, (const float*)(ws + WS_BIAS)};
            pg8::gemm_phase<true>(lds, g, S, E);
        }
        LAS unsigned* slot = (LAS unsigned*)(lds + LDS_BYTES - 16);
        for (;;) {
            if (tid == 0) *slot = atomicAdd((unsigned*)(ws + WS_CTL), 1u);
            __syncthreads();
            const unsigned u = *slot;
            __syncthreads();
            if (u >= 512u) break;
#ifndef NO_ATTN
            attn_unit(P, lds, (int)u);
#endif
        }
    }
    xcd_barrier(xb);
#ifndef NO_P2
    p3b_gate(P);
#endif
    xcd_barrier(xb);
    {
        pg8::Gemm g{(const bf16_t*)(ws + WS_H8), (const bf16_t*)((unsigned char*)P.out + DO_WG8), 1024}; pg8::Order S; S.init(128, 16, G, bx, 8);
        pg8::EpiGate E{ws, (const float*)(ws + WS_BIAS)};
        pg8::gemm_phase<true>(lds, g, S, E);
    }
    xcd_barrier(xb);
    {
        pg8::Order S; S.init(128, 8, G, bx, 0);
        { pg8::Gemm g{(const bf16_t*)(ws + WS_Z1), (const bf16_t*)(ws + WS_WML), 1536}; pg8::EpiMerge E{(bf16_t*)(ws + WS_MERGED), (const bf16_t*)(ws + WS_G0), 0}; pg8::gemm_phase(lds, g, S, E); }
        { pg8::Gemm g{(const bf16_t*)(ws + WS_Z2), (const bf16_t*)(ws + WS_WRET), 1536}; pg8::EpiMerge E{(bf16_t*)(ws + WS_MERGED), (const bf16_t*)(ws + WS_G12), 1}; pg8::gemm_phase(lds, g, S, E); }
        { pg8::Gemm g{(const bf16_t*)((unsigned char*)P.out + DO_XA8), (const bf16_t*)((unsigned char*)P.out + DO_WX8), 512, 0, 0x7B7B7B7B}; pg8::EpiMerge E{(bf16_t*)(ws + WS_MERGED), (const bf16_t*)(ws + WS_G12 + SZ20), 2}; pg8::gemm_phase<true>(lds, g, S, E); }
    }
    xcd_barrier(xb);
    {
        pg8::Gemm g{(const bf16_t*)(ws + WS_MERGED), (const bf16_t*)(ws + WS_WOUT), 2048}; pg8::Order S; S.init(128, 8, G, bx, 0);
        pg8::EpiOut E{(bf16_t*)(ws + WS_G0)};
        pg8::gemm_phase(lds, g, S, E);
    }
    xcd_barrier(xb);
    {
        const bf16_t* D = (const bf16_t*)(ws + WS_G0); const int lane = tid & 63, wave = tid >> 6;
        f32x4 gg[8];
#pragma unroll
        for (int i = 0; i < 8; ++i) gg[i] = *(const f32x4*)(P.fin_g + 4 * (lane + 64 * i));
        for (int row = bx * 16 + wave * 2; row < T; row += G * 16) {
            const float* x0 = P.x + (size_t)row * 2048; const float* x1 = x0 + 2048; const bf16_t* d0 = D + (size_t)row * 2048; const bf16_t* d1 = d0 + 2048;
            float* o0 = P.out + (size_t)row * 2048; float* o1 = o0 + 2048;
            f32x4 a[8], b[8]; u32x2 da[8], db[8];
#pragma unroll
            for (int i = 0; i < 8; ++i) { a[i] = *(const f32x4*)(x0 + 4 * (lane + 64 * i)); b[i] = *(const f32x4*)(x1 + 4 * (lane + 64 * i)); da[i] = *(const u32x2*)(d0 + 4 * (lane + 64 * i)); db[i] = *(const u32x2*)(d1 + 4 * (lane + 64 * i)); }
            float s0 = 0.f, s1 = 0.f;
#pragma unroll
            for (int i = 0; i < 8; ++i) {
                a[i] += (f32x4){bflo(da[i].x), bfhi(da[i].x), bflo(da[i].y), bfhi(da[i].y)}; b[i] += (f32x4){bflo(db[i].x), bfhi(db[i].x), bflo(db[i].y), bfhi(db[i].y)};
                s0 += a[i][0] * a[i][0] + a[i][1] * a[i][1] + a[i][2] * a[i][2] + a[i][3] * a[i][3]; s1 += b[i][0] * b[i][0] + b[i][1] * b[i][1] + b[i][2] * b[i][2] + b[i][3] * b[i][3]; }
            s0 = wave_sum(s0); s1 = wave_sum(s1);
            const float c0 = rsqrtf(s0 * (1.0f / 2048.0f) + EPS), c1 = rsqrtf(s1 * (1.0f / 2048.0f) + EPS);
#pragma unroll
            for (int i = 0; i < 8; ++i) { *(f32x4*)(o0 + 4 * (lane + 64 * i)) = a[i] * c0 * gg[i]; *(f32x4*)(o1 + 4 * (lane + 64 * i)) = b[i] * c1 * gg[i]; }
        }
    }
}

extern "C" void kernel_launch(void* const* d_in, const int* in_sizes, int n_in, void* d_out, int out_size, void* d_ws, size_t ws_size, hipStream_t stream) {
    static int grid = 0;
    if (grid == 0) {
        if (n_in != 17 || out_size != T * DM || ws_size < WS_END) { fprintf(stderr, "kernel_launch: unexpected shapes / workspace (%d inputs, out %d, ws %zu, need %zu)\n", n_in, out_size, ws_size, (size_t)WS_END); grid = -1; return; }
        int dev = 0, cus = 0, per_cu = 0;
        hipGetDevice(&dev); hipDeviceGetAttribute(&cus, hipDeviceAttributeMultiprocessorCount, dev);
        if (hipFuncSetAttribute((const void*)fwd_megakernel, hipFuncAttributeMaxDynamicSharedMemorySize, LDS_BYTES) != hipSuccess) { fprintf(stderr, "kernel_launch: hipFuncSetAttribute failed\n"); grid = -1; return; }
        if (hipOccupancyMaxActiveBlocksPerMultiprocessor(&per_cu, (const void*)fwd_megakernel, 512, LDS_BYTES) != hipSuccess || per_cu < 1) { fprintf(stderr, "kernel_launch: occupancy query gave %d\n", per_cu); per_cu = 1; }
        (void)hipGetLastError();
        grid = cus * 1;
    }
    if (grid < 0) return;
    Params p{};
    p.x = (const float*)d_in[0]; p.mem = (const float*)d_in[1]; p.pos = (const int*)d_in[2]; p.ln_g = (const float*)d_in[3]; p.mem_ln_g = (const float*)d_in[4];
    p.w_in = (const float*)d_in[5]; p.b_in = (const float*)d_in[6]; p.conv_w = (const float*)d_in[7]; p.conv_b = (const float*)d_in[8]; p.ml_g = (const float*)d_in[9];
    p.ret_g = (const float*)d_in[10]; p.w_kv = (const float*)d_in[11]; p.w_ml = (const float*)d_in[12]; p.w_ret = (const float*)d_in[13]; p.w_xa = (const float*)d_in[14];
    p.w_out = (const float*)d_in[15]; p.fin_g = (const float*)d_in[16]; p.out = (float*)d_out; p.ws = (unsigned char*)d_ws;
    void* args[] = {&p};
    hipError_t e = hipLaunchCooperativeKernel((const void*)fwd_megakernel, dim3(grid), dim3(512), args, LDS_BYTES, stream);
    if (e != hipSuccess) fprintf(stderr, "cooperative launch failed: %s (grid %d)\n", hipGetErrorString(e), grid);
}
```

```cpp
#include <hip/hip_runtime.h>
#include <hip/hip_cooperative_groups.h>
#include <cstdint>
#include <cstdio>
namespace cg = cooperative_groups;

#define LAS __attribute__((address_space(3)))
typedef unsigned short bf16_t;
typedef short bf16x8 __attribute__((ext_vector_type(8)));
typedef short s16x4 __attribute__((ext_vector_type(4)));
typedef float f32x4 __attribute__((ext_vector_type(4)));
typedef float f32x2 __attribute__((ext_vector_type(2)));
typedef unsigned u32x4 __attribute__((ext_vector_type(4)));
typedef unsigned u32x2 __attribute__((ext_vector_type(2)));
typedef int i32x4 __attribute__((ext_vector_type(4)));
typedef int i32x8 __attribute__((ext_vector_type(8)));
#define DI __device__ __forceinline__

constexpr int T = 32768, DM = 2048, SEQ = 4096, NB = 8;
constexpr int N_IN = 18956, NPAD = 19200;
constexpr int NT_P1 = 51;
constexpr int PN_GATE = 51;
constexpr int PN_KV = 75;
constexpr float EPS = 1e-6f;
constexpr int LDS_BYTES = 156 * 1024;

constexpr size_t WS_CTL = 0;
constexpr size_t WS_BAR = 4096;
constexpr size_t WS_SS = WS_BAR + 16384;
constexpr size_t WS_BIAS = WS_SS + (size_t)T * 4;
constexpr size_t WS_IF = WS_BIAS + 81920;
constexpr size_t WS_GS = WS_IF + (size_t)T * 16 * 4;
constexpr size_t GS_ARR = (size_t)48 * 4096;
constexpr size_t WS_GDEC = WS_GS + 5 * GS_ARR * 4;
constexpr size_t WS_RV = WS_GDEC + 48 * 64 * 4;
constexpr size_t WS_WIN = WS_RV + 16384;
constexpr size_t WS_WKV = WS_WIN + (size_t)NPAD * DM * 2;
constexpr size_t WS_WML = WS_WKV + (size_t)2048 * 2048 * 2;
constexpr size_t WS_WRET = WS_WML + (size_t)2048 * 1536 * 2;
constexpr size_t WS_WXA = WS_WRET + (size_t)2048 * 1536 * 2;
constexpr size_t WS_WOUT = WS_WXA + (size_t)2048 * 1024 * 2;
constexpr size_t WS_MKV = WS_WOUT + (size_t)2048 * 2048 * 2;
constexpr size_t WS_BIG = WS_MKV + (size_t)2048 * 2048 * 2;
constexpr size_t SZ15 = (size_t)T * 1536 * 2, SZ10 = (size_t)T * 1024 * 2;
constexpr size_t SZ20 = (size_t)T * 2048 * 2;
constexpr size_t WS_V1 = WS_BIG, WS_QK2 = WS_V1 + SZ15, WS_V2 = WS_QK2 + SZ15;
constexpr size_t WS_O1 = WS_V2 + SZ15, WS_Q3 = WS_O1 + SZ15;
constexpr size_t WS_Z1 = WS_Q3 + SZ10, WS_Z2 = WS_Z1 + SZ15, WS_Z3 = WS_Z2 + SZ15;
constexpr size_t WS_QK1 = WS_Z3 + SZ10;
constexpr size_t WS_H8 = WS_QK1 + SZ20;
constexpr size_t WS_END = WS_H8 + (size_t)T * DM;
constexpr size_t WS_G0 = WS_QK1, WS_G12 = WS_V1, WS_MERGED = WS_O1;
static_assert(2 * SZ20 <= 3 * SZ15 && SZ20 <= SZ15 + SZ10, "overlays");
constexpr size_t DO_H = 0, DO_MN = (size_t)T * DM * 2, DO_QKC = DO_MN + (size_t)2048 * 2048 * 2;
constexpr size_t DO_WG8 = DO_QKC + (size_t)T * 1536 * 2;
constexpr size_t DO_WO8 = DO_WG8 + (size_t)6144 * 2048;
constexpr size_t DO_WX8 = DO_WO8 + (size_t)5120 * 2048;
static_assert(DO_WX8 + (size_t)2048 * 1024 <= (size_t)T * DM * 4, "d_out scratch");
constexpr size_t DO_XA8 = DO_H;

struct Params {
    const float* x; const float* mem; const int* pos; const float* ln_g; const float* mem_ln_g; const float* w_in; const float* b_in;
    const float* conv_w; const float* conv_b; const float* ml_g; const float* ret_g; const float* w_kv; const float* w_ml; const float* w_ret;
    const float* w_xa; const float* w_out; const float* fin_g; float* out; unsigned char* ws;
};

typedef __bf16 bf16v2_t __attribute__((ext_vector_type(2)));
DI unsigned cvt_pk_bf16(float lo, float hi) { const f32x2 v = {lo, hi}; const bf16v2_t r = __builtin_convertvector(v, bf16v2_t); return __builtin_bit_cast(unsigned, r); }
DI float bf2f(unsigned short b) { return __uint_as_float((unsigned)b << 16); }
DI float bflo(unsigned u) { return __uint_as_float(u << 16); }
DI float bfhi(unsigned u) { return __uint_as_float(u & 0xffff0000u); }
DI float sigmoidf_(float v) { return __builtin_amdgcn_rcpf(1.0f + __builtin_amdgcn_exp2f(-1.4426950408889634f * v)); }
DI float siluf_(float v) { return v * __builtin_amdgcn_rcpf(1.0f + __builtin_amdgcn_exp2f(-1.4426950408889634f * v)); }
#define LBAR() do { asm volatile("s_waitcnt lgkmcnt(0)" ::: "memory"); __builtin_amdgcn_s_barrier(); asm volatile("" ::: "memory"); } while (0)
DI float wave_sum(float v) { for (int o = 32; o > 0; o >>= 1) v += __shfl_xor(v, o); return v; }
DI s16x4 tr_read(unsigned lds_addr) { s16x4 r; asm volatile("ds_read_b64_tr_b16 %0, %1\n\ts_waitcnt lgkmcnt(0)" : "=&v"(r) : "v"(lds_addr) : "memory"); return r; }
DI void tr_read8(s16x4 (&o)[8], unsigned a0, unsigned a1, unsigned a2, unsigned a3, unsigned a4, unsigned a5, unsigned a6, unsigned a7) {
    asm volatile("ds_read_b64_tr_b16 %0, %8\n\tds_read_b64_tr_b16 %1, %9\n\tds_read_b64_tr_b16 %2, %10\n\tds_read_b64_tr_b16 %3, %11\n\tds_read_b64_tr_b16 %4, %12\n\tds_read_b64_tr_b16 %5, %13\n\tds_read_b64_tr_b16 %6, %14\n\tds_read_b64_tr_b16 %7, %15\n\ts_waitcnt lgkmcnt(0)"
                 : "=&v"(o[0]), "=&v"(o[1]), "=&v"(o[2]), "=&v"(o[3]), "=&v"(o[4]), "=&v"(o[5]), "=&v"(o[6]), "=&v"(o[7])
                 : "v"(a0), "v"(a1), "v"(a2), "v"(a3), "v"(a4), "v"(a5), "v"(a6), "v"(a7) : "memory");
}
DI unsigned pack_i8x4(float a, float b, float c, float d, float s) {
    const int i0 = (int)rintf(fminf(fmaxf(a * s, -127.f), 127.f)), i1 = (int)rintf(fminf(fmaxf(b * s, -127.f), 127.f)), i2 = (int)rintf(fminf(fmaxf(c * s, -127.f), 127.f)), i3 = (int)rintf(fminf(fmaxf(d * s, -127.f), 127.f));
    return (unsigned)(i0 & 255) | ((unsigned)(i1 & 255) << 8) | ((unsigned)(i2 & 255) << 16) | ((unsigned)i3 << 24);
}
DI f32x4 deq_acc(f32x4 a, float qs) {
    if (qs == 0.f) return a;
    f32x4 r; r[0] = (float)__float_as_int(a[0]) * qs; r[1] = (float)__float_as_int(a[1]) * qs; r[2] = (float)__float_as_int(a[2]) * qs; r[3] = (float)__float_as_int(a[3]) * qs; return r;
}
constexpr float H8_SCALE = 16.f, W8_SCALE = 1024.f, Q8_DEQ = 1.0f / (16.f * 1024.f);
DI int opaque_tid() { int t = threadIdx.x; asm volatile("" : "+v"(t)); return t; }
#define MFMA16(a, b, c) __builtin_amdgcn_mfma_f32_16x16x32_bf16((a), (b), (c), 0, 0, 0)

namespace pg8 {
constexpr int BM = 256, BK = 64, HALF = 128, HTB = HALF * BK * 2, STAGE_BYTES = 8 * HTB, NXCD = 8, WGM = 8;
DI int lds_byte(int r, int c) { const int st = (r >> 4) * 2 + (c >> 5), rr = r & 15, cc = c & 31, ob = rr * 64 + cc * 2; return st * 1024 + (ob ^ (((ob >> 9) & 1) << 5)); }
DI void stage_rc(int b, int& R, int& C) { const int st = b / 1024, sb = b % 1024, swz = sb ^ (((sb >> 9) & 1) << 5); R = (st >> 1) * 16 + swz / 64; C = (st & 1) * 32 + (swz % 64) / 2; }
DI int perm32(int rho) { const int n = rho >> 4, i = rho & 15; return 8 * (i >> 2) + 4 * n + (i & 3); }
struct Unit { int pm, pn; };
struct Gemm { const bf16_t* A; const bf16_t* Bt; int K; int ntile = 0; int sca = 0x7F7F7F7F; };
struct Order {
    int nM, nN, nwg, G, c, pn_off, extra, pm0x, pn0x, skip_lo, skip_n, skip2_lo, skip2_n;
    DI void init(int nM_, int nN_, int G_, int c_, int pn_off_, int extra_ = 0, int pm0x_ = 0, int pn0x_ = 0) { nM = nM_; nN = nN_; nwg = nM * nN; G = G_; c = c_; pn_off = pn_off_; extra = extra_; pm0x = pm0x_; pn0x = pn0x_; skip_lo = 0; skip_n = 0; skip2_lo = 0; skip2_n = 0; }
    DI bool next(int i, Unit& u) const {
        long L = (long)i * G + c;
        if (L < nwg) {
            int wgid = (int)L; { const int q = nwg / NXCD, r = nwg % NXCD, xcd = wgid % NXCD, off = wgid / NXCD; wgid = (xcd < r ? xcd * (q + 1) : r * (q + 1) + (xcd - r) * q) + off; }
            const int nig = WGM * nN, gid = wgid / nig, fm = gid * WGM, gsz = (nM - fm) < WGM ? (nM - fm) : WGM;
            u.pm = fm + ((wgid % nig) % gsz); u.pn = pn_off + (wgid % nig) / gsz; if (skip_n && u.pn >= skip_lo) u.pn += skip_n; if (skip2_n && u.pn >= skip2_lo) u.pn += skip2_n; return true;
        }
        L -= nwg; if (L >= extra) return false;
        u.pm = pm0x + (int)(L >> 3); u.pn = pn0x + (int)(L & 7); return true;
    }
};

template <int MODE = 0, class Epi>
DI void gemm_phase(LAS unsigned char* lds, const Gemm g, const Order& S, const Epi& E) {
    constexpr bool FP8 = (MODE == 1);
    const int tid = opaque_tid(), wid = __builtin_amdgcn_readfirstlane(tid >> 6), lane = tid & 63, wr = wid >> 2, wc = wid & 3, fr = lane & 15, fq = lane >> 4;
    const int K = g.K, nt = g.ntile ? g.ntile : K / BK;
    unsigned voffA[2], voffB[2];
#pragma unroll
    for (int i = 0; i < 2; ++i) { int R, C; stage_rc(tid * 16 + i * 8192, R, C); const int Rb = (R & ~31) + perm32(R & 31);
        voffA[i] = (unsigned)(R * K + C) * 2u; voffB[i] = (unsigned)(Rb * K + C) * 2u; }
    const size_t kstep = (size_t)(BK * 2);
    const size_t hstep = (size_t)HALF * K * 2;
    const size_t tstep = 2 * hstep;
    const unsigned ldsw = (unsigned)wid * 1024u;
    const int aoff = lds_byte(wr * 64 + fr, fq * 8), boff = lds_byte(wc * 32 + fr, fq * 8);
#define PG8_SA(b, h) (((b) * 2 + (h)) * HTB)
#define PG8_SB(b, h) ((4 + (b) * 2 + (h)) * HTB)
#define PG8_STAGE(bufoff, gbase, voff) do { _Pragma("unroll") for (int _i = 0; _i < 2; ++_i) \
        __builtin_amdgcn_global_load_lds((const unsigned*)((const char*)(gbase) + (voff)[_i]), (LAS unsigned*)(lds + (bufoff) + ldsw + _i * 8192), 16, 0, 0); } while (0)
#define PG8_LD16(off) (*(const LAS i32x4*)(lds + (off)))
#define PG8_LDA(dst, b, h) do { if constexpr (FP8) { _Pragma("unroll") for (int m = 0; m < 4; ++m) dst##8[m] = __builtin_shufflevector(PG8_LD16(PG8_SA(b, h) + aoff + m * 2048), PG8_LD16(PG8_SA(b, h) + aoff + m * 2048 + 1024), 0, 1, 2, 3, 4, 5, 6, 7); } \
        else { _Pragma("unroll") for (int m = 0; m < 4; ++m) _Pragma("unroll") for (int k = 0; k < 2; ++k) dst[m][k] = *(const LAS bf16x8*)(lds + PG8_SA(b, h) + aoff + m * 2048 + k * 1024); } } while (0)
#define PG8_LDB(dst, b, h) do { if constexpr (FP8) { _Pragma("unroll") for (int n = 0; n < 2; ++n) dst##8[n] = __builtin_shufflevector(PG8_LD16(PG8_SB(b, h) + boff + n * 2048), PG8_LD16(PG8_SB(b, h) + boff + n * 2048 + 1024), 0, 1, 2, 3, 4, 5, 6, 7); } \
        else { _Pragma("unroll") for (int n = 0; n < 2; ++n) _Pragma("unroll") for (int k = 0; k < 2; ++k) dst[n][k] = *(const LAS bf16x8*)(lds + PG8_SB(b, h) + boff + n * 2048 + k * 1024); } } while (0)
#define PG8_MMA(ai, bj, At, Bt) do { __builtin_amdgcn_s_setprio(1); \
        if constexpr (FP8) { _Pragma("unroll") for (int m = 0; m < 4; ++m) _Pragma("unroll") for (int n = 0; n < 2; ++n) \
            asm volatile("v_mfma_scale_f32_16x16x128_f8f6f4 %0, %1, %2, %0, %3, %4 op_sel_hi:[0,0,0]" : "+v"(acc[ai][bj][m][n]) : "v"(Bt##8[n]), "v"(At##8[m]), "v"(sc_w), "v"(sc_1)); } \
        else if constexpr (MODE == 2) { _Pragma("unroll") for (int m = 0; m < 4; ++m) _Pragma("unroll") for (int n = 0; n < 2; ++n) _Pragma("unroll") for (int k = 0; k < 2; ++k) \
            acc[ai][bj][m][n] = __builtin_bit_cast(f32x4, __builtin_amdgcn_mfma_i32_16x16x64_i8(__builtin_bit_cast(i32x4, Bt[n][k]), __builtin_bit_cast(i32x4, At[m][k]), __builtin_bit_cast(i32x4, acc[ai][bj][m][n]), 0, 0, 0)); } \
        else { _Pragma("unroll") for (int m = 0; m < 4; ++m) _Pragma("unroll") for (int n = 0; n < 2; ++n) _Pragma("unroll") for (int k = 0; k < 2; ++k) \
            acc[ai][bj][m][n] = __builtin_amdgcn_mfma_f32_16x16x32_bf16(Bt[n][k], At[m][k], acc[ai][bj][m][n], 0, 0, 0); } \
        __builtin_amdgcn_s_setprio(0); } while (0)
#define PG8_WAIT_V(n) asm volatile("s_waitcnt vmcnt(" #n ")" ::: "memory")
#define PG8_WAIT_L(n) asm volatile("s_waitcnt lgkmcnt(" #n ")" ::: "memory")
#define PG8_BAR __builtin_amdgcn_s_barrier()
#define PG8_SCHED __builtin_amdgcn_sched_barrier(0)
    Unit cur, nxt; int ui = 0;
    if (!S.next(0, cur)) return;
    f32x4 acc[2][2][4][2];
#pragma unroll
    for (int a = 0; a < 2; ++a)
#pragma unroll
        for (int b = 0; b < 2; ++b)
#pragma unroll
            for (int m = 0; m < 4; ++m)
#pragma unroll
                for (int n = 0; n < 2; ++n) acc[a][b][m][n] = (f32x4){0.f, 0.f, 0.f, 0.f};
    bf16x8 At[4][2], B0[2][2], B1[2][2];
    const int sc_w = 0x79797979, sc_1 = g.sca;
    i32x8 At8[4], B08[2], B18[2];
    const char* cA = (const char*)g.A + (size_t)cur.pm * tstep; const char* cB = (const char*)g.Bt + (size_t)cur.pn * tstep;
    PG8_STAGE(PG8_SB(0, 0), cB, voffB); PG8_STAGE(PG8_SB(0, 1), cB + hstep, voffB); PG8_STAGE(PG8_SA(0, 0), cA, voffA); PG8_STAGE(PG8_SA(0, 1), cA + hstep, voffA);
    if (wr == 1) PG8_BAR;
    PG8_WAIT_V(2); PG8_BAR;
    PG8_STAGE(PG8_SB(1, 0), cB + kstep, voffB); PG8_STAGE(PG8_SA(1, 0), cA + kstep, voffA); PG8_STAGE(PG8_SB(1, 1), cB + hstep + kstep, voffB);
    PG8_WAIT_V(6); PG8_BAR;
    for (;;) {
        const bool has_next = S.next(ui + 1, nxt);
        const char* nA = has_next ? (const char*)g.A + (size_t)nxt.pm * tstep : cA; const char* nB = has_next ? (const char*)g.Bt + (size_t)nxt.pn * tstep : cB;
        for (int t = 0; t < nt; t += 2) {
            const bool last = (t == nt - 2);
            const char* a1 = cA + (size_t)(t + 1) * kstep;
            const char* a2 = last ? nA : cA + (size_t)(t + 2) * kstep; const char* b2 = last ? nB : cB + (size_t)(t + 2) * kstep;
            const char* a3 = a2 + kstep; const char* b3 = b2 + kstep;
            PG8_LDB(B0, 0, 0); PG8_LDB(B1, 0, 1); PG8_SCHED; PG8_LDA(At, 0, 0); PG8_STAGE(PG8_SA(1, 1), a1 + hstep, voffA);
            PG8_WAIT_V(8); PG8_WAIT_L(0); PG8_BAR; PG8_MMA(0, 0, At, B0); PG8_MMA(0, 1, At, B1); PG8_BAR; PG8_SCHED;
            PG8_LDA(At, 0, 1); PG8_STAGE(PG8_SB(0, 0), b2, voffB); PG8_STAGE(PG8_SB(0, 1), b2 + hstep, voffB); PG8_STAGE(PG8_SA(0, 0), a2, voffA);
            PG8_WAIT_V(8); PG8_WAIT_L(0); PG8_BAR; PG8_MMA(1, 0, At, B0); PG8_MMA(1, 1, At, B1); PG8_BAR; PG8_SCHED;
            PG8_LDB(B0, 1, 0); PG8_LDB(B1, 1, 1); PG8_SCHED; PG8_LDA(At, 1, 0); PG8_STAGE(PG8_SA(0, 1), a2 + hstep, voffA);
            PG8_WAIT_V(8); PG8_WAIT_L(0); PG8_BAR; PG8_MMA(0, 0, At, B0); PG8_MMA(0, 1, At, B1); PG8_BAR; PG8_SCHED;
            PG8_LDA(At, 1, 1); PG8_STAGE(PG8_SB(1, 0), b3, voffB); PG8_STAGE(PG8_SB(1, 1), b3 + hstep, voffB); PG8_STAGE(PG8_SA(1, 0), a3, voffA);
            PG8_WAIT_V(8); PG8_WAIT_L(0); PG8_BAR; PG8_MMA(1, 0, At, B0); PG8_MMA(1, 1, At, B1); PG8_BAR; PG8_SCHED;
        }
        if (wr == 0) PG8_BAR;
        if constexpr (FP8) asm volatile("s_nop 15\n\ts_nop 15" ::: "memory");
        E(acc, cur, wr, wc, fr, fq);
        if (!has_next) break;
#pragma unroll
        for (int a = 0; a < 2; ++a)
#pragma unroll
            for (int b = 0; b < 2; ++b)
#pragma unroll
                for (int m = 0; m < 4; ++m)
#pragma unroll
                    for (int n = 0; n < 2; ++n) acc[a][b][m][n] = (f32x4){0.f, 0.f, 0.f, 0.f};
        cur = nxt; cA = nA; cB = nB; ++ui;
        if (wr == 1) PG8_BAR;
    }
    PG8_WAIT_V(0);
    PG8_BAR;
#undef PG8_SA
#undef PG8_SB
#undef PG8_STAGE
#undef PG8_LDA
#undef PG8_LD16
#undef PG8_LDB
#undef PG8_MMA
#undef PG8_WAIT_V
#undef PG8_WAIT_L
#undef PG8_BAR
#undef PG8_SCHED
}
typedef f32x4 Acc[2][2][4][2];

struct EpiProj {
    unsigned char* ws; const float* bias; int shift_lo, shift; float qs;
    DI void operator()(const Acc& acc, const Unit& u, int wr, int wc, int fr, int fq) const {
        int row0 = u.pm * BM + wr * 64 + fr; const int pn = u.pn >= shift_lo ? u.pn + shift : u.pn;
        bf16_t* base; int ldc, ct; const float* bp = bias + pn * BM;
        if (u.pm >= 128) { base = (bf16_t*)(ws + WS_MKV); ldc = 2048; ct = pn - PN_KV; row0 -= T; bp = nullptr; }
        else if (pn < 6) { base = (bf16_t*)(ws + WS_QK1); ldc = 1536; ct = pn; }
        else if (pn < 12) { base = (bf16_t*)(ws + WS_V1); ldc = 1536; ct = pn - 6; }
        else if (pn < 18) { base = (bf16_t*)(ws + WS_QK2); ldc = 1536; ct = pn - 12; }
        else if (pn < 24) { base = (bf16_t*)(ws + WS_V2); ldc = 1536; ct = pn - 18; }
        else if (pn < 30) { base = (bf16_t*)(ws + WS_O1); ldc = 1536; ct = pn - 24; }
        else if (pn < 34) { base = (bf16_t*)(ws + WS_Q3); ldc = 1024; ct = pn - 30; }
        else if (pn < 40) { base = (bf16_t*)(ws + WS_Z1); ldc = 1536; ct = pn - 34; }
        else if (pn < 46) { base = (bf16_t*)(ws + WS_Z2); ldc = 1536; ct = pn - 40; }
        else if (pn < 50) { base = (bf16_t*)(ws + WS_Z3); ldc = 1024; ct = pn - 46; }
        else {
            if (wc == 0 && fq < 2) {
                float* IFp = (float*)(ws + WS_IF);
                const f32x4 b0 = *(const f32x4*)(bp + 8 * fq), b1 = *(const f32x4*)(bp + 8 * fq + 4);
#pragma unroll
                for (int ai = 0; ai < 2; ++ai)
#pragma unroll
                    for (int m = 0; m < 4; ++m) { float* rp = IFp + (size_t)(row0 + ai * HALF + m * 16) * 16 + 8 * fq;
                        *(f32x4*)rp = acc[ai][0][m][0] + b0; *(f32x4*)(rp + 4) = acc[ai][0][m][1] + b1; }
            }
            return;
        }
        const int col0 = ct * BM + wc * 32 + 8 * fq, bc0 = wc * 32 + 8 * fq;
        f32x4 bv[2][2];
#pragma unroll
        for (int bj = 0; bj < 2; ++bj)
#pragma unroll
            for (int n = 0; n < 2; ++n) bv[bj][n] = bp ? *(const f32x4*)(bp + bc0 + bj * HALF + 4 * n) : (f32x4){0.f, 0.f, 0.f, 0.f};
#pragma unroll
        for (int ai = 0; ai < 2; ++ai)
#pragma unroll
            for (int m = 0; m < 4; ++m) { bf16_t* rowp = base + (size_t)(row0 + ai * HALF + m * 16) * ldc + col0;
#pragma unroll
                for (int bj = 0; bj < 2; ++bj) { const f32x4 v0 = deq_acc(acc[ai][bj][m][0], qs) + bv[bj][0], v1 = deq_acc(acc[ai][bj][m][1], qs) + bv[bj][1];
                    u32x4 w; w.x = cvt_pk_bf16(v0[0], v0[1]); w.y = cvt_pk_bf16(v0[2], v0[3]); w.z = cvt_pk_bf16(v1[0], v1[1]); w.w = cvt_pk_bf16(v1[2], v1[3]);
                    *(u32x4*)(rowp + bj * HALF) = w; } }
    }
};
struct EpiGate {
    unsigned char* ws; const float* bias; float qs;
    DI void operator()(const Acc& acc, const Unit& u, int wr, int wc, int fr, int fq) const {
        const int row0 = u.pm * BM + wr * 64 + fr; const float* bp = bias + (PN_GATE + u.pn) * BM + wc * 32 + 8 * fq;
        const int ct = u.pn, gi = ct >> 3; bf16_t* G = (bf16_t*)(ws + (gi == 0 ? WS_G0 : WS_G12 + (size_t)(gi - 1) * SZ20));
        const int col0 = (ct & 7) * BM + wc * 32 + 8 * fq;
        f32x4 bv[2][2];
#pragma unroll
        for (int bj = 0; bj < 2; ++bj)
#pragma unroll
            for (int n = 0; n < 2; ++n) bv[bj][n] = *(const f32x4*)(bp + bj * HALF + 4 * n);
#pragma unroll
        for (int ai = 0; ai < 2; ++ai)
#pragma unroll
            for (int m = 0; m < 4; ++m) { bf16_t* rowp = G + (size_t)(row0 + ai * HALF + m * 16) * 2048 + col0;
#pragma unroll
                for (int bj = 0; bj < 2; ++bj) { f32x4 v0 = deq_acc(acc[ai][bj][m][0], qs) + bv[bj][0], v1 = deq_acc(acc[ai][bj][m][1], qs) + bv[bj][1];
#pragma unroll
                    for (int e = 0; e < 4; ++e) { v0[e] = sigmoidf_(v0[e]); v1[e] = sigmoidf_(v1[e]); }
                    u32x4 w; w.x = cvt_pk_bf16(v0[0], v0[1]); w.y = cvt_pk_bf16(v0[2], v0[3]); w.z = cvt_pk_bf16(v1[0], v1[1]); w.w = cvt_pk_bf16(v1[2], v1[3]);
                    *(u32x4*)(rowp + bj * HALF) = w; } }
    }
};
struct EpiMerge {
    bf16_t* merged; const bf16_t* G; int gi;
    DI void operator()(const Acc& acc, const Unit& u, int wr, int wc, int fr, int fq) const {
        const int row0 = u.pm * BM + wr * 64 + fr, col0 = u.pn * BM + wc * 32 + 8 * fq;
#pragma unroll
        for (int ai = 0; ai < 2; ++ai)
#pragma unroll
            for (int m = 0; m < 4; ++m) { const size_t r = (size_t)(row0 + ai * HALF + m * 16);
#pragma unroll
                for (int bj = 0; bj < 2; ++bj) {
                    const u32x4 gv = *(const u32x4*)(G + r * 2048 + col0 + bj * HALF);
                    bf16_t* mp = merged + r * 2048 + col0 + bj * HALF;
                    const f32x4 a0 = acc[ai][bj][m][0], a1 = acc[ai][bj][m][1];
                    float o[8] = {a0[0] * bflo(gv.x), a0[1] * bfhi(gv.x), a0[2] * bflo(gv.y), a0[3] * bfhi(gv.y), a1[0] * bflo(gv.z), a1[1] * bfhi(gv.z), a1[2] * bflo(gv.w), a1[3] * bfhi(gv.w)};
                    if (gi > 0) { const u32x4 pv = __builtin_nontemporal_load((const u32x4*)mp);
                        o[0] += bflo(pv.x); o[1] += bfhi(pv.x); o[2] += bflo(pv.y); o[3] += bfhi(pv.y); o[4] += bflo(pv.z); o[5] += bfhi(pv.z); o[6] += bflo(pv.w); o[7] += bfhi(pv.w); }
                    u32x4 w; w.x = cvt_pk_bf16(o[0], o[1]); w.y = cvt_pk_bf16(o[2], o[3]); w.z = cvt_pk_bf16(o[4], o[5]); w.w = cvt_pk_bf16(o[6], o[7]);
                    *(u32x4*)mp = w; } }
    }
};
struct EpiOut {
    bf16_t* D;
    DI void operator()(const Acc& acc, const Unit& u, int wr, int wc, int fr, int fq) const {
        const int row0 = u.pm * BM + wr * 64 + fr, col0 = u.pn * BM + wc * 32 + 8 * fq;
#pragma unroll
        for (int ai = 0; ai < 2; ++ai)
#pragma unroll
            for (int m = 0; m < 4; ++m) { bf16_t* rowp = D + (size_t)(row0 + ai * HALF + m * 16) * 2048 + col0;
#pragma unroll
                for (int bj = 0; bj < 2; ++bj) { const f32x4 v0 = acc[ai][bj][m][0], v1 = acc[ai][bj][m][1];
                    u32x4 w; w.x = cvt_pk_bf16(v0[0], v0[1]); w.y = cvt_pk_bf16(v0[2], v0[3]); w.z = cvt_pk_bf16(v1[0], v1[1]); w.w = cvt_pk_bf16(v1[2], v1[3]);
                    *(u32x4*)(rowp + bj * HALF) = w; } }
    }
};
}

DI int src_col_of(int n) {
    if (n < 3072) return n;
    if (n < 4608) return n - 3072 + 6156;
    if (n < 6144) return n - 4608 + 7692;
    if (n < 7680) return n - 6144 + 3072;
    if (n < 8704) return n - 7680 + 10764;
    if (n < 10240) return n - 8704 + 4608;
    if (n < 11776) return n - 10240 + 9228;
    if (n < 12800) return n - 11776 + 11788;
    if (n < 12812) return n - 12800 + 6144;
    if (n < 13056) return -1;
    return n - 13056 + 12812;
}
struct TpItem { const float* W; bf16_t* WT; unsigned char* W8; int Nsrc, K, n0, k0, remap, n8, m8; };
DI bool tp_decode(const Params& P, int it, TpItem& t) {
    constexpr int I_IN = 300 * 8, I_KV = 32 * 8, I_ML = 32 * 6, I_RET = 32 * 6, I_XA = 32 * 4, I_OUT = 32 * 8;
    unsigned char* ws = P.ws; int r = it; t.remap = 0; t.W8 = nullptr; t.n8 = 0; t.m8 = 2;
    if (r < I_IN) { t.W = P.w_in; t.WT = (bf16_t*)(ws + WS_WIN); t.Nsrc = N_IN; t.K = 2048; t.n0 = (r >> 3) * 64; t.k0 = (r & 7) * 256; t.remap = 1;
        if (t.n0 >= 6144 && t.n0 < 10240) { t.W8 = (unsigned char*)P.out + DO_WO8; t.n8 = t.n0 - 6144; }
        else if (t.n0 >= 11776 && t.n0 < 12800) { t.W8 = (unsigned char*)P.out + DO_WO8; t.n8 = t.n0 - 11776 + 4096; }
        else if (t.n0 >= 13056) { t.W8 = (unsigned char*)P.out + DO_WG8; t.n8 = t.n0 - 13056; }
        return true; } r -= I_IN;
    if (r < I_KV) { t.W = P.w_kv; t.WT = (bf16_t*)(ws + WS_WKV); t.Nsrc = 2048; t.K = 2048; t.n0 = (r >> 3) * 64; t.k0 = (r & 7) * 256; return true; } r -= I_KV;
    if (r < I_ML) { t.W = P.w_ml; t.WT = (bf16_t*)(ws + WS_WML); t.Nsrc = 2048; t.K = 1536; t.n0 = (r / 6) * 64; t.k0 = (r % 6) * 256; return true; } r -= I_ML;
    if (r < I_RET) { t.W = P.w_ret; t.WT = (bf16_t*)(ws + WS_WRET); t.Nsrc = 2048; t.K = 1536; t.n0 = (r / 6) * 64; t.k0 = (r % 6) * 256; return true; } r -= I_RET;
    if (r < I_XA) { t.W = P.w_xa; t.WT = (bf16_t*)(ws + WS_WXA); t.Nsrc = 2048; t.K = 1024; t.n0 = (r >> 2) * 64; t.k0 = (r & 3) * 256; t.W8 = (unsigned char*)P.out + DO_WX8; t.n8 = t.n0; t.m8 = 1; return true; } r -= I_XA;
    if (r < I_OUT) { t.W = P.w_out; t.WT = (bf16_t*)(ws + WS_WOUT); t.Nsrc = 2048; t.K = 2048; t.n0 = (r >> 3) * 64; t.k0 = (r & 7) * 256; return true; }
    return false;
}
DI void tp_load(const TpItem& t, int tid, f32x4 (&v)[8]) {
    const int nq = tid & 15, kk0 = tid >> 4; const int src = t.remap ? src_col_of(t.n0 + 4 * nq) : (t.n0 + 4 * nq);
#pragma unroll
    for (int i = 0; i < 8; ++i) v[i] = src >= 0 ? *(const f32x4*)(t.W + (size_t)(t.k0 + kk0 + 32 * i) * t.Nsrc + src) : (f32x4){0.f, 0.f, 0.f, 0.f};
}
DI void p0_transposes(const Params& P, LAS unsigned char* lds) {
    const int tid = opaque_tid(), G = gridDim.x, bx = blockIdx.x, nq = tid & 15, kk0 = tid >> 4;
    LAS bf16_t* tile = (LAS bf16_t*)lds;
    TpItem cur, nxt; f32x4 v[8];
    int it = bx; bool have = tp_decode(P, it, cur);
    if (have) tp_load(cur, tid, v);
    while (have) {
        if (cur.W8) {
#pragma unroll
            for (int i = 0; i < 8; ++i) { const int kk = kk0 + 32 * i; unsigned q = 0u;
                if (cur.m8 == 2) q = pack_i8x4(v[i][0], v[i][1], v[i][2], v[i][3], W8_SCALE);
                else { q = __builtin_amdgcn_cvt_pk_fp8_f32(v[i][0] * 64.f, v[i][1] * 64.f, q, false); q = __builtin_amdgcn_cvt_pk_fp8_f32(v[i][2] * 64.f, v[i][3] * 64.f, q, true); }
#pragma unroll
                for (int e = 0; e < 4; ++e) *(LAS unsigned char*)(lds + (4 * nq + e) * 272 + kk) = (unsigned char)(q >> (8 * e)); }
        } else {
#pragma unroll
            for (int i = 0; i < 8; ++i) { const int kk = kk0 + 32 * i;
#pragma unroll
                for (int e = 0; e < 4; ++e) tile[(4 * nq + e) * 264 + kk] = (bf16_t)(cvt_pk_bf16(v[i][e], 0.f) & 0xffffu); }
        }
        __syncthreads();
        it += G; const bool hn = tp_decode(P, it, nxt);
        if (hn) tp_load(nxt, tid, v);
        if (cur.W8) {
#pragma unroll
            for (int j = 0; j < 2; ++j) { const int p = tid + 512 * j, n2 = p >> 4, kq = p & 15; const u32x4 tv = *(const LAS u32x4*)(lds + n2 * 272 + kq * 16); *(u32x4*)(cur.W8 + (size_t)(cur.n8 + n2) * cur.K + cur.k0 + 16 * kq) = tv; }
        } else {
#pragma unroll
            for (int j = 0; j < 4; ++j) { const int p = tid + 512 * j, n2 = p >> 5, kq = p & 31; const u32x4 tv = *(const LAS u32x4*)(lds + n2 * 528 + kq * 16); *(u32x4*)(cur.WT + (size_t)(cur.n0 + n2) * cur.K + cur.k0 + 8 * kq) = tv; }
        }
        __syncthreads();
        cur = nxt; have = hn;
    }
}
DI void rms_row(const float* xr, const float* g, bf16_t* o, unsigned char* o8, int lane) {
    f32x4 v[8]; float s = 0.f;
#pragma unroll
    for (int i = 0; i < 8; ++i) { v[i] = *(const f32x4*)(xr + 4 * (lane + 64 * i)); s += v[i][0] * v[i][0] + v[i][1] * v[i][1] + v[i][2] * v[i][2] + v[i][3] * v[i][3]; }
    s = wave_sum(s); const float sc = rsqrtf(s * (1.0f / 2048.0f) + EPS);
#pragma unroll
    for (int i = 0; i < 8; ++i) { const f32x4 gg = *(const f32x4*)(g + 4 * (lane + 64 * i)); const f32x4 y = v[i] * sc * gg;
        u32x2 w; w.x = cvt_pk_bf16(y[0], y[1]); w.y = cvt_pk_bf16(y[2], y[3]); *(u32x2*)(o + 4 * (lane + 64 * i)) = w;
        if (o8) *(unsigned*)(o8 + 4 * (lane + 64 * i)) = pack_i8x4(y[0], y[1], y[2], y[3], H8_SCALE); }
}
DI void p0_prologue(const Params& P, LAS unsigned char* lds) {
    const int tid = opaque_tid(), lane = tid & 63, wave = tid >> 6, G = gridDim.x, bx = blockIdx.x;
    unsigned char* ws = P.ws;
    if (bx == 0 && tid < 64) ((unsigned*)(ws + WS_CTL))[tid] = 0u;
    if (bx == 0) for (int i = tid; i < 3456; i += 512) ((unsigned*)(ws + WS_BAR))[i] = 0u;
    for (int i = bx * 512 + tid; i < T; i += G * 512) ((float*)(ws + WS_SS))[i] = 0.f;
    for (int i = bx * 512 + tid; i < NPAD; i += G * 512) { const int s = src_col_of(i); ((float*)(ws + WS_BIAS))[i] = s >= 0 ? P.b_in[s] : 0.f; }
    bf16_t* H = (bf16_t*)((unsigned char*)P.out + DO_H);
    for (int r = bx * 8 + wave; r < T + 2048; r += G * 8) {
        if (r < T) rms_row(P.x + (size_t)r * DM, P.ln_g, H + (size_t)r * DM, ws + WS_H8 + (size_t)r * DM, lane);
        else rms_row(P.mem + (size_t)(r - T) * DM, P.mem_ln_g, H + (size_t)r * DM, nullptr, lane);
    }
    p0_transposes(P, lds);
}

DI float logsigmoidf_(float v) { return fminf(v, 0.f) - log1pf(expf(-fabsf(v))); }
DI void p2_gates_wg(const Params& P, int bh, LAS unsigned char* lds) {
    const int tid = opaque_tid(), lane = tid & 63, wave = tid >> 6;
    unsigned char* ws = P.ws; const int b = bh / 6, h = bh % 6;
    const float* IFp = (const float*)(ws + WS_IF) + (size_t)b * SEQ * 16;
    float* A1 = (float*)(ws + WS_GS) + (size_t)bh * SEQ; float* IB = A1 + GS_ARR; float* INTER = IB + GS_ARR; float* EDEN = INTER + GS_ARR; float* W = EDEN + GS_ARR;
    float* DEC = (float*)(ws + WS_GDEC) + bh * 64;
    LAS f32x2* AB = (LAS f32x2*)lds;
    float iv[8], fv[8], bbv[8], ibv[8], mxv[8], gv[8], mxa[8];
#pragma unroll
    for (int k = 0; k < 8; ++k) { const int t = (wave * 8 + k) * 64 + lane; iv[k] = IFp[(size_t)t * 16 + h]; fv[k] = IFp[(size_t)t * 16 + 6 + h]; }
#pragma unroll
    for (int k = 0; k < 8; ++k) {
        float bb = logsigmoidf_(fv[k]);
#pragma unroll
        for (int o = 1; o < 64; o <<= 1) { const float u = __shfl_up(bb, o); if (lane >= o) bb += u; }
        const float g = __shfl(bb, 63), ib = iv[k] - bb;
        float mx = ib;
#pragma unroll
        for (int o = 1; o < 64; o <<= 1) { const float u = __shfl_up(mx, o); if (lane >= o) mx = fmaxf(mx, u); }
        const float mxall = __shfl(mx, 63);
        bbv[k] = bb; ibv[k] = ib; mxv[k] = mx; gv[k] = g; mxa[k] = mxall;
        if (lane == 0) AB[wave * 8 + k] = (f32x2){g, g + mxall};
        __builtin_amdgcn_sched_barrier(0);
    }
    __syncthreads();
    float m = 0.f;
    for (int c = 0; c < wave * 8; ++c) { const f32x2 ab = AB[c]; m = fmaxf(m + ab.x, ab.y); }
#pragma unroll
    for (int k = 0; k < 8; ++k) {
        const int c = wave * 8 + k, t = c * 64 + lane;
        const float log_inter = bbv[k] + m, m_row = fmaxf(log_inter, bbv[k] + mxv[k]);
        const float m_new = fmaxf(gv[k] + m, gv[k] + mxa[k]);
        A1[t] = bbv[k] - m_row; IB[t] = ibv[k]; INTER[t] = expf(log_inter - m_row); EDEN[t] = expf(-m_row); W[t] = expf(gv[k] + ibv[k] - m_new);
        if (lane == 0) DEC[c] = expf(gv[k] + m - m_new);
        m = m_new;
        __builtin_amdgcn_sched_barrier(0);
    }
    __syncthreads();
}
DI void p2_prep(const Params& P, LAS unsigned char* lds) {
    const int tid = opaque_tid(), lane = tid & 63, wave = tid >> 6, G = gridDim.x, bx = blockIdx.x;
    unsigned char* ws = P.ws;
    for (int it = bx; it < 48; it += G) p2_gates_wg(P, it, lds);
    if (bx == (G > 48 ? 48 : 0) && tid < 6 * 64) {
        const int h = tid >> 6, l = tid & 63; const float lg = logf(1.0f - exp2f(-5.0f - (float)h));
        float* RV = (float*)(ws + WS_RV) + h * 5 * 64;
        RV[l] = (float)l * lg; RV[64 + l] = -(float)l * lg; RV[128 + l] = expf((float)(l + 1) * lg); RV[192 + l] = 1.0f; RV[256 + l] = expf((float)(63 - l) * lg);
        if (l == 0) ((float*)(ws + WS_RV))[6 * 5 * 64 + h] = expf(64.0f * lg);
    }
    const bf16_t* QK1 = (const bf16_t*)(ws + WS_QK1); bf16_t* QKC = (bf16_t*)((unsigned char*)P.out + DO_QKC);
    for (int idx = bx * 512 + tid; idx < (T / 16) * 192; idx += G * 512) {
        const int rb = idx / 192, cgp = idx % 192, r0 = rb * 16, c0 = cgp * 8;
        float w[4][8], bz[8], u[3][8];
#pragma unroll
        for (int k = 0; k < 4; ++k) { const f32x4 a = *(const f32x4*)(P.conv_w + k * 1536 + c0), b = *(const f32x4*)(P.conv_w + k * 1536 + c0 + 4);
            w[k][0] = a[0]; w[k][1] = a[1]; w[k][2] = a[2]; w[k][3] = a[3]; w[k][4] = b[0]; w[k][5] = b[1]; w[k][6] = b[2]; w[k][7] = b[3]; }
        { const f32x4 a = *(const f32x4*)(P.conv_b + c0), b = *(const f32x4*)(P.conv_b + c0 + 4); bz[0] = a[0]; bz[1] = a[1]; bz[2] = a[2]; bz[3] = a[3]; bz[4] = b[0]; bz[5] = b[1]; bz[6] = b[2]; bz[7] = b[3]; }
        const bool hist = (r0 & (SEQ - 1)) != 0;
#pragma unroll
        for (int k = 0; k < 3; ++k) {
            u32x4 v = (u32x4){0u, 0u, 0u, 0u}; if (hist) v = *(const u32x4*)(QK1 + (size_t)(r0 - 3 + k) * 1536 + c0);
            u[k][0] = bflo(v.x); u[k][1] = bfhi(v.x); u[k][2] = bflo(v.y); u[k][3] = bfhi(v.y); u[k][4] = bflo(v.z); u[k][5] = bfhi(v.z); u[k][6] = bflo(v.w); u[k][7] = bfhi(v.w); }
        const float sc = c0 < 768 ? 0.08838834764831845f : 1.0f;
        for (int rh = 0; rh < 16; rh += 8) {
        u32x4 rows[8];
#pragma unroll
        for (int r = 0; r < 8; ++r) rows[r] = *(const u32x4*)(QK1 + (size_t)(r0 + rh + r) * 1536 + c0);
#pragma unroll
        for (int rr = 0; rr < 8; ++rr) { const int r = rh + rr;
            const u32x4 v = rows[rr];
            const float cu[8] = {bflo(v.x), bfhi(v.x), bflo(v.y), bfhi(v.y), bflo(v.z), bfhi(v.z), bflo(v.w), bfhi(v.w)};
            float y[8];
#pragma unroll
            for (int e = 0; e < 8; ++e) { const float a = bz[e] + w[0][e] * u[0][e] + w[1][e] * u[1][e] + w[2][e] * u[2][e] + w[3][e] * cu[e]; y[e] = siluf_(a) * sc; u[0][e] = u[1][e]; u[1][e] = u[2][e]; u[2][e] = cu[e]; }
            u32x4 o; o.x = cvt_pk_bf16(y[0], y[1]); o.y = cvt_pk_bf16(y[2], y[3]); o.z = cvt_pk_bf16(y[4], y[5]); o.w = cvt_pk_bf16(y[6], y[7]);
            *(u32x4*)(QKC + (size_t)(r0 + r) * 1536 + c0) = o;
        }
        }
    }
    bf16_t* QK2 = (bf16_t*)(ws + WS_QK2);
    for (int idx = bx * 512 + tid; idx < T * 8; idx += G * 512) {
        const int tok = idx >> 3, dg = idx & 7; const float pos = (float)P.pos[tok];
        float cs[8], sn[8];
#pragma unroll
        for (int j = 0; j < 8; ++j) { const float fr = exp2f(-(float)(dg * 8 + j) * (13.287712379549449f / 64.0f)); const float ang = pos * fr;
            double rev = (double)ang * 0.15915494309189535; rev -= rint(rev); const float rf = (float)rev;
            sn[j] = __builtin_amdgcn_sinf(rf); cs[j] = __builtin_amdgcn_cosf(rf); }
        for (int hg = 0; hg < 4; ++hg) {
            u32x4 la[3], lb[3];
#pragma unroll
            for (int k = 0; k < 3; ++k) { const bf16_t* p = QK2 + (size_t)tok * 1536 + (hg * 3 + k) * 128 + dg * 8; la[k] = *(const u32x4*)p; lb[k] = *(const u32x4*)(p + 64); }
#pragma unroll
            for (int k = 0; k < 3; ++k) {
                bf16_t* p = QK2 + (size_t)tok * 1536 + (hg * 3 + k) * 128 + dg * 8; const float sc = hg >= 2 ? 0.08838834764831845f : 1.0f;
                const u32x4 a = la[k], b = lb[k];
                const float t1[8] = {bflo(a.x), bfhi(a.x), bflo(a.y), bfhi(a.y), bflo(a.z), bfhi(a.z), bflo(a.w), bfhi(a.w)};
                const float t2[8] = {bflo(b.x), bfhi(b.x), bflo(b.y), bfhi(b.y), bflo(b.z), bfhi(b.z), bflo(b.w), bfhi(b.w)};
                float o1[8], o2[8];
#pragma unroll
                for (int j = 0; j < 8; ++j) { o1[j] = (t1[j] * cs[j] - t2[j] * sn[j]) * sc; o2[j] = (t1[j] * sn[j] + t2[j] * cs[j]) * sc; }
                u32x4 x1, x2; x1.x = cvt_pk_bf16(o1[0], o1[1]); x1.y = cvt_pk_bf16(o1[2], o1[3]); x1.z = cvt_pk_bf16(o1[4], o1[5]); x1.w = cvt_pk_bf16(o1[6], o1[7]);
                x2.x = cvt_pk_bf16(o2[0], o2[1]); x2.y = cvt_pk_bf16(o2[2], o2[3]); x2.z = cvt_pk_bf16(o2[4], o2[5]); x2.w = cvt_pk_bf16(o2[6], o2[7]);
                *(u32x4*)p = x1; *(u32x4*)(p + 64) = x2;
            }
        }
    }
}

constexpr int SQ_P = 272, SV_P = 528, ST_P = 144;
constexpr int SC_STAGE = 64 * SQ_P * 2 + 64 * SV_P;
constexpr int SC_ST = 2 * SC_STAGE;
constexpr int SC_NV = SC_ST + 64 * ST_P;
constexpr int SC_RDEN = SC_NV + 512;
constexpr int SC_LNP = SC_RDEN + 256;
constexpr int SC_VEC = SC_LNP + 4096;
constexpr int SC_GAIN = SC_VEC + 2560;
constexpr int SC_END = SC_GAIN + 1024;
static_assert(SC_END <= LDS_BYTES, "scan LDS");

DI void scan_item(const Params& P, LAS unsigned char* lds, int item) {
    const int tid = opaque_tid(), lane = tid & 63, w = __builtin_amdgcn_readfirstlane(tid >> 6), r = lane & 15, g = lane >> 4, q4 = r >> 2, p4 = r & 3;
    unsigned char* ws = P.ws;
    const bool is_ml = item < 48; const int bh = is_ml ? item : item - 48, b = bh / 6, h = bh % 6;
    const bf16_t* Qg = (is_ml ? (const bf16_t*)((unsigned char*)P.out + DO_QKC) : (const bf16_t*)(ws + WS_QK2)) + (size_t)b * SEQ * 1536 + h * 128;
    const bf16_t* Kg = Qg + 768;
    bf16_t* Vg = (bf16_t*)(ws + (is_ml ? WS_V1 : WS_V2)) + (size_t)b * SEQ * 1536 + h * 256;
    const float* vbase; const float* vDEC; int cstr, dstr; size_t vstr;
    if (is_ml) { vbase = (const float*)(ws + WS_GS) + (size_t)bh * SEQ; vstr = GS_ARR; vDEC = (const float*)(ws + WS_GDEC) + bh * 64; cstr = 64; dstr = 1; }
    else { vbase = (const float*)(ws + WS_RV) + h * 320; vstr = 64; vDEC = (const float*)(ws + WS_RV) + 6 * 320 + h; cstr = 0; dstr = 0; }
    const float* vptr = vbase + (size_t)(tid >> 6) * vstr + (tid & 63);
    const unsigned ldsb = (unsigned)(size_t)lds;
    f32x4 Cacc[8][2];
#pragma unroll
    for (int i = 0; i < 8; ++i) { Cacc[i][0] = (f32x4){0.f, 0.f, 0.f, 0.f}; Cacc[i][1] = (f32x4){0.f, 0.f, 0.f, 0.f}; }
    if (tid < 128) ((LAS float*)(lds + SC_NV))[tid] = 0.f;
    if (tid < 64) ((LAS float*)(lds + SC_RDEN))[tid] = 1.0f;
    u32x4 pq[2], pk[2], pv[4];
    unsigned qoff = (unsigned)(tid >> 4) * 3072u + (unsigned)(tid & 15) * 16u, voff = (unsigned)(tid >> 5) * 3072u + (unsigned)(tid & 31) * 16u, zoff = (unsigned)r * 3072u + (unsigned)(32 * w + 8 * g) * 2u;
#define SC_LOAD(c) do { const size_t cb = (size_t)(c) * 64 * 3072; const char* qb_ = (const char*)Qg + cb; const char* kb_ = (const char*)Kg + cb; const char* vb_ = (const char*)Vg + cb; \
        _Pragma("unroll") for (int i = 0; i < 2; ++i) { pq[i] = *(const u32x4*)(qb_ + (qoff + i * 98304u)); pk[i] = *(const u32x4*)(kb_ + (qoff + i * 98304u)); } \
        _Pragma("unroll") for (int i = 0; i < 4; ++i) { pv[i] = *(const u32x4*)(vb_ + (voff + i * 49152u)); } } while (0)
#define SC_STORE(st) do { LAS unsigned char* sb = lds + (st) * SC_STAGE; \
        _Pragma("unroll") for (int i = 0; i < 2; ++i) { const int pp = tid + 512 * i, row = pp >> 4, ch = pp & 15; *(LAS u32x4*)(sb + row * SQ_P + ch * 16) = pq[i]; *(LAS u32x4*)(sb + 64 * SQ_P + row * SQ_P + ch * 16) = pk[i]; } \
        _Pragma("unroll") for (int i = 0; i < 4; ++i) { const int pp = tid + 512 * i, row = pp >> 5, ch = pp & 31; *(LAS u32x4*)(sb + 128 * SQ_P + row * SV_P + ch * 16) = pv[i]; } } while (0)
    SC_LOAD(0); SC_STORE(0);
    if (tid < 320) ((LAS float*)(lds + SC_VEC))[tid] = vptr[0];
    __syncthreads();

    for (int c = 0; c < 64; ++c) {
        const int cur = c & 1;
        asm volatile("" : "+v"(qoff), "+v"(voff), "+v"(zoff));
        LAS unsigned char* Qs = lds + cur * SC_STAGE; LAS unsigned char* Ks = Qs + 64 * SQ_P; LAS unsigned char* Vs = Qs + 128 * SQ_P;
        const unsigned KsA = ldsb + cur * SC_STAGE + 64 * SQ_P, VsA = ldsb + cur * SC_STAGE + 128 * SQ_P;
        const LAS float* cA1 = (const LAS float*)(lds + SC_VEC + cur * 1280); const LAS float* cIB = cA1 + 64; const LAS float* cINT = cA1 + 128; const LAS float* cEDEN = cA1 + 192; const LAS float* cW = cA1 + 256;
        const float decay = vDEC[c * dstr];
        {
            const int mb = w >> 1, l = 16 * mb + r; const float a1 = cA1[l];
            bf16x8 qf[4];
#pragma unroll
            for (int ks = 0; ks < 4; ++ks) qf[ks] = *(const LAS bf16x8*)(Qs + l * SQ_P + (32 * ks + 8 * g) * 2);
#pragma unroll
            for (int nn = 0; nn < 2; ++nn) {
                const int nb = 2 * (w & 1) + nn; u32x2 o = (u32x2){0u, 0u};
                if (nb <= mb) {
                    f32x4 s = (f32x4){0.f, 0.f, 0.f, 0.f};
#pragma unroll
                    for (int ks = 0; ks < 4; ++ks) { const bf16x8 kf = *(const LAS bf16x8*)(Ks + (16 * nb + r) * SQ_P + (32 * ks + 8 * g) * 2); s = MFMA16(kf, qf[ks], s); }
                    const f32x4 ib = *(const LAS f32x4*)(cIB + 16 * nb + 4 * g);
                    float d[4];
#pragma unroll
                    for (int j = 0; j < 4; ++j) { const int sidx = 16 * nb + 4 * g + j; d[j] = (sidx <= l) ? s[j] * __expf(a1 + ib[j]) : 0.f; }
                    o.x = cvt_pk_bf16(d[0], d[1]); o.y = cvt_pk_bf16(d[2], d[3]);
                }
                *(LAS u32x2*)(lds + SC_ST + l * ST_P + (16 * nb + 4 * g) * 2) = o;
            }
        }
        LBAR();
        if (is_ml) {
            const int l = tid >> 3, part = tid & 7;
            const u32x4 sv = *(const LAS u32x4*)(lds + SC_ST + l * ST_P + part * 16);
            float ssum = bflo(sv.x) + bfhi(sv.x) + bflo(sv.y) + bfhi(sv.y) + bflo(sv.z) + bfhi(sv.z) + bflo(sv.w) + bfhi(sv.w);
            const u32x4 q0 = *(const LAS u32x4*)(Qs + l * SQ_P + part * 32), q1 = *(const LAS u32x4*)(Qs + l * SQ_P + part * 32 + 16);
            const LAS f32x4* nv = (const LAS f32x4*)(lds + SC_NV + part * 64);
            const f32x4 n0 = nv[0], n1 = nv[1], n2 = nv[2], n3 = nv[3];
            float qn = bflo(q0.x) * n0[0] + bfhi(q0.x) * n0[1] + bflo(q0.y) * n0[2] + bfhi(q0.y) * n0[3] + bflo(q0.z) * n1[0] + bfhi(q0.z) * n1[1] + bflo(q0.w) * n1[2] + bfhi(q0.w) * n1[3]
                     + bflo(q1.x) * n2[0] + bfhi(q1.x) * n2[1] + bflo(q1.y) * n2[2] + bfhi(q1.y) * n2[3] + bflo(q1.z) * n3[0] + bfhi(q1.z) * n3[1] + bflo(q1.w) * n3[2] + bfhi(q1.w) * n3[3];
            float val = ssum + cINT[l] * qn;
            val += __shfl_xor(val, 1); val += __shfl_xor(val, 2); val += __shfl_xor(val, 4);
            if (part == 0) ((LAS float*)(lds + SC_RDEN))[l] = 1.0f / fmaxf(fabsf(val), cEDEN[l]);
        }
        __builtin_amdgcn_sched_barrier(0);
        LBAR();
        bf16x8 vf[2][2];
        unsigned vtb = VsA + (8 * g + q4) * SV_P + (32 * w + 8 * p4) * 2; asm volatile("" : "+v"(vtb));
        unsigned ktb = KsA + (8 * g + q4) * SQ_P + (4 * p4) * 2; asm volatile("" : "+v"(ktb));
        { s16x4 t8[8];
          tr_read8(t8, vtb, vtb + 4 * SV_P, vtb + 32 * SV_P, vtb + 36 * SV_P, vtb + 8, vtb + 8 + 4 * SV_P, vtb + 8 + 32 * SV_P, vtb + 8 + 36 * SV_P);
          vf[0][0] = __builtin_shufflevector(t8[0], t8[1], 0, 1, 2, 3, 4, 5, 6, 7); vf[0][1] = __builtin_shufflevector(t8[2], t8[3], 0, 1, 2, 3, 4, 5, 6, 7);
          vf[1][0] = __builtin_shufflevector(t8[4], t8[5], 0, 1, 2, 3, 4, 5, 6, 7); vf[1][1] = __builtin_shufflevector(t8[6], t8[7], 0, 1, 2, 3, 4, 5, 6, 7); }
        f32x4 hi_[4][2], hx_[4][2];
#pragma unroll
        for (int mb = 0; mb < 4; ++mb)
#pragma unroll
            for (int vt = 0; vt < 2; ++vt) { hi_[mb][vt] = (f32x4){0.f, 0.f, 0.f, 0.f}; hx_[mb][vt] = (f32x4){0.f, 0.f, 0.f, 0.f}; }
#pragma unroll
        for (int mb = 0; mb < 4; ++mb)
#pragma unroll
            for (int ks = 0; ks < 2; ++ks) {
                if (ks == 1 && mb < 2) continue;
                const bf16x8 sf = *(const LAS bf16x8*)(lds + SC_ST + (16 * mb + r) * ST_P + (32 * ks + 8 * g) * 2);
                hi_[mb][0] = MFMA16(vf[0][ks], sf, hi_[mb][0]); hi_[mb][1] = MFMA16(vf[1][ks], sf, hi_[mb][1]);
            }
#pragma unroll
        for (int p = 0; p < 4; ++p) {
            bf16x8 cf[2];
#pragma unroll
            for (int vt = 0; vt < 2; ++vt) { u32x4 t; const f32x4 c0 = Cacc[2 * p][vt], c1 = Cacc[2 * p + 1][vt];
                t.x = cvt_pk_bf16(c0[0], c0[1]); t.y = cvt_pk_bf16(c0[2], c0[3]); t.z = cvt_pk_bf16(c1[0], c1[1]); t.w = cvt_pk_bf16(c1[2], c1[3]); cf[vt] = __builtin_bit_cast(bf16x8, t); }
#pragma unroll
            for (int mb = 0; mb < 4; ++mb) {
                const u32x2 qa = *(const LAS u32x2*)(Qs + (16 * mb + r) * SQ_P + (32 * p + 4 * g) * 2), qb = *(const LAS u32x2*)(Qs + (16 * mb + r) * SQ_P + (32 * p + 16 + 4 * g) * 2);
                u32x4 t; t.x = qa.x; t.y = qa.y; t.z = qb.x; t.w = qb.y; const bf16x8 qf2 = __builtin_bit_cast(bf16x8, t);
                hx_[mb][0] = MFMA16(cf[0], qf2, hx_[mb][0]); hx_[mb][1] = MFMA16(cf[1], qf2, hx_[mb][1]);
            }
            __builtin_amdgcn_sched_barrier(0);
        }
#pragma unroll
        for (int mb = 0; mb < 4; ++mb) { const int l = 16 * mb + r; const float it = cINT[l], rd = ((const LAS float*)(lds + SC_RDEN))[l];
            float v[8];
#pragma unroll
            for (int vt = 0; vt < 2; ++vt)
#pragma unroll
                for (int j = 0; j < 4; ++j) v[4 * vt + j] = (hi_[mb][vt][j] + it * hx_[mb][vt][j]) * rd;
            u32x4 st; st.x = cvt_pk_bf16(v[0], v[1]); st.y = cvt_pk_bf16(v[2], v[3]); st.z = cvt_pk_bf16(v[4], v[5]); st.w = cvt_pk_bf16(v[6], v[7]);
            *(u32x4*)((char*)Vg + (size_t)c * 64 * 3072 + (zoff + mb * 49152u)) = st;
        }
        {
            bf16x8 vw[2][2];
#pragma unroll
            for (int ks = 0; ks < 2; ++ks) { const f32x4 w0 = *(const LAS f32x4*)(cW + 32 * ks + 8 * g), w1 = *(const LAS f32x4*)(cW + 32 * ks + 8 * g + 4);
#pragma unroll
                for (int vt = 0; vt < 2; ++vt) { const u32x4 t = __builtin_bit_cast(u32x4, vf[vt][ks]); u32x4 o;
                    o.x = cvt_pk_bf16(bflo(t.x) * w0[0], bfhi(t.x) * w0[1]); o.y = cvt_pk_bf16(bflo(t.y) * w0[2], bfhi(t.y) * w0[3]);
                    o.z = cvt_pk_bf16(bflo(t.z) * w1[0], bfhi(t.z) * w1[1]); o.w = cvt_pk_bf16(bflo(t.w) * w1[2], bfhi(t.w) * w1[3]); vw[vt][ks] = __builtin_bit_cast(bf16x8, o); } }
#pragma unroll
            for (int dp = 0; dp < 4; ++dp) {
                s16x4 t8[8]; const unsigned kb0 = ktb + (32 * dp) * 2, kb1 = kb0 + 32;
                tr_read8(t8, kb0, kb0 + 4 * SQ_P, kb0 + 32 * SQ_P, kb0 + 36 * SQ_P, kb1, kb1 + 4 * SQ_P, kb1 + 32 * SQ_P, kb1 + 36 * SQ_P);
#pragma unroll
                for (int dd = 0; dd < 2; ++dd) { const int db = 2 * dp + dd;
                    Cacc[db][0] = Cacc[db][0] * decay; Cacc[db][1] = Cacc[db][1] * decay;
#pragma unroll
                    for (int ks = 0; ks < 2; ++ks) {
                        const bf16x8 kf = __builtin_shufflevector(t8[4 * dd + 2 * ks], t8[4 * dd + 2 * ks + 1], 0, 1, 2, 3, 4, 5, 6, 7);
                        Cacc[db][0] = MFMA16(kf, vw[0][ks], Cacc[db][0]); Cacc[db][1] = MFMA16(kf, vw[1][ks], Cacc[db][1]);
                    } }
            }
        }
        __builtin_amdgcn_sched_barrier(0);
        float vpre = 0.f;
        if (c + 1 < 64) { SC_LOAD(c + 1); if (tid < 320) vpre = vptr[(c + 1) * cstr]; }
        __builtin_amdgcn_sched_barrier(0);
        if (is_ml) {
            const int d = tid >> 2, part = tid & 3; float s = 0.f;
#pragma unroll
            for (int j = 0; j < 16; ++j) { const int sidx = 16 * part + j; s += cW[sidx] * bf2f(*(const LAS bf16_t*)(Ks + sidx * SQ_P + d * 2)); }
            s += __shfl_xor(s, 1); s += __shfl_xor(s, 2);
            if (part == 0) { LAS float* np = (LAS float*)(lds + SC_NV) + d; *np = decay * (*np) + s; }
        }
        if (c + 1 < 64) { SC_STORE(cur ^ 1); if (tid < 320) ((LAS float*)(lds + SC_VEC + (cur ^ 1) * 1280))[tid] = vpre; }
        LBAR();
    }
#undef SC_LOAD
#undef SC_STORE
}


DI void p3b_gate(const Params& P) {
    const int tid = opaque_tid(), lane = tid & 63, sub = lane >> 4, li = lane & 15, G = gridDim.x, bx = blockIdx.x;
    unsigned char* ws = P.ws;
    const int nw = T * 6 * 2 / 4;
    for (int wv = bx * 8 + (tid >> 6); wv < nw; wv += G * 8) {
        int pair = wv * 4 + sub; const int br = pair >= T * 6; pair -= br * T * 6; const int t = pair / 6, h = pair - t * 6;
        const size_t off = (size_t)t * 1536 + h * 256 + li * 16;
        const bf16_t* hp = (const bf16_t*)(ws + (br ? WS_V2 : WS_V1)) + off; bf16_t* zp = (bf16_t*)(ws + (br ? WS_Z2 : WS_Z1)) + off; const bf16_t* op = (const bf16_t*)(ws + WS_O1) + off;
        const float* gp = (br ? P.ret_g : P.ml_g) + h * 256 + li * 16;
        const u32x4 h0 = *(const u32x4*)hp, h1 = *(const u32x4*)(hp + 8), z0 = *(const u32x4*)zp, z1 = *(const u32x4*)(zp + 8);
        u32x4 o0 = (u32x4){0u, 0u, 0u, 0u}, o1 = o0; if (!br) { o0 = *(const u32x4*)op; o1 = *(const u32x4*)(op + 8); }
        const unsigned hh[8] = {h0.x, h0.y, h0.z, h0.w, h1.x, h1.y, h1.z, h1.w}, zz[8] = {z0.x, z0.y, z0.z, z0.w, z1.x, z1.y, z1.z, z1.w}, oo[8] = {o0.x, o0.y, o0.z, o0.w, o1.x, o1.y, o1.z, o1.w};
        float hv[16], s1 = 0.f, s2 = 0.f;
#pragma unroll
        for (int e = 0; e < 16; ++e) { hv[e] = (e & 1) ? bfhi(hh[e >> 1]) : bflo(hh[e >> 1]); s1 += hv[e]; s2 += hv[e] * hv[e]; }
#pragma unroll
        for (int o = 1; o < 16; o <<= 1) { s1 += __shfl_xor(s1, o); s2 += __shfl_xor(s2, o); }
        const float mean = s1 * (1.0f / 256.0f), var = fmaxf(s2 * (1.0f / 256.0f) - mean * mean, 0.f), rstd = rsqrtf(var + EPS);
        float y[16];
#pragma unroll
        for (int q = 0; q < 4; ++q) { const f32x4 gg = *(const f32x4*)(gp + 4 * q);
#pragma unroll
            for (int j = 0; j < 4; ++j) { const int e = 4 * q + j; const float z = (e & 1) ? bfhi(zz[e >> 1]) : bflo(zz[e >> 1]); float v = (hv[e] - mean) * rstd * gg[j] * siluf_(z);
                if (!br) { const float o = (e & 1) ? bfhi(oo[e >> 1]) : bflo(oo[e >> 1]); v *= sigmoidf_(o); } y[e] = v; } }
        u32x4 a, c2; a.x = cvt_pk_bf16(y[0], y[1]); a.y = cvt_pk_bf16(y[2], y[3]); a.z = cvt_pk_bf16(y[4], y[5]); a.w = cvt_pk_bf16(y[6], y[7]);
        c2.x = cvt_pk_bf16(y[8], y[9]); c2.y = cvt_pk_bf16(y[10], y[11]); c2.z = cvt_pk_bf16(y[12], y[13]); c2.w = cvt_pk_bf16(y[14], y[15]);
        *(u32x4*)zp = a; *(u32x4*)(zp + 8) = c2;
    }
}

constexpr int AK_P = 528;
constexpr int AV_P = 544;
static_assert(256 * AV_P <= LDS_BYTES - 16, "attn LDS");
DI void attn_unit(const Params& P, LAS unsigned char* lds, int unit) {
    const int tid = opaque_tid(), lane = tid & 63, w = __builtin_amdgcn_readfirstlane(tid >> 6), r = lane & 15, g = lane >> 4, q4 = r >> 2, p4 = r & 3;
    unsigned char* ws = P.ws;
    const int b = unit >> 6, hh = (unit >> 4) & 3, qb = unit & 15;
    const size_t trow = (size_t)b * SEQ + qb * 256 + 32 * w + r;
    const bf16_t* Qp = (const bf16_t*)(ws + WS_Q3) + trow * 1024 + hh * 256;
    bf16_t* Zp = (bf16_t*)(ws + WS_Z3) + trow * 1024 + hh * 256;
    const bf16_t* Kp = (const bf16_t*)(ws + WS_MKV) + (size_t)b * 256 * 2048 + hh * 256;
    const bf16_t* Vp = Kp + 1024;
    const unsigned ldsb = (unsigned)(size_t)lds;
#pragma unroll
    for (int i = 0; i < 16; ++i) { const int pp = tid + 512 * i, row = pp >> 5, ch = pp & 31; *(LAS u32x4*)(lds + row * AK_P + ch * 16) = *(const u32x4*)(Kp + (size_t)row * 2048 + ch * 8); }
    __syncthreads();
    bf16x8 pf[2][8]; float rs[2];
#pragma unroll
    for (int mb = 0; mb < 2; ++mb) {
        bf16x8 qf[8];
#pragma unroll
        for (int ks = 0; ks < 8; ++ks) qf[ks] = *(const bf16x8*)(Qp + (size_t)mb * 16 * 1024 + 32 * ks + 8 * g);
        f32x4 s[16];
#pragma unroll
        for (int nb = 0; nb < 16; ++nb) { s[nb] = (f32x4){0.f, 0.f, 0.f, 0.f};
#pragma unroll
            for (int ks = 0; ks < 8; ++ks) { const bf16x8 kf = *(const LAS bf16x8*)(lds + (16 * nb + r) * AK_P + (32 * ks + 8 * g) * 2); s[nb] = MFMA16(kf, qf[ks], s[nb]); } __builtin_amdgcn_sched_barrier(0); }
        float mx = -3.0e38f;
#pragma unroll
        for (int nb = 0; nb < 16; ++nb) mx = fmaxf(mx, fmaxf(fmaxf(s[nb][0], s[nb][1]), fmaxf(s[nb][2], s[nb][3])));
        mx = fmaxf(mx, __shfl_xor(mx, 16)); mx = fmaxf(mx, __shfl_xor(mx, 32));
        const float sc = 0.0625f * 1.4426950408889634f; float sum = 0.f;
#pragma unroll
        for (int nb = 0; nb < 16; ++nb)
#pragma unroll
            for (int j = 0; j < 4; ++j) { const float e = __builtin_amdgcn_exp2f((s[nb][j] - mx) * sc); s[nb][j] = e; sum += e; }
        sum += __shfl_xor(sum, 16); sum += __shfl_xor(sum, 32);
        rs[mb] = 1.0f / sum;
#pragma unroll
        for (int kk = 0; kk < 8; ++kk) { u32x4 t; t.x = cvt_pk_bf16(s[2 * kk][0], s[2 * kk][1]); t.y = cvt_pk_bf16(s[2 * kk][2], s[2 * kk][3]); t.z = cvt_pk_bf16(s[2 * kk + 1][0], s[2 * kk + 1][1]); t.w = cvt_pk_bf16(s[2 * kk + 1][2], s[2 * kk + 1][3]); pf[mb][kk] = __builtin_bit_cast(bf16x8, t); }
        __builtin_amdgcn_sched_barrier(0);
    }
    __syncthreads();
#pragma unroll
    for (int i = 0; i < 16; ++i) { const int pp = tid + 512 * i, row = pp >> 5, ch = pp & 31; *(LAS u32x4*)(lds + row * AV_P + ch * 16) = *(const u32x4*)(Vp + (size_t)row * 2048 + ch * 8); }
    __syncthreads();
#pragma unroll
    for (int VG = 0; VG < 4; ++VG) {
        unsigned vb = ldsb + (4 * g + q4) * AV_P + (4 * p4) * 2; asm volatile("" : "+v"(vb));
        bf16_t* zp = Zp + 64 * VG + 4 * g;
        u32x2 zl[2][4];
#pragma unroll
        for (int mb = 0; mb < 2; ++mb)
#pragma unroll
            for (int vq = 0; vq < 4; ++vq) zl[mb][vq] = *(const u32x2*)(zp + (size_t)mb * 16 * 1024 + 16 * vq);
        f32x4 o[2][4];
#pragma unroll
        for (int vq = 0; vq < 4; ++vq) { o[0][vq] = (f32x4){0.f, 0.f, 0.f, 0.f}; o[1][vq] = (f32x4){0.f, 0.f, 0.f, 0.f};
#pragma unroll
            for (int kh = 0; kh < 2; ++kh) {
                s16x4 t8[8]; const unsigned a0 = vb + (128 * kh) * AV_P + (64 * VG + 16 * vq) * 2;
                tr_read8(t8, a0, a0 + 16 * AV_P, a0 + 32 * AV_P, a0 + 48 * AV_P, a0 + 64 * AV_P, a0 + 80 * AV_P, a0 + 96 * AV_P, a0 + 112 * AV_P);
#pragma unroll
                for (int k2 = 0; k2 < 4; ++k2) { const bf16x8 vfr = __builtin_shufflevector(t8[2 * k2], t8[2 * k2 + 1], 0, 1, 2, 3, 4, 5, 6, 7);
                    o[0][vq] = MFMA16(vfr, pf[0][4 * kh + k2], o[0][vq]); o[1][vq] = MFMA16(vfr, pf[1][4 * kh + k2], o[1][vq]); }
            } }
#pragma unroll
        for (int mb = 0; mb < 2; ++mb)
#pragma unroll
            for (int vq = 0; vq < 4; ++vq) {
                const u32x2 zz = zl[mb][vq]; const f32x4 ov = o[mb][vq];
                const float y0 = ov[0] * rs[mb] * siluf_(bflo(zz.x)), y1 = ov[1] * rs[mb] * siluf_(bfhi(zz.x)), y2 = ov[2] * rs[mb] * siluf_(bflo(zz.y)), y3 = ov[3] * rs[mb] * siluf_(bfhi(zz.y));
                unsigned st = 0u; st = __builtin_amdgcn_cvt_pk_fp8_f32(y0 * 16.f, y1 * 16.f, st, false); st = __builtin_amdgcn_cvt_pk_fp8_f32(y2 * 16.f, y3 * 16.f, st, true);
                *(unsigned*)((unsigned char*)P.out + DO_XA8 + (trow + 16 * mb) * 1024 + hh * 256 + 64 * VG + 4 * g + 16 * vq) = st;
            }
    }
    __syncthreads();
}

#define XB_TMO      128
#define XB_XCNT(j)  (256  + 64 * (j))
#define XB_XSUB(j)  (1280 + 64 * (j))
#define XB_XGEN(j)  (2304 + 64 * (j))
#define XB_TOP      3328
#define XB_TOPGEN   3392
#define XCD_BAR_WORDS 3456
#define XB_SPIN_CAP (1u << 18)
DI unsigned xb_ld(unsigned* p)              { return __hip_atomic_load(p, __ATOMIC_RELAXED, __HIP_MEMORY_SCOPE_AGENT); }
DI unsigned xb_add(unsigned* p, unsigned v) { return __hip_atomic_fetch_add(p, v, __ATOMIC_RELAXED, __HIP_MEMORY_SCOPE_AGENT); }
DI unsigned xb_xcc_id() { return (unsigned)__builtin_amdgcn_s_getreg((3 << 11) | 20) & 0xFu; }
#define XB_SPIN(cond, bar) do { unsigned _sp = 0; while (cond) { __builtin_amdgcn_s_sleep(1); \
    if ((++_sp & 255u) == 0u) { if (xb_ld(&(bar)[XB_TMO])) break; if (_sp > XB_SPIN_CAP) { atomicAdd(&(bar)[XB_TMO], 1u); break; } } } } while (0)
struct XcdBarrier { unsigned* bar; unsigned x; volatile LAS unsigned* st; };
DI XcdBarrier xcd_barrier_post(unsigned* bar, volatile LAS unsigned* st) {
    XcdBarrier b; b.bar = bar; b.x = xb_xcc_id(); b.st = st;
    if (threadIdx.x == 0) (void)xb_add(&bar[XB_XCNT(b.x)], 1u);
    return b;
}
DI void xcd_barrier_complete(unsigned* bar, unsigned x, unsigned& nloc, unsigned& nx) {
    const unsigned G = gridDim.x * gridDim.y * gridDim.z;
    unsigned sum, cnt, mine, sp = 0u;
    for (;;) {
        sum = 0u; cnt = 0u; mine = 0u;
#pragma unroll
        for (unsigned j = 0; j < 16; ++j) { const unsigned c = xb_ld(&bar[XB_XCNT(j)]); sum += c; cnt += (c > 0u) ? 1u : 0u; mine = (j == x) ? c : mine; }
        if (sum == G) break;
        __builtin_amdgcn_s_sleep(1);
        if ((++sp & 255u) == 0u) { if (xb_ld(&bar[XB_TMO])) break; if (sp > XB_SPIN_CAP) { atomicAdd(&bar[XB_TMO], 1u); break; } }
    }
    nloc = mine > 0u ? mine : 1u; nx = cnt > 0u ? cnt : 1u;
}
DI void xcd_barrier(const XcdBarrier& b) {
    asm volatile("s_waitcnt vmcnt(0)" ::: "memory");
    __syncthreads();
    if (threadIdx.x == 0) {
        unsigned* bar = b.bar;
        __builtin_amdgcn_s_waitcnt(0);
        unsigned nloc = b.st[0], nx = b.st[1];
        if (nloc == 0u) { xcd_barrier_complete(bar, b.x, nloc, nx); b.st[0] = nloc; b.st[1] = nx; }
        const unsigned old = xb_add(&bar[XB_XSUB(b.x)], 1u);
        const unsigned gen = old / nloc;
        if (old + 1u == (gen + 1u) * nloc) {
            __builtin_amdgcn_fence(__ATOMIC_RELEASE, "agent");
            asm volatile("s_waitcnt vmcnt(0)" ::: "memory");
            const unsigned og = xb_add(&bar[XB_TOP], 1u);
            const unsigned tg = og / nx;
            if (og + 1u == (tg + 1u) * nx) xb_add(&bar[XB_TOPGEN], 1u);
            else XB_SPIN(xb_ld(&bar[XB_TOPGEN]) == tg, bar);
            __builtin_amdgcn_fence(__ATOMIC_ACQUIRE, "agent");
            xb_add(&bar[XB_XGEN(b.x)], 1u);
            asm volatile("s_waitcnt vmcnt(0)" ::: "memory");
        } else {
            XB_SPIN(xb_ld(&bar[XB_XGEN(b.x)]) == gen, bar);
            __builtin_amdgcn_fence(__ATOMIC_ACQUIRE, "agent");
            asm volatile("s_waitcnt vmcnt(0)" ::: "memory");
        }
    }
    __syncthreads();
}

__global__ void __launch_bounds__(512) fwd_megakernel(Params P) {
    extern __shared__ __attribute__((aligned(16))) unsigned char smem[];
    LAS unsigned char* lds = (LAS unsigned char*)smem;
    cg::grid_group grid = cg::this_grid();
    unsigned char* ws = P.ws;
    const int G = gridDim.x, bx = blockIdx.x, tid = threadIdx.x;
    bf16_t* H = (bf16_t*)((unsigned char*)P.out + DO_H);

    if (tid < 4) ((LAS unsigned*)(lds + LDS_BYTES - 32))[tid] = 0u;
    __syncthreads();
#ifndef NO_P0
    p0_prologue(P, lds);
#endif
    grid.sync();
    const XcdBarrier xb = xcd_barrier_post((unsigned*)(ws + WS_BAR), (volatile LAS unsigned*)(lds + LDS_BYTES - 32));
    {
        { pg8::Gemm g{H, (const bf16_t*)(ws + WS_WIN), 2048}; pg8::Order S; S.init(128, NT_P1 - 20, G, bx, 0, 64, 128, PN_KV); S.skip_lo = 24; S.skip_n = 16; S.skip2_lo = 46; S.skip2_n = 4;
          pg8::EpiProj E{ws, (const float*)(ws + WS_BIAS), 1 << 20, 0, 0.f};
          pg8::gemm_phase(lds, g, S, E); }
        { pg8::Gemm g{(const bf16_t*)(ws + WS_H8), (const bf16_t*)((unsigned char*)P.out + DO_WO8 - (size_t)24 * 256 * 2048), 1024}; pg8::Order S; S.init(128, 20, G, bx, 24);
          pg8::EpiProj E{ws, (const float*)(ws + WS_BIAS), 40, 6, Q8_DEQ};
          pg8::gemm_phase<2>(lds, g, S, E); }
    }
    xcd_barrier(xb);
#ifndef NO_P2
    p2_prep(P, lds);
#endif
    xcd_barrier(xb);
    {
#ifndef NO_SCAN
        for (int it = bx; it < 96; it += G) scan_item(P, lds, it);
#endif
        if (bx >= 96 && G > 96) {
            pg8::Gemm g{(const bf16_t*)(ws + WS_H8), (const bf16_t*)((unsigned char*)P.out + DO_WG8), 1024}; pg8::Order S; S.init(128, 8, G - 96, bx - 96, 0);
            pg8::EpiGate E{ws, (const float*)(ws + WS_BIAS), Q8_DEQ};
            pg8::gemm_phase<2>(lds, g, S, E);
        }
        LAS unsigned* slot = (LAS unsigned*)(lds + LDS_BYTES - 16);
        for (;;) {
            if (tid == 0) *slot = atomicAdd((unsigned*)(ws + WS_CTL), 1u);
            __syncthreads();
            const unsigned u = *slot;
            __syncthreads();
            if (u >= 512u) break;
#ifndef NO_ATTN
            attn_unit(P, lds, (int)u);
#endif
        }
    }
    xcd_barrier(xb);
#ifndef NO_P2
    p3b_gate(P);
#endif
    xcd_barrier(xb);
    {
        pg8::Gemm g{(const bf16_t*)(ws + WS_H8), (const bf16_t*)((unsigned char*)P.out + DO_WG8), 1024}; pg8::Order S; S.init(128, 16, G, bx, 8);
        pg8::EpiGate E{ws, (const float*)(ws + WS_BIAS), Q8_DEQ};
        pg8::gemm_phase<2>(lds, g, S, E);
    }
    xcd_barrier(xb);
    {
        pg8::Order S; S.init(128, 8, G, bx, 0);
        { pg8::Gemm g{(const bf16_t*)(ws + WS_Z1), (const bf16_t*)(ws + WS_WML), 1536}; pg8::EpiMerge E{(bf16_t*)(ws + WS_MERGED), (const bf16_t*)(ws + WS_G0), 0}; pg8::gemm_phase(lds, g, S, E); }
        { pg8::Gemm g{(const bf16_t*)(ws + WS_Z2), (const bf16_t*)(ws + WS_WRET), 1536}; pg8::EpiMerge E{(bf16_t*)(ws + WS_MERGED), (const bf16_t*)(ws + WS_G12), 1}; pg8::gemm_phase(lds, g, S, E); }
        { pg8::Gemm g{(const bf16_t*)((unsigned char*)P.out + DO_XA8), (const bf16_t*)((unsigned char*)P.out + DO_WX8), 512, 0, 0x7B7B7B7B}; pg8::EpiMerge E{(bf16_t*)(ws + WS_MERGED), (const bf16_t*)(ws + WS_G12 + SZ20), 2}; pg8::gemm_phase<1>(lds, g, S, E); }
    }
    xcd_barrier(xb);
    {
        pg8::Gemm g{(const bf16_t*)(ws + WS_MERGED), (const bf16_t*)(ws + WS_WOUT), 2048}; pg8::Order S; S.init(128, 8, G, bx, 0);
        pg8::EpiOut E{(bf16_t*)(ws + WS_G0)};
        pg8::gemm_phase(lds, g, S, E);
    }
    xcd_barrier(xb);
    {
        const bf16_t* D = (const bf16_t*)(ws + WS_G0); const int lane = tid & 63, wave = tid >> 6;
        f32x4 gg[8];
#pragma unroll
        for (int i = 0; i < 8; ++i) gg[i] = *(const f32x4*)(P.fin_g + 4 * (lane + 64 * i));
        for (int row = bx * 16 + wave * 2; row < T; row += G * 16) {
            const float* x0 = P.x + (size_t)row * 2048; const float* x1 = x0 + 2048; const bf16_t* d0 = D + (size_t)row * 2048; const bf16_t* d1 = d0 + 2048;
            float* o0 = P.out + (size_t)row * 2048; float* o1 = o0 + 2048;
            f32x4 a[8], b[8]; u32x2 da[8], db[8];
#pragma unroll
            for (int i = 0; i < 8; ++i) { a[i] = *(const f32x4*)(x0 + 4 * (lane + 64 * i)); b[i] = *(const f32x4*)(x1 + 4 * (lane + 64 * i)); da[i] = *(const u32x2*)(d0 + 4 * (lane + 64 * i)); db[i] = *(const u32x2*)(d1 + 4 * (lane + 64 * i)); }
            float s0 = 0.f, s1 = 0.f;
#pragma unroll
            for (int i = 0; i < 8; ++i) {
                a[i] += (f32x4){bflo(da[i].x), bfhi(da[i].x), bflo(da[i].y), bfhi(da[i].y)}; b[i] += (f32x4){bflo(db[i].x), bfhi(db[i].x), bflo(db[i].y), bfhi(db[i].y)};
                s0 += a[i][0] * a[i][0] + a[i][1] * a[i][1] + a[i][2] * a[i][2] + a[i][3] * a[i][3]; s1 += b[i][0] * b[i][0] + b[i][1] * b[i][1] + b[i][2] * b[i][2] + b[i][3] * b[i][3]; }
            s0 = wave_sum(s0); s1 = wave_sum(s1);
            const float c0 = rsqrtf(s0 * (1.0f / 2048.0f) + EPS), c1 = rsqrtf(s1 * (1.0f / 2048.0f) + EPS);
#pragma unroll
            for (int i = 0; i < 8; ++i) { *(f32x4*)(o0 + 4 * (lane + 64 * i)) = a[i] * c0 * gg[i]; *(f32x4*)(o1 + 4 * (lane + 64 * i)) = b[i] * c1 * gg[i]; }
        }
    }
}

extern "C" void kernel_launch(void* const* d_in, const int* in_sizes, int n_in, void* d_out, int out_size, void* d_ws, size_t ws_size, hipStream_t stream) {
    static int grid = 0;
    if (grid == 0) {
        if (n_in != 17 || out_size != T * DM || ws_size < WS_END) { fprintf(stderr, "kernel_launch: unexpected shapes / workspace (%d inputs, out %d, ws %zu, need %zu)\n", n_in, out_size, ws_size, (size_t)WS_END); grid = -1; return; }
        int dev = 0, cus = 0, per_cu = 0;
        hipGetDevice(&dev); hipDeviceGetAttribute(&cus, hipDeviceAttributeMultiprocessorCount, dev);
        if (hipFuncSetAttribute((const void*)fwd_megakernel, hipFuncAttributeMaxDynamicSharedMemorySize, LDS_BYTES) != hipSuccess) { fprintf(stderr, "kernel_launch: hipFuncSetAttribute failed\n"); grid = -1; return; }
        if (hipOccupancyMaxActiveBlocksPerMultiprocessor(&per_cu, (const void*)fwd_megakernel, 512, LDS_BYTES) != hipSuccess || per_cu < 1) { fprintf(stderr, "kernel_launch: occupancy query gave %d\n", per_cu); per_cu = 1; }
        (void)hipGetLastError();
        grid = cus * 1;
    }
    if (grid < 0) return;
    Params p{};
    p.x = (const float*)d_in[0]; p.mem = (const float*)d_in[1]; p.pos = (const int*)d_in[2]; p.ln_g = (const float*)d_in[3]; p.mem_ln_g = (const float*)d_in[4];
    p.w_in = (const float*)d_in[5]; p.b_in = (const float*)d_in[6]; p.conv_w = (const float*)d_in[7]; p.conv_b = (const float*)d_in[8]; p.ml_g = (const float*)d_in[9];
    p.ret_g = (const float*)d_in[10]; p.w_kv = (const float*)d_in[11]; p.w_ml = (const float*)d_in[12]; p.w_ret = (const float*)d_in[13]; p.w_xa = (const float*)d_in[14];
    p.w_out = (const float*)d_in[15]; p.fin_g = (const float*)d_in[16]; p.out = (float*)d_out; p.ws = (unsigned char*)d_ws;
    void* args[] = {&p};
    hipError_t e = hipLaunchCooperativeKernel((const void*)fwd_megakernel, dim3(grid), dim3(512), args, LDS_BYTES, stream);
    if (e != hipSuccess) fprintf(stderr, "cooperative launch failed: %s (grid %d)\n", hipGetErrorString(e), grid);
}
```

```cpp
#include <hip/hip_runtime.h>
#include <hip/hip_cooperative_groups.h>
#include <cstdint>
#include <cstdio>
namespace cg = cooperative_groups;

#define LAS __attribute__((address_space(3)))
typedef unsigned short bf16_t;
typedef short bf16x8 __attribute__((ext_vector_type(8)));
typedef short s16x4 __attribute__((ext_vector_type(4)));
typedef float f32x4 __attribute__((ext_vector_type(4)));
typedef float f32x2 __attribute__((ext_vector_type(2)));
typedef unsigned u32x4 __attribute__((ext_vector_type(4)));
typedef unsigned u32x2 __attribute__((ext_vector_type(2)));
typedef int i32x4 __attribute__((ext_vector_type(4)));
typedef int i32x8 __attribute__((ext_vector_type(8)));
#define DI __device__ __forceinline__

constexpr int T = 32768, DM = 2048, SEQ = 4096, NB = 8;
constexpr int N_IN = 18956, NPAD = 19200;
constexpr int NT_P1 = 51;
constexpr int PN_GATE = 51;
constexpr int PN_KV = 75;
constexpr float EPS = 1e-6f;
constexpr int LDS_BYTES = 156 * 1024;

constexpr size_t WS_CTL = 0;
constexpr size_t WS_BAR = 4096;
constexpr size_t WS_SS = WS_BAR + 16384;
constexpr size_t WS_BIAS = WS_SS + (size_t)T * 4;
constexpr size_t WS_IF = WS_BIAS + 81920;
constexpr size_t WS_GS = WS_IF + (size_t)T * 16 * 4;
constexpr size_t GS_ARR = (size_t)48 * 4096;
constexpr size_t WS_GDEC = WS_GS + 5 * GS_ARR * 4;
constexpr size_t WS_RV = WS_GDEC + 48 * 64 * 4;
constexpr size_t WS_WIN = WS_RV + 16384;
constexpr size_t WS_WKV = WS_WIN + (size_t)NPAD * DM * 2;
constexpr size_t WS_WML = WS_WKV + (size_t)2048 * 2048 * 2;
constexpr size_t WS_WRET = WS_WML + (size_t)2048 * 1536 * 2;
constexpr size_t WS_WXA = WS_WRET + (size_t)2048 * 1536 * 2;
constexpr size_t WS_WOUT = WS_WXA + (size_t)2048 * 1024 * 2;
constexpr size_t WS_MKV = WS_WOUT + (size_t)2048 * 2048 * 2;
constexpr size_t WS_BIG = WS_MKV + (size_t)2048 * 2048 * 2;
constexpr size_t SZ15 = (size_t)T * 1536 * 2, SZ10 = (size_t)T * 1024 * 2;
constexpr size_t SZ20 = (size_t)T * 2048 * 2;
constexpr size_t WS_V1 = WS_BIG, WS_QK2 = WS_V1 + SZ15, WS_V2 = WS_QK2 + SZ15;
constexpr size_t WS_O1 = WS_V2 + SZ15, WS_Q3 = WS_O1 + SZ15;
constexpr size_t WS_Z1 = WS_Q3 + SZ10, WS_Z2 = WS_Z1 + SZ15, WS_Z3 = WS_Z2 + SZ15;
constexpr size_t WS_QK1 = WS_Z3 + SZ10;
constexpr size_t WS_H8 = WS_QK1 + SZ20;
constexpr size_t WS_WV8 = WS_H8 + (size_t)T * DM;
constexpr size_t WS_END = WS_WV8 + (size_t)1536 * 2048;
constexpr size_t WS_G0 = WS_QK1, WS_G12 = WS_V1, WS_MERGED = WS_O1;
static_assert(2 * SZ20 <= 3 * SZ15 && SZ20 <= SZ15 + SZ10, "overlays");
constexpr size_t DO_H = 0, DO_MN = (size_t)T * DM * 2, DO_QKC = DO_MN + (size_t)2048 * 2048 * 2;
constexpr size_t DO_WG8 = DO_QKC + (size_t)T * 1536 * 2;
constexpr size_t DO_WO8 = DO_WG8 + (size_t)6144 * 2048;
constexpr size_t DO_WX8 = DO_WO8 + (size_t)5120 * 2048;
static_assert(DO_WX8 + (size_t)2048 * 1024 <= (size_t)T * DM * 4, "d_out scratch");
constexpr size_t DO_XA8 = DO_H;

struct Params {
    const float* x; const float* mem; const int* pos; const float* ln_g; const float* mem_ln_g; const float* w_in; const float* b_in;
    const float* conv_w; const float* conv_b; const float* ml_g; const float* ret_g; const float* w_kv; const float* w_ml; const float* w_ret;
    const float* w_xa; const float* w_out; const float* fin_g; float* out; unsigned char* ws;
};

typedef __bf16 bf16v2_t __attribute__((ext_vector_type(2)));
DI unsigned cvt_pk_bf16(float lo, float hi) { const f32x2 v = {lo, hi}; const bf16v2_t r = __builtin_convertvector(v, bf16v2_t); return __builtin_bit_cast(unsigned, r); }
DI float bf2f(unsigned short b) { return __uint_as_float((unsigned)b << 16); }
DI float bflo(unsigned u) { return __uint_as_float(u << 16); }
DI float bfhi(unsigned u) { return __uint_as_float(u & 0xffff0000u); }
DI float sigmoidf_(float v) { return __builtin_amdgcn_rcpf(1.0f + __builtin_amdgcn_exp2f(-1.4426950408889634f * v)); }
DI float siluf_(float v) { return v * __builtin_amdgcn_rcpf(1.0f + __builtin_amdgcn_exp2f(-1.4426950408889634f * v)); }
#define LBAR() do { asm volatile("s_waitcnt lgkmcnt(0)" ::: "memory"); __builtin_amdgcn_s_barrier(); asm volatile("" ::: "memory"); } while (0)
DI float wave_sum(float v) { for (int o = 32; o > 0; o >>= 1) v += __shfl_xor(v, o); return v; }
DI s16x4 tr_read(unsigned lds_addr) { s16x4 r; asm volatile("ds_read_b64_tr_b16 %0, %1\n\ts_waitcnt lgkmcnt(0)" : "=&v"(r) : "v"(lds_addr) : "memory"); return r; }
DI void tr_read8(s16x4 (&o)[8], unsigned a0, unsigned a1, unsigned a2, unsigned a3, unsigned a4, unsigned a5, unsigned a6, unsigned a7) {
    asm volatile("ds_read_b64_tr_b16 %0, %8\n\tds_read_b64_tr_b16 %1, %9\n\tds_read_b64_tr_b16 %2, %10\n\tds_read_b64_tr_b16 %3, %11\n\tds_read_b64_tr_b16 %4, %12\n\tds_read_b64_tr_b16 %5, %13\n\tds_read_b64_tr_b16 %6, %14\n\tds_read_b64_tr_b16 %7, %15\n\ts_waitcnt lgkmcnt(0)"
                 : "=&v"(o[0]), "=&v"(o[1]), "=&v"(o[2]), "=&v"(o[3]), "=&v"(o[4]), "=&v"(o[5]), "=&v"(o[6]), "=&v"(o[7])
                 : "v"(a0), "v"(a1), "v"(a2), "v"(a3), "v"(a4), "v"(a5), "v"(a6), "v"(a7) : "memory");
}
DI unsigned pack_i8x4(float a, float b, float c, float d, float s) {
    const int i0 = (int)rintf(fminf(fmaxf(a * s, -127.f), 127.f)), i1 = (int)rintf(fminf(fmaxf(b * s, -127.f), 127.f)), i2 = (int)rintf(fminf(fmaxf(c * s, -127.f), 127.f)), i3 = (int)rintf(fminf(fmaxf(d * s, -127.f), 127.f));
    return (unsigned)(i0 & 255) | ((unsigned)(i1 & 255) << 8) | ((unsigned)(i2 & 255) << 16) | ((unsigned)i3 << 24);
}
DI f32x4 deq_acc(f32x4 a, float qs) {
    if (qs == 0.f) return a;
    f32x4 r; r[0] = (float)__float_as_int(a[0]) * qs; r[1] = (float)__float_as_int(a[1]) * qs; r[2] = (float)__float_as_int(a[2]) * qs; r[3] = (float)__float_as_int(a[3]) * qs; return r;
}
constexpr float H8_SCALE = 32.f, W8_SCALE = 1536.f, Q8_DEQ = 1.0f / (32.f * 1536.f);
DI int opaque_tid() { int t = threadIdx.x; asm volatile("" : "+v"(t)); return t; }
#define MFMA16(a, b, c) __builtin_amdgcn_mfma_f32_16x16x32_bf16((a), (b), (c), 0, 0, 0)

namespace pg8 {
constexpr int BM = 256, BK = 64, HALF = 128, HTB = HALF * BK * 2, STAGE_BYTES = 8 * HTB, NXCD = 8, WGM = 8;
DI int lds_byte(int r, int c) { const int st = (r >> 4) * 2 + (c >> 5), rr = r & 15, cc = c & 31, ob = rr * 64 + cc * 2; return st * 1024 + (ob ^ (((ob >> 9) & 1) << 5)); }
DI void stage_rc(int b, int& R, int& C) { const int st = b / 1024, sb = b % 1024, swz = sb ^ (((sb >> 9) & 1) << 5); R = (st >> 1) * 16 + swz / 64; C = (st & 1) * 32 + (swz % 64) / 2; }
DI int perm32(int rho) { const int n = rho >> 4, i = rho & 15; return 8 * (i >> 2) + 4 * n + (i & 3); }
struct Unit { int pm, pn; };
struct Gemm { const bf16_t* A; const bf16_t* Bt; int K; int ntile = 0; int sca = 0x7F7F7F7F; };
struct Order {
    int nM, nN, nwg, G, c, pn_off, extra, pm0x, pn0x, skip0_lo, skip0_n, skip_lo, skip_n, skip2_lo, skip2_n;
    DI void init(int nM_, int nN_, int G_, int c_, int pn_off_, int extra_ = 0, int pm0x_ = 0, int pn0x_ = 0) { nM = nM_; nN = nN_; nwg = nM * nN; G = G_; c = c_; pn_off = pn_off_; extra = extra_; pm0x = pm0x_; pn0x = pn0x_; skip0_lo = 0; skip0_n = 0; skip_lo = 0; skip_n = 0; skip2_lo = 0; skip2_n = 0; }
    DI bool next(int i, Unit& u) const {
        long L = (long)i * G + c;
        if (L < nwg) {
            int wgid = (int)L; { const int q = nwg / NXCD, r = nwg % NXCD, xcd = wgid % NXCD, off = wgid / NXCD; wgid = (xcd < r ? xcd * (q + 1) : r * (q + 1) + (xcd - r) * q) + off; }
            const int nig = WGM * nN, gid = wgid / nig, fm = gid * WGM, gsz = (nM - fm) < WGM ? (nM - fm) : WGM;
            u.pm = fm + ((wgid % nig) % gsz); u.pn = pn_off + (wgid % nig) / gsz; if (skip0_n && u.pn >= skip0_lo) u.pn += skip0_n; if (skip_n && u.pn >= skip_lo) u.pn += skip_n; if (skip2_n && u.pn >= skip2_lo) u.pn += skip2_n; return true;
        }
        L -= nwg; if (L >= extra) return false;
        u.pm = pm0x + (int)(L >> 3); u.pn = pn0x + (int)(L & 7); return true;
    }
};

template <int MODE = 0, class Epi>
DI void gemm_phase(LAS unsigned char* lds, const Gemm g, const Order& S, const Epi& E) {
    constexpr bool FP8 = (MODE == 1);
    const int tid = opaque_tid(), wid = __builtin_amdgcn_readfirstlane(tid >> 6), lane = tid & 63, wr = wid >> 2, wc = wid & 3, fr = lane & 15, fq = lane >> 4;
    const int K = g.K, nt = g.ntile ? g.ntile : K / BK;
    unsigned voffA[2], voffB[2];
#pragma unroll
    for (int i = 0; i < 2; ++i) { int R, C; stage_rc(tid * 16 + i * 8192, R, C); const int Rb = (R & ~31) + perm32(R & 31);
        voffA[i] = (unsigned)(R * K + C) * 2u; voffB[i] = (unsigned)(Rb * K + C) * 2u; }
    const size_t kstep = (size_t)(BK * 2);
    const size_t hstep = (size_t)HALF * K * 2;
    const size_t tstep = 2 * hstep;
    const unsigned ldsw = (unsigned)wid * 1024u;
    const int aoff = lds_byte(wr * 64 + fr, fq * 8), boff = lds_byte(wc * 32 + fr, fq * 8);
#define PG8_SA(b, h) (((b) * 2 + (h)) * HTB)
#define PG8_SB(b, h) ((4 + (b) * 2 + (h)) * HTB)
#define PG8_STAGE(bufoff, gbase, voff) do { _Pragma("unroll") for (int _i = 0; _i < 2; ++_i) \
        __builtin_amdgcn_global_load_lds((const unsigned*)((const char*)(gbase) + (voff)[_i]), (LAS unsigned*)(lds + (bufoff) + ldsw + _i * 8192), 16, 0, 0); } while (0)
#define PG8_LD16(off) (*(const LAS i32x4*)(lds + (off)))
#define PG8_LDA(dst, b, h) do { if constexpr (FP8) { _Pragma("unroll") for (int m = 0; m < 4; ++m) dst##8[m] = __builtin_shufflevector(PG8_LD16(PG8_SA(b, h) + aoff + m * 2048), PG8_LD16(PG8_SA(b, h) + aoff + m * 2048 + 1024), 0, 1, 2, 3, 4, 5, 6, 7); } \
        else { _Pragma("unroll") for (int m = 0; m < 4; ++m) _Pragma("unroll") for (int k = 0; k < 2; ++k) dst[m][k] = *(const LAS bf16x8*)(lds + PG8_SA(b, h) + aoff + m * 2048 + k * 1024); } } while (0)
#define PG8_LDB(dst, b, h) do { if constexpr (FP8) { _Pragma("unroll") for (int n = 0; n < 2; ++n) dst##8[n] = __builtin_shufflevector(PG8_LD16(PG8_SB(b, h) + boff + n * 2048), PG8_LD16(PG8_SB(b, h) + boff + n * 2048 + 1024), 0, 1, 2, 3, 4, 5, 6, 7); } \
        else { _Pragma("unroll") for (int n = 0; n < 2; ++n) _Pragma("unroll") for (int k = 0; k < 2; ++k) dst[n][k] = *(const LAS bf16x8*)(lds + PG8_SB(b, h) + boff + n * 2048 + k * 1024); } } while (0)
#define PG8_MMA(ai, bj, At, Bt) do { __builtin_amdgcn_s_setprio(1); \
        if constexpr (FP8) { _Pragma("unroll") for (int m = 0; m < 4; ++m) _Pragma("unroll") for (int n = 0; n < 2; ++n) \
            asm volatile("v_mfma_scale_f32_16x16x128_f8f6f4 %0, %1, %2, %0, %3, %4 op_sel_hi:[0,0,0]" : "+v"(acc[ai][bj][m][n]) : "v"(Bt##8[n]), "v"(At##8[m]), "v"(sc_w), "v"(sc_1)); } \
        else if constexpr (MODE == 2) { _Pragma("unroll") for (int m = 0; m < 4; ++m) _Pragma("unroll") for (int n = 0; n < 2; ++n) _Pragma("unroll") for (int k = 0; k < 2; ++k) \
            acc[ai][bj][m][n] = __builtin_bit_cast(f32x4, __builtin_amdgcn_mfma_i32_16x16x64_i8(__builtin_bit_cast(i32x4, Bt[n][k]), __builtin_bit_cast(i32x4, At[m][k]), __builtin_bit_cast(i32x4, acc[ai][bj][m][n]), 0, 0, 0)); } \
        else { _Pragma("unroll") for (int m = 0; m < 4; ++m) _Pragma("unroll") for (int n = 0; n < 2; ++n) _Pragma("unroll") for (int k = 0; k < 2; ++k) \
            acc[ai][bj][m][n] = __builtin_amdgcn_mfma_f32_16x16x32_bf16(Bt[n][k], At[m][k], acc[ai][bj][m][n], 0, 0, 0); } \
        __builtin_amdgcn_s_setprio(0); } while (0)
#define PG8_WAIT_V(n) asm volatile("s_waitcnt vmcnt(" #n ")" ::: "memory")
#define PG8_WAIT_L(n) asm volatile("s_waitcnt lgkmcnt(" #n ")" ::: "memory")
#define PG8_BAR __builtin_amdgcn_s_barrier()
#define PG8_SCHED __builtin_amdgcn_sched_barrier(0)
    Unit cur, nxt; int ui = 0;
    if (!S.next(0, cur)) return;
    f32x4 acc[2][2][4][2];
#pragma unroll
    for (int a = 0; a < 2; ++a)
#pragma unroll
        for (int b = 0; b < 2; ++b)
#pragma unroll
            for (int m = 0; m < 4; ++m)
#pragma unroll
                for (int n = 0; n < 2; ++n) acc[a][b][m][n] = (f32x4){0.f, 0.f, 0.f, 0.f};
    bf16x8 At[4][2], B0[2][2], B1[2][2];
    const int sc_w = 0x79797979, sc_1 = g.sca;
    i32x8 At8[4], B08[2], B18[2];
    const char* cA = (const char*)g.A + (size_t)cur.pm * tstep; const char* cB = (const char*)g.Bt + (size_t)cur.pn * tstep;
    PG8_STAGE(PG8_SB(0, 0), cB, voffB); PG8_STAGE(PG8_SB(0, 1), cB + hstep, voffB); PG8_STAGE(PG8_SA(0, 0), cA, voffA); PG8_STAGE(PG8_SA(0, 1), cA + hstep, voffA);
    if (wr == 1) PG8_BAR;
    PG8_WAIT_V(2); PG8_BAR;
    PG8_STAGE(PG8_SB(1, 0), cB + kstep, voffB); PG8_STAGE(PG8_SA(1, 0), cA + kstep, voffA); PG8_STAGE(PG8_SB(1, 1), cB + hstep + kstep, voffB);
    PG8_WAIT_V(6); PG8_BAR;
    for (;;) {
        const bool has_next = S.next(ui + 1, nxt);
        const char* nA = has_next ? (const char*)g.A + (size_t)nxt.pm * tstep : cA; const char* nB = has_next ? (const char*)g.Bt + (size_t)nxt.pn * tstep : cB;
        for (int t = 0; t < nt; t += 2) {
            const bool last = (t == nt - 2);
            const char* a1 = cA + (size_t)(t + 1) * kstep;
            const char* a2 = last ? nA : cA + (size_t)(t + 2) * kstep; const char* b2 = last ? nB : cB + (size_t)(t + 2) * kstep;
            const char* a3 = a2 + kstep; const char* b3 = b2 + kstep;
            PG8_LDB(B0, 0, 0); PG8_LDB(B1, 0, 1); PG8_SCHED; PG8_LDA(At, 0, 0); PG8_STAGE(PG8_SA(1, 1), a1 + hstep, voffA);
            PG8_WAIT_V(8); PG8_WAIT_L(0); PG8_BAR; PG8_MMA(0, 0, At, B0); PG8_MMA(0, 1, At, B1); PG8_BAR; PG8_SCHED;
            PG8_LDA(At, 0, 1); PG8_STAGE(PG8_SB(0, 0), b2, voffB); PG8_STAGE(PG8_SB(0, 1), b2 + hstep, voffB); PG8_STAGE(PG8_SA(0, 0), a2, voffA);
            PG8_WAIT_V(8); PG8_WAIT_L(0); PG8_BAR; PG8_MMA(1, 0, At, B0); PG8_MMA(1, 1, At, B1); PG8_BAR; PG8_SCHED;
            PG8_LDB(B0, 1, 0); PG8_LDB(B1, 1, 1); PG8_SCHED; PG8_LDA(At, 1, 0); PG8_STAGE(PG8_SA(0, 1), a2 + hstep, voffA);
            PG8_WAIT_V(8); PG8_WAIT_L(0); PG8_BAR; PG8_MMA(0, 0, At, B0); PG8_MMA(0, 1, At, B1); PG8_BAR; PG8_SCHED;
            PG8_LDA(At, 1, 1); PG8_STAGE(PG8_SB(1, 0), b3, voffB); PG8_STAGE(PG8_SB(1, 1), b3 + hstep, voffB); PG8_STAGE(PG8_SA(1, 0), a3, voffA);
            PG8_WAIT_V(8); PG8_WAIT_L(0); PG8_BAR; PG8_MMA(1, 0, At, B0); PG8_MMA(1, 1, At, B1); PG8_BAR; PG8_SCHED;
        }
        if (wr == 0) PG8_BAR;
        if constexpr (FP8) asm volatile("s_nop 15\n\ts_nop 15" ::: "memory");
        E(acc, cur, wr, wc, fr, fq);
        if (!has_next) break;
#pragma unroll
        for (int a = 0; a < 2; ++a)
#pragma unroll
            for (int b = 0; b < 2; ++b)
#pragma unroll
                for (int m = 0; m < 4; ++m)
#pragma unroll
                    for (int n = 0; n < 2; ++n) acc[a][b][m][n] = (f32x4){0.f, 0.f, 0.f, 0.f};
        cur = nxt; cA = nA; cB = nB; ++ui;
        if (wr == 1) PG8_BAR;
    }
    PG8_WAIT_V(0);
    PG8_BAR;
#undef PG8_SA
#undef PG8_SB
#undef PG8_STAGE
#undef PG8_LDA
#undef PG8_LD16
#undef PG8_LDB
#undef PG8_MMA
#undef PG8_WAIT_V
#undef PG8_WAIT_L
#undef PG8_BAR
#undef PG8_SCHED
}
typedef f32x4 Acc[2][2][4][2];

struct EpiProj {
    unsigned char* ws; const float* bias; int shift_lo, shift; float qs;
    DI void operator()(const Acc& acc, const Unit& u, int wr, int wc, int fr, int fq) const {
        int row0 = u.pm * BM + wr * 64 + fr; const int pn = u.pn >= shift_lo ? u.pn + shift : u.pn;
        bf16_t* base; int ldc, ct; const float* bp = bias + pn * BM;
        if (u.pm >= 128) { base = (bf16_t*)(ws + WS_MKV); ldc = 2048; ct = pn - PN_KV; row0 -= T; bp = nullptr; }
        else if (pn < 6) { base = (bf16_t*)(ws + WS_QK1); ldc = 1536; ct = pn; }
        else if (pn < 12) { base = (bf16_t*)(ws + WS_V1); ldc = 1536; ct = pn - 6; }
        else if (pn < 18) { base = (bf16_t*)(ws + WS_QK2); ldc = 1536; ct = pn - 12; }
        else if (pn < 24) { base = (bf16_t*)(ws + WS_V2); ldc = 1536; ct = pn - 18; }
        else if (pn < 30) { base = (bf16_t*)(ws + WS_O1); ldc = 1536; ct = pn - 24; }
        else if (pn < 34) { base = (bf16_t*)(ws + WS_Q3); ldc = 1024; ct = pn - 30; }
        else if (pn < 40) { base = (bf16_t*)(ws + WS_Z1); ldc = 1536; ct = pn - 34; }
        else if (pn < 46) { base = (bf16_t*)(ws + WS_Z2); ldc = 1536; ct = pn - 40; }
        else if (pn < 50) { base = (bf16_t*)(ws + WS_Z3); ldc = 1024; ct = pn - 46; }
        else {
            if (wc == 0 && fq < 2) {
                float* IFp = (float*)(ws + WS_IF);
                const f32x4 b0 = *(const f32x4*)(bp + 8 * fq), b1 = *(const f32x4*)(bp + 8 * fq + 4);
#pragma unroll
                for (int ai = 0; ai < 2; ++ai)
#pragma unroll
                    for (int m = 0; m < 4; ++m) { float* rp = IFp + (size_t)(row0 + ai * HALF + m * 16) * 16 + 8 * fq;
                        *(f32x4*)rp = acc[ai][0][m][0] + b0; *(f32x4*)(rp + 4) = acc[ai][0][m][1] + b1; }
            }
            return;
        }
        const int col0 = ct * BM + wc * 32 + 8 * fq, bc0 = wc * 32 + 8 * fq;
        f32x4 bv[2][2];
#pragma unroll
        for (int bj = 0; bj < 2; ++bj)
#pragma unroll
            for (int n = 0; n < 2; ++n) bv[bj][n] = bp ? *(const f32x4*)(bp + bc0 + bj * HALF + 4 * n) : (f32x4){0.f, 0.f, 0.f, 0.f};
#pragma unroll
        for (int ai = 0; ai < 2; ++ai)
#pragma unroll
            for (int m = 0; m < 4; ++m) { bf16_t* rowp = base + (size_t)(row0 + ai * HALF + m * 16) * ldc + col0;
#pragma unroll
                for (int bj = 0; bj < 2; ++bj) { const f32x4 v0 = deq_acc(acc[ai][bj][m][0], qs) + bv[bj][0], v1 = deq_acc(acc[ai][bj][m][1], qs) + bv[bj][1];
                    u32x4 w; w.x = cvt_pk_bf16(v0[0], v0[1]); w.y = cvt_pk_bf16(v0[2], v0[3]); w.z = cvt_pk_bf16(v1[0], v1[1]); w.w = cvt_pk_bf16(v1[2], v1[3]);
                    *(u32x4*)(rowp + bj * HALF) = w; } }
    }
};
struct EpiGate {
    unsigned char* ws; const float* bias; float qs;
    DI void operator()(const Acc& acc, const Unit& u, int wr, int wc, int fr, int fq) const {
        const int row0 = u.pm * BM + wr * 64 + fr; const float* bp = bias + (PN_GATE + u.pn) * BM + wc * 32 + 8 * fq;
        const int ct = u.pn, gi = ct >> 3; bf16_t* G = (bf16_t*)(ws + (gi == 0 ? WS_G0 : WS_G12 + (size_t)(gi - 1) * SZ20));
        const int col0 = (ct & 7) * BM + wc * 32 + 8 * fq;
        f32x4 bv[2][2];
#pragma unroll
        for (int bj = 0; bj < 2; ++bj)
#pragma unroll
            for (int n = 0; n < 2; ++n) bv[bj][n] = *(const f32x4*)(bp + bj * HALF + 4 * n);
#pragma unroll
        for (int ai = 0; ai < 2; ++ai)
#pragma unroll
            for (int m = 0; m < 4; ++m) { bf16_t* rowp = G + (size_t)(row0 + ai * HALF + m * 16) * 2048 + col0;
#pragma unroll
                for (int bj = 0; bj < 2; ++bj) { f32x4 v0 = deq_acc(acc[ai][bj][m][0], qs) + bv[bj][0], v1 = deq_acc(acc[ai][bj][m][1], qs) + bv[bj][1];
#pragma unroll
                    for (int e = 0; e < 4; ++e) { v0[e] = sigmoidf_(v0[e]); v1[e] = sigmoidf_(v1[e]); }
                    u32x4 w; w.x = cvt_pk_bf16(v0[0], v0[1]); w.y = cvt_pk_bf16(v0[2], v0[3]); w.z = cvt_pk_bf16(v1[0], v1[1]); w.w = cvt_pk_bf16(v1[2], v1[3]);
                    *(u32x4*)(rowp + bj * HALF) = w; } }
    }
};
struct EpiMerge {
    bf16_t* merged; const bf16_t* G; int gi;
    DI void operator()(const Acc& acc, const Unit& u, int wr, int wc, int fr, int fq) const {
        const int row0 = u.pm * BM + wr * 64 + fr, col0 = u.pn * BM + wc * 32 + 8 * fq;
#pragma unroll
        for (int ai = 0; ai < 2; ++ai)
#pragma unroll
            for (int m = 0; m < 4; ++m) { const size_t r = (size_t)(row0 + ai * HALF + m * 16);
#pragma unroll
                for (int bj = 0; bj < 2; ++bj) {
                    const u32x4 gv = *(const u32x4*)(G + r * 2048 + col0 + bj * HALF);
                    bf16_t* mp = merged + r * 2048 + col0 + bj * HALF;
                    const f32x4 a0 = acc[ai][bj][m][0], a1 = acc[ai][bj][m][1];
                    float o[8] = {a0[0] * bflo(gv.x), a0[1] * bfhi(gv.x), a0[2] * bflo(gv.y), a0[3] * bfhi(gv.y), a1[0] * bflo(gv.z), a1[1] * bfhi(gv.z), a1[2] * bflo(gv.w), a1[3] * bfhi(gv.w)};
                    if (gi > 0) { const u32x4 pv = __builtin_nontemporal_load((const u32x4*)mp);
                        o[0] += bflo(pv.x); o[1] += bfhi(pv.x); o[2] += bflo(pv.y); o[3] += bfhi(pv.y); o[4] += bflo(pv.z); o[5] += bfhi(pv.z); o[6] += bflo(pv.w); o[7] += bfhi(pv.w); }
                    u32x4 w; w.x = cvt_pk_bf16(o[0], o[1]); w.y = cvt_pk_bf16(o[2], o[3]); w.z = cvt_pk_bf16(o[4], o[5]); w.w = cvt_pk_bf16(o[6], o[7]);
                    *(u32x4*)mp = w; } }
    }
};
struct EpiOut {
    bf16_t* D;
    DI void operator()(const Acc& acc, const Unit& u, int wr, int wc, int fr, int fq) const {
        const int row0 = u.pm * BM + wr * 64 + fr, col0 = u.pn * BM + wc * 32 + 8 * fq;
#pragma unroll
        for (int ai = 0; ai < 2; ++ai)
#pragma unroll
            for (int m = 0; m < 4; ++m) { bf16_t* rowp = D + (size_t)(row0 + ai * HALF + m * 16) * 2048 + col0;
#pragma unroll
                for (int bj = 0; bj < 2; ++bj) { const f32x4 v0 = acc[ai][bj][m][0], v1 = acc[ai][bj][m][1];
                    u32x4 w; w.x = cvt_pk_bf16(v0[0], v0[1]); w.y = cvt_pk_bf16(v0[2], v0[3]); w.z = cvt_pk_bf16(v1[0], v1[1]); w.w = cvt_pk_bf16(v1[2], v1[3]);
                    *(u32x4*)(rowp + bj * HALF) = w; } }
    }
};
}

DI int src_col_of(int n) {
    if (n < 3072) return n;
    if (n < 4608) return n - 3072 + 6156;
    if (n < 6144) return n - 4608 + 7692;
    if (n < 7680) return n - 6144 + 3072;
    if (n < 8704) return n - 7680 + 10764;
    if (n < 10240) return n - 8704 + 4608;
    if (n < 11776) return n - 10240 + 9228;
    if (n < 12800) return n - 11776 + 11788;
    if (n < 12812) return n - 12800 + 6144;
    if (n < 13056) return -1;
    return n - 13056 + 12812;
}
struct TpItem { const float* W; bf16_t* WT; unsigned char* W8; int Nsrc, K, n0, k0, remap, n8, m8; };
DI bool tp_decode(const Params& P, int it, TpItem& t) {
    constexpr int I_IN = 300 * 8, I_KV = 32 * 8, I_ML = 32 * 6, I_RET = 32 * 6, I_XA = 32 * 4, I_OUT = 32 * 8;
    unsigned char* ws = P.ws; int r = it; t.remap = 0; t.W8 = nullptr; t.n8 = 0; t.m8 = 2;
    if (r < I_IN) { t.W = P.w_in; t.WT = (bf16_t*)(ws + WS_WIN); t.Nsrc = N_IN; t.K = 2048; t.n0 = (r >> 3) * 64; t.k0 = (r & 7) * 256; t.remap = 1;
        if (t.n0 >= 1536 && t.n0 < 3072) { t.W8 = ws + WS_WV8; t.n8 = t.n0 - 1536; }
        else if (t.n0 >= 6144 && t.n0 < 10240) { t.W8 = (unsigned char*)P.out + DO_WO8; t.n8 = t.n0 - 6144; }
        else if (t.n0 >= 11776 && t.n0 < 12800) { t.W8 = (unsigned char*)P.out + DO_WO8; t.n8 = t.n0 - 11776 + 4096; }
        else if (t.n0 >= 13056) { t.W8 = (unsigned char*)P.out + DO_WG8; t.n8 = t.n0 - 13056; }
        return true; } r -= I_IN;
    if (r < I_KV) { t.W = P.w_kv; t.WT = (bf16_t*)(ws + WS_WKV); t.Nsrc = 2048; t.K = 2048; t.n0 = (r >> 3) * 64; t.k0 = (r & 7) * 256; return true; } r -= I_KV;
    if (r < I_ML) { t.W = P.w_ml; t.WT = (bf16_t*)(ws + WS_WML); t.Nsrc = 2048; t.K = 1536; t.n0 = (r / 6) * 64; t.k0 = (r % 6) * 256; return true; } r -= I_ML;
    if (r < I_RET) { t.W = P.w_ret; t.WT = (bf16_t*)(ws + WS_WRET); t.Nsrc = 2048; t.K = 1536; t.n0 = (r / 6) * 64; t.k0 = (r % 6) * 256; return true; } r -= I_RET;
    if (r < I_XA) { t.W = P.w_xa; t.WT = (bf16_t*)(ws + WS_WXA); t.Nsrc = 2048; t.K = 1024; t.n0 = (r >> 2) * 64; t.k0 = (r & 3) * 256; t.W8 = (unsigned char*)P.out + DO_WX8; t.n8 = t.n0; t.m8 = 1; return true; } r -= I_XA;
    if (r < I_OUT) { t.W = P.w_out; t.WT = (bf16_t*)(ws + WS_WOUT); t.Nsrc = 2048; t.K = 2048; t.n0 = (r >> 3) * 64; t.k0 = (r & 7) * 256; return true; }
    return false;
}
DI void tp_load(const TpItem& t, int tid, f32x4 (&v)[8]) {
    const int nq = tid & 15, kk0 = tid >> 4; const int src = t.remap ? src_col_of(t.n0 + 4 * nq) : (t.n0 + 4 * nq);
#pragma unroll
    for (int i = 0; i < 8; ++i) v[i] = src >= 0 ? *(const f32x4*)(t.W + (size_t)(t.k0 + kk0 + 32 * i) * t.Nsrc + src) : (f32x4){0.f, 0.f, 0.f, 0.f};
}
DI void p0_transposes(const Params& P, LAS unsigned char* lds) {
    const int tid = opaque_tid(), G = gridDim.x, bx = blockIdx.x, nq = tid & 15, kk0 = tid >> 4;
    LAS bf16_t* tile = (LAS bf16_t*)lds;
    TpItem cur, nxt; f32x4 v[8];
    int it = bx; bool have = tp_decode(P, it, cur);
    if (have) tp_load(cur, tid, v);
    while (have) {
        if (cur.W8) {
#pragma unroll
            for (int i = 0; i < 8; ++i) { const int kk = kk0 + 32 * i; unsigned q = 0u;
                if (cur.m8 == 2) q = pack_i8x4(v[i][0], v[i][1], v[i][2], v[i][3], W8_SCALE);
                else { q = __builtin_amdgcn_cvt_pk_fp8_f32(v[i][0] * 64.f, v[i][1] * 64.f, q, false); q = __builtin_amdgcn_cvt_pk_fp8_f32(v[i][2] * 64.f, v[i][3] * 64.f, q, true); }
#pragma unroll
                for (int e = 0; e < 4; ++e) *(LAS unsigned char*)(lds + (4 * nq + e) * 272 + kk) = (unsigned char)(q >> (8 * e)); }
        } else {
#pragma unroll
            for (int i = 0; i < 8; ++i) { const int kk = kk0 + 32 * i;
#pragma unroll
                for (int e = 0; e < 4; ++e) tile[(4 * nq + e) * 264 + kk] = (bf16_t)(cvt_pk_bf16(v[i][e], 0.f) & 0xffffu); }
        }
        __syncthreads();
        it += G; const bool hn = tp_decode(P, it, nxt);
        if (hn) tp_load(nxt, tid, v);
        if (cur.W8) {
#pragma unroll
            for (int j = 0; j < 2; ++j) { const int p = tid + 512 * j, n2 = p >> 4, kq = p & 15; const u32x4 tv = *(const LAS u32x4*)(lds + n2 * 272 + kq * 16); *(u32x4*)(cur.W8 + (size_t)(cur.n8 + n2) * cur.K + cur.k0 + 16 * kq) = tv; }
        } else {
#pragma unroll
            for (int j = 0; j < 4; ++j) { const int p = tid + 512 * j, n2 = p >> 5, kq = p & 31; const u32x4 tv = *(const LAS u32x4*)(lds + n2 * 528 + kq * 16); *(u32x4*)(cur.WT + (size_t)(cur.n0 + n2) * cur.K + cur.k0 + 8 * kq) = tv; }
        }
        __syncthreads();
        cur = nxt; have = hn;
    }
}
DI void rms_row(const float* xr, const float* g, bf16_t* o, unsigned char* o8, int lane) {
    f32x4 v[8]; float s = 0.f;
#pragma unroll
    for (int i = 0; i < 8; ++i) { v[i] = *(const f32x4*)(xr + 4 * (lane + 64 * i)); s += v[i][0] * v[i][0] + v[i][1] * v[i][1] + v[i][2] * v[i][2] + v[i][3] * v[i][3]; }
    s = wave_sum(s); const float sc = rsqrtf(s * (1.0f / 2048.0f) + EPS);
#pragma unroll
    for (int i = 0; i < 8; ++i) { const f32x4 gg = *(const f32x4*)(g + 4 * (lane + 64 * i)); const f32x4 y = v[i] * sc * gg;
        u32x2 w; w.x = cvt_pk_bf16(y[0], y[1]); w.y = cvt_pk_bf16(y[2], y[3]); *(u32x2*)(o + 4 * (lane + 64 * i)) = w;
        if (o8) *(unsigned*)(o8 + 4 * (lane + 64 * i)) = pack_i8x4(y[0], y[1], y[2], y[3], H8_SCALE); }
}
DI void p0_prologue(const Params& P, LAS unsigned char* lds) {
    const int tid = opaque_tid(), lane = tid & 63, wave = tid >> 6, G = gridDim.x, bx = blockIdx.x;
    unsigned char* ws = P.ws;
    if (bx == 0 && tid < 64) ((unsigned*)(ws + WS_CTL))[tid] = 0u;
    if (bx == 0) for (int i = tid; i < 3456; i += 512) ((unsigned*)(ws + WS_BAR))[i] = 0u;
    for (int i = bx * 512 + tid; i < T; i += G * 512) ((float*)(ws + WS_SS))[i] = 0.f;
    for (int i = bx * 512 + tid; i < NPAD; i += G * 512) { const int s = src_col_of(i); ((float*)(ws + WS_BIAS))[i] = s >= 0 ? P.b_in[s] : 0.f; }
    bf16_t* H = (bf16_t*)((unsigned char*)P.out + DO_H);
    for (int r = bx * 8 + wave; r < T + 2048; r += G * 8) {
        if (r < T) rms_row(P.x + (size_t)r * DM, P.ln_g, H + (size_t)r * DM, ws + WS_H8 + (size_t)r * DM, lane);
        else rms_row(P.mem + (size_t)(r - T) * DM, P.mem_ln_g, H + (size_t)r * DM, nullptr, lane);
    }
    p0_transposes(P, lds);
}

DI float logsigmoidf_(float v) { return fminf(v, 0.f) - log1pf(expf(-fabsf(v))); }
DI void p2_gates_wg(const Params& P, int bh, LAS unsigned char* lds) {
    const int tid = opaque_tid(), lane = tid & 63, wave = tid >> 6;
    unsigned char* ws = P.ws; const int b = bh / 6, h = bh % 6;
    const float* IFp = (const float*)(ws + WS_IF) + (size_t)b * SEQ * 16;
    float* A1 = (float*)(ws + WS_GS) + (size_t)bh * SEQ; float* IB = A1 + GS_ARR; float* INTER = IB + GS_ARR; float* EDEN = INTER + GS_ARR; float* W = EDEN + GS_ARR;
    float* DEC = (float*)(ws + WS_GDEC) + bh * 64;
    LAS f32x2* AB = (LAS f32x2*)lds;
    float iv[8], fv[8], bbv[8], ibv[8], mxv[8], gv[8], mxa[8];
#pragma unroll
    for (int k = 0; k < 8; ++k) { const int t = (wave * 8 + k) * 64 + lane; iv[k] = IFp[(size_t)t * 16 + h]; fv[k] = IFp[(size_t)t * 16 + 6 + h]; }
#pragma unroll
    for (int k = 0; k < 8; ++k) {
        float bb = logsigmoidf_(fv[k]);
#pragma unroll
        for (int o = 1; o < 64; o <<= 1) { const float u = __shfl_up(bb, o); if (lane >= o) bb += u; }
        const float g = __shfl(bb, 63), ib = iv[k] - bb;
        float mx = ib;
#pragma unroll
        for (int o = 1; o < 64; o <<= 1) { const float u = __shfl_up(mx, o); if (lane >= o) mx = fmaxf(mx, u); }
        const float mxall = __shfl(mx, 63);
        bbv[k] = bb; ibv[k] = ib; mxv[k] = mx; gv[k] = g; mxa[k] = mxall;
        if (lane == 0) AB[wave * 8 + k] = (f32x2){g, g + mxall};
        __builtin_amdgcn_sched_barrier(0);
    }
    __syncthreads();
    float m = 0.f;
    for (int c = 0; c < wave * 8; ++c) { const f32x2 ab = AB[c]; m = fmaxf(m + ab.x, ab.y); }
#pragma unroll
    for (int k = 0; k < 8; ++k) {
        const int c = wave * 8 + k, t = c * 64 + lane;
        const float log_inter = bbv[k] + m, m_row = fmaxf(log_inter, bbv[k] + mxv[k]);
        const float m_new = fmaxf(gv[k] + m, gv[k] + mxa[k]);
        A1[t] = bbv[k] - m_row; IB[t] = ibv[k]; INTER[t] = expf(log_inter - m_row); EDEN[t] = expf(-m_row); W[t] = expf(gv[k] + ibv[k] - m_new);
        if (lane == 0) DEC[c] = expf(gv[k] + m - m_new);
        m = m_new;
        __builtin_amdgcn_sched_barrier(0);
    }
    __syncthreads();
}
DI void p2_prep(const Params& P, LAS unsigned char* lds) {
    const int tid = opaque_tid(), lane = tid & 63, wave = tid >> 6, G = gridDim.x, bx = blockIdx.x;
    unsigned char* ws = P.ws;
    for (int it = bx; it < 48; it += G) p2_gates_wg(P, it, lds);
    if (bx == (G > 48 ? 48 : 0) && tid < 6 * 64) {
        const int h = tid >> 6, l = tid & 63; const float lg = logf(1.0f - exp2f(-5.0f - (float)h));
        float* RV = (float*)(ws + WS_RV) + h * 5 * 64;
        RV[l] = (float)l * lg; RV[64 + l] = -(float)l * lg; RV[128 + l] = expf((float)(l + 1) * lg); RV[192 + l] = 1.0f; RV[256 + l] = expf((float)(63 - l) * lg);
        if (l == 0) ((float*)(ws + WS_RV))[6 * 5 * 64 + h] = expf(64.0f * lg);
    }
    const bf16_t* QK1 = (const bf16_t*)(ws + WS_QK1); bf16_t* QKC = (bf16_t*)((unsigned char*)P.out + DO_QKC);
    for (int idx = bx * 512 + tid; idx < (T / 16) * 192; idx += G * 512) {
        const int rb = idx / 192, cgp = idx % 192, r0 = rb * 16, c0 = cgp * 8;
        float w[4][8], bz[8], u[3][8];
#pragma unroll
        for (int k = 0; k < 4; ++k) { const f32x4 a = *(const f32x4*)(P.conv_w + k * 1536 + c0), b = *(const f32x4*)(P.conv_w + k * 1536 + c0 + 4);
            w[k][0] = a[0]; w[k][1] = a[1]; w[k][2] = a[2]; w[k][3] = a[3]; w[k][4] = b[0]; w[k][5] = b[1]; w[k][6] = b[2]; w[k][7] = b[3]; }
        { const f32x4 a = *(const f32x4*)(P.conv_b + c0), b = *(const f32x4*)(P.conv_b + c0 + 4); bz[0] = a[0]; bz[1] = a[1]; bz[2] = a[2]; bz[3] = a[3]; bz[4] = b[0]; bz[5] = b[1]; bz[6] = b[2]; bz[7] = b[3]; }
        const bool hist = (r0 & (SEQ - 1)) != 0;
#pragma unroll
        for (int k = 0; k < 3; ++k) {
            u32x4 v = (u32x4){0u, 0u, 0u, 0u}; if (hist) v = *(const u32x4*)(QK1 + (size_t)(r0 - 3 + k) * 1536 + c0);
            u[k][0] = bflo(v.x); u[k][1] = bfhi(v.x); u[k][2] = bflo(v.y); u[k][3] = bfhi(v.y); u[k][4] = bflo(v.z); u[k][5] = bfhi(v.z); u[k][6] = bflo(v.w); u[k][7] = bfhi(v.w); }
        const float sc = c0 < 768 ? 0.08838834764831845f : 1.0f;
        for (int rh = 0; rh < 16; rh += 8) {
        u32x4 rows[8];
#pragma unroll
        for (int r = 0; r < 8; ++r) rows[r] = *(const u32x4*)(QK1 + (size_t)(r0 + rh + r) * 1536 + c0);
#pragma unroll
        for (int rr = 0; rr < 8; ++rr) { const int r = rh + rr;
            const u32x4 v = rows[rr];
            const float cu[8] = {bflo(v.x), bfhi(v.x), bflo(v.y), bfhi(v.y), bflo(v.z), bfhi(v.z), bflo(v.w), bfhi(v.w)};
            float y[8];
#pragma unroll
            for (int e = 0; e < 8; ++e) { const float a = bz[e] + w[0][e] * u[0][e] + w[1][e] * u[1][e] + w[2][e] * u[2][e] + w[3][e] * cu[e]; y[e] = siluf_(a) * sc; u[0][e] = u[1][e]; u[1][e] = u[2][e]; u[2][e] = cu[e]; }
            u32x4 o; o.x = cvt_pk_bf16(y[0], y[1]); o.y = cvt_pk_bf16(y[2], y[3]); o.z = cvt_pk_bf16(y[4], y[5]); o.w = cvt_pk_bf16(y[6], y[7]);
            *(u32x4*)(QKC + (size_t)(r0 + r) * 1536 + c0) = o;
        }
        }
    }
    bf16_t* QK2 = (bf16_t*)(ws + WS_QK2);
    for (int idx = bx * 512 + tid; idx < T * 8; idx += G * 512) {
        const int tok = idx >> 3, dg = idx & 7; const float pos = (float)P.pos[tok];
        float cs[8], sn[8];
#pragma unroll
        for (int j = 0; j < 8; ++j) { const float fr = exp2f(-(float)(dg * 8 + j) * (13.287712379549449f / 64.0f)); const float ang = pos * fr;
            double rev = (double)ang * 0.15915494309189535; rev -= rint(rev); const float rf = (float)rev;
            sn[j] = __builtin_amdgcn_sinf(rf); cs[j] = __builtin_amdgcn_cosf(rf); }
        for (int hg = 0; hg < 4; ++hg) {
            u32x4 la[3], lb[3];
#pragma unroll
            for (int k = 0; k < 3; ++k) { const bf16_t* p = QK2 + (size_t)tok * 1536 + (hg * 3 + k) * 128 + dg * 8; la[k] = *(const u32x4*)p; lb[k] = *(const u32x4*)(p + 64); }
#pragma unroll
            for (int k = 0; k < 3; ++k) {
                bf16_t* p = QK2 + (size_t)tok * 1536 + (hg * 3 + k) * 128 + dg * 8; const float sc = hg >= 2 ? 0.08838834764831845f : 1.0f;
                const u32x4 a = la[k], b = lb[k];
                const float t1[8] = {bflo(a.x), bfhi(a.x), bflo(a.y), bfhi(a.y), bflo(a.z), bfhi(a.z), bflo(a.w), bfhi(a.w)};
                const float t2[8] = {bflo(b.x), bfhi(b.x), bflo(b.y), bfhi(b.y), bflo(b.z), bfhi(b.z), bflo(b.w), bfhi(b.w)};
                float o1[8], o2[8];
#pragma unroll
                for (int j = 0; j < 8; ++j) { o1[j] = (t1[j] * cs[j] - t2[j] * sn[j]) * sc; o2[j] = (t1[j] * sn[j] + t2[j] * cs[j]) * sc; }
                u32x4 x1, x2; x1.x = cvt_pk_bf16(o1[0], o1[1]); x1.y = cvt_pk_bf16(o1[2], o1[3]); x1.z = cvt_pk_bf16(o1[4], o1[5]); x1.w = cvt_pk_bf16(o1[6], o1[7]);
                x2.x = cvt_pk_bf16(o2[0], o2[1]); x2.y = cvt_pk_bf16(o2[2], o2[3]); x2.z = cvt_pk_bf16(o2[4], o2[5]); x2.w = cvt_pk_bf16(o2[6], o2[7]);
                *(u32x4*)p = x1; *(u32x4*)(p + 64) = x2;
            }
        }
    }
}

constexpr int SQ_P = 272, SV_P = 528, ST_P = 144;
constexpr int SC_STAGE = 64 * SQ_P * 2 + 64 * SV_P;
constexpr int SC_ST = 2 * SC_STAGE;
constexpr int SC_NV = SC_ST + 64 * ST_P;
constexpr int SC_RDEN = SC_NV + 512;
constexpr int SC_LNP = SC_RDEN + 256;
constexpr int SC_VEC = SC_LNP + 4096;
constexpr int SC_GAIN = SC_VEC + 2560;
constexpr int SC_END = SC_GAIN + 1024;
static_assert(SC_END <= LDS_BYTES, "scan LDS");

DI void scan_item(const Params& P, LAS unsigned char* lds, int item) {
    const int tid = opaque_tid(), lane = tid & 63, w = __builtin_amdgcn_readfirstlane(tid >> 6), r = lane & 15, g = lane >> 4, q4 = r >> 2, p4 = r & 3;
    unsigned char* ws = P.ws;
    const bool is_ml = item < 48; const int bh = is_ml ? item : item - 48, b = bh / 6, h = bh % 6;
    const bf16_t* Qg = (is_ml ? (const bf16_t*)((unsigned char*)P.out + DO_QKC) : (const bf16_t*)(ws + WS_QK2)) + (size_t)b * SEQ * 1536 + h * 128;
    const bf16_t* Kg = Qg + 768;
    bf16_t* Vg = (bf16_t*)(ws + (is_ml ? WS_V1 : WS_V2)) + (size_t)b * SEQ * 1536 + h * 256;
    const float* vbase; const float* vDEC; int cstr, dstr; size_t vstr;
    if (is_ml) { vbase = (const float*)(ws + WS_GS) + (size_t)bh * SEQ; vstr = GS_ARR; vDEC = (const float*)(ws + WS_GDEC) + bh * 64; cstr = 64; dstr = 1; }
    else { vbase = (const float*)(ws + WS_RV) + h * 320; vstr = 64; vDEC = (const float*)(ws + WS_RV) + 6 * 320 + h; cstr = 0; dstr = 0; }
    const float* vptr = vbase + (size_t)(tid >> 6) * vstr + (tid & 63);
    const unsigned ldsb = (unsigned)(size_t)lds;
    f32x4 Cacc[8][2];
#pragma unroll
    for (int i = 0; i < 8; ++i) { Cacc[i][0] = (f32x4){0.f, 0.f, 0.f, 0.f}; Cacc[i][1] = (f32x4){0.f, 0.f, 0.f, 0.f}; }
    if (tid < 128) ((LAS float*)(lds + SC_NV))[tid] = 0.f;
    if (tid < 64) ((LAS float*)(lds + SC_RDEN))[tid] = 1.0f;
    u32x4 pq[2], pk[2], pv[4];
    unsigned qoff = (unsigned)(tid >> 4) * 3072u + (unsigned)(tid & 15) * 16u, voff = (unsigned)(tid >> 5) * 3072u + (unsigned)(tid & 31) * 16u, zoff = (unsigned)r * 3072u + (unsigned)(32 * w + 8 * g) * 2u;
#define SC_LOAD(c) do { const size_t cb = (size_t)(c) * 64 * 3072; const char* qb_ = (const char*)Qg + cb; const char* kb_ = (const char*)Kg + cb; const char* vb_ = (const char*)Vg + cb; \
        _Pragma("unroll") for (int i = 0; i < 2; ++i) { pq[i] = *(const u32x4*)(qb_ + (qoff + i * 98304u)); pk[i] = *(const u32x4*)(kb_ + (qoff + i * 98304u)); } \
        _Pragma("unroll") for (int i = 0; i < 4; ++i) { pv[i] = *(const u32x4*)(vb_ + (voff + i * 49152u)); } } while (0)
#define SC_STORE(st) do { LAS unsigned char* sb = lds + (st) * SC_STAGE; \
        _Pragma("unroll") for (int i = 0; i < 2; ++i) { const int pp = tid + 512 * i, row = pp >> 4, ch = pp & 15; *(LAS u32x4*)(sb + row * SQ_P + ch * 16) = pq[i]; *(LAS u32x4*)(sb + 64 * SQ_P + row * SQ_P + ch * 16) = pk[i]; } \
        _Pragma("unroll") for (int i = 0; i < 4; ++i) { const int pp = tid + 512 * i, row = pp >> 5, ch = pp & 31; *(LAS u32x4*)(sb + 128 * SQ_P + row * SV_P + ch * 16) = pv[i]; } } while (0)
    SC_LOAD(0); SC_STORE(0);
    if (tid < 320) ((LAS float*)(lds + SC_VEC))[tid] = vptr[0];
    __syncthreads();

    for (int c = 0; c < 64; ++c) {
        const int cur = c & 1;
        asm volatile("" : "+v"(qoff), "+v"(voff), "+v"(zoff));
        LAS unsigned char* Qs = lds + cur * SC_STAGE; LAS unsigned char* Ks = Qs + 64 * SQ_P; LAS unsigned char* Vs = Qs + 128 * SQ_P;
        const unsigned KsA = ldsb + cur * SC_STAGE + 64 * SQ_P, VsA = ldsb + cur * SC_STAGE + 128 * SQ_P;
        const LAS float* cA1 = (const LAS float*)(lds + SC_VEC + cur * 1280); const LAS float* cIB = cA1 + 64; const LAS float* cINT = cA1 + 128; const LAS float* cEDEN = cA1 + 192; const LAS float* cW = cA1 + 256;
        const float decay = vDEC[c * dstr];
        {
            const int mb = w >> 1, l = 16 * mb + r; const float a1 = cA1[l];
            bf16x8 qf[4];
#pragma unroll
            for (int ks = 0; ks < 4; ++ks) qf[ks] = *(const LAS bf16x8*)(Qs + l * SQ_P + (32 * ks + 8 * g) * 2);
#pragma unroll
            for (int nn = 0; nn < 2; ++nn) {
                const int nb = 2 * (w & 1) + nn; u32x2 o = (u32x2){0u, 0u};
                if (nb <= mb) {
                    f32x4 s = (f32x4){0.f, 0.f, 0.f, 0.f};
#pragma unroll
                    for (int ks = 0; ks < 4; ++ks) { const bf16x8 kf = *(const LAS bf16x8*)(Ks + (16 * nb + r) * SQ_P + (32 * ks + 8 * g) * 2); s = MFMA16(kf, qf[ks], s); }
                    const f32x4 ib = *(const LAS f32x4*)(cIB + 16 * nb + 4 * g);
                    float d[4];
#pragma unroll
                    for (int j = 0; j < 4; ++j) { const int sidx = 16 * nb + 4 * g + j; d[j] = (sidx <= l) ? s[j] * __expf(a1 + ib[j]) : 0.f; }
                    o.x = cvt_pk_bf16(d[0], d[1]); o.y = cvt_pk_bf16(d[2], d[3]);
                }
                *(LAS u32x2*)(lds + SC_ST + l * ST_P + (16 * nb + 4 * g) * 2) = o;
            }
        }
        LBAR();
        if (is_ml) {
            const int l = tid >> 3, part = tid & 7;
            const u32x4 sv = *(const LAS u32x4*)(lds + SC_ST + l * ST_P + part * 16);
            float ssum = bflo(sv.x) + bfhi(sv.x) + bflo(sv.y) + bfhi(sv.y) + bflo(sv.z) + bfhi(sv.z) + bflo(sv.w) + bfhi(sv.w);
            const u32x4 q0 = *(const LAS u32x4*)(Qs + l * SQ_P + part * 32), q1 = *(const LAS u32x4*)(Qs + l * SQ_P + part * 32 + 16);
            const LAS f32x4* nv = (const LAS f32x4*)(lds + SC_NV + part * 64);
            const f32x4 n0 = nv[0], n1 = nv[1], n2 = nv[2], n3 = nv[3];
            float qn = bflo(q0.x) * n0[0] + bfhi(q0.x) * n0[1] + bflo(q0.y) * n0[2] + bfhi(q0.y) * n0[3] + bflo(q0.z) * n1[0] + bfhi(q0.z) * n1[1] + bflo(q0.w) * n1[2] + bfhi(q0.w) * n1[3]
                     + bflo(q1.x) * n2[0] + bfhi(q1.x) * n2[1] + bflo(q1.y) * n2[2] + bfhi(q1.y) * n2[3] + bflo(q1.z) * n3[0] + bfhi(q1.z) * n3[1] + bflo(q1.w) * n3[2] + bfhi(q1.w) * n3[3];
            float val = ssum + cINT[l] * qn;
            val += __shfl_xor(val, 1); val += __shfl_xor(val, 2); val += __shfl_xor(val, 4);
            if (part == 0) ((LAS float*)(lds + SC_RDEN))[l] = 1.0f / fmaxf(fabsf(val), cEDEN[l]);
        }
        __builtin_amdgcn_sched_barrier(0);
        LBAR();
        bf16x8 vf[2][2];
        unsigned vtb = VsA + (8 * g + q4) * SV_P + (32 * w + 8 * p4) * 2; asm volatile("" : "+v"(vtb));
        unsigned ktb = KsA + (8 * g + q4) * SQ_P + (4 * p4) * 2; asm volatile("" : "+v"(ktb));
        { s16x4 t8[8];
          tr_read8(t8, vtb, vtb + 4 * SV_P, vtb + 32 * SV_P, vtb + 36 * SV_P, vtb + 8, vtb + 8 + 4 * SV_P, vtb + 8 + 32 * SV_P, vtb + 8 + 36 * SV_P);
          vf[0][0] = __builtin_shufflevector(t8[0], t8[1], 0, 1, 2, 3, 4, 5, 6, 7); vf[0][1] = __builtin_shufflevector(t8[2], t8[3], 0, 1, 2, 3, 4, 5, 6, 7);
          vf[1][0] = __builtin_shufflevector(t8[4], t8[5], 0, 1, 2, 3, 4, 5, 6, 7); vf[1][1] = __builtin_shufflevector(t8[6], t8[7], 0, 1, 2, 3, 4, 5, 6, 7); }
        f32x4 hi_[4][2], hx_[4][2];
#pragma unroll
        for (int mb = 0; mb < 4; ++mb)
#pragma unroll
            for (int vt = 0; vt < 2; ++vt) { hi_[mb][vt] = (f32x4){0.f, 0.f, 0.f, 0.f}; hx_[mb][vt] = (f32x4){0.f, 0.f, 0.f, 0.f}; }
#pragma unroll
        for (int mb = 0; mb < 4; ++mb)
#pragma unroll
            for (int ks = 0; ks < 2; ++ks) {
                if (ks == 1 && mb < 2) continue;
                const bf16x8 sf = *(const LAS bf16x8*)(lds + SC_ST + (16 * mb + r) * ST_P + (32 * ks + 8 * g) * 2);
                hi_[mb][0] = MFMA16(vf[0][ks], sf, hi_[mb][0]); hi_[mb][1] = MFMA16(vf[1][ks], sf, hi_[mb][1]);
            }
#pragma unroll
        for (int p = 0; p < 4; ++p) {
            bf16x8 cf[2];
#pragma unroll
            for (int vt = 0; vt < 2; ++vt) { u32x4 t; const f32x4 c0 = Cacc[2 * p][vt], c1 = Cacc[2 * p + 1][vt];
                t.x = cvt_pk_bf16(c0[0], c0[1]); t.y = cvt_pk_bf16(c0[2], c0[3]); t.z = cvt_pk_bf16(c1[0], c1[1]); t.w = cvt_pk_bf16(c1[2], c1[3]); cf[vt] = __builtin_bit_cast(bf16x8, t); }
#pragma unroll
            for (int mb = 0; mb < 4; ++mb) {
                const u32x2 qa = *(const LAS u32x2*)(Qs + (16 * mb + r) * SQ_P + (32 * p + 4 * g) * 2), qb = *(const LAS u32x2*)(Qs + (16 * mb + r) * SQ_P + (32 * p + 16 + 4 * g) * 2);
                u32x4 t; t.x = qa.x; t.y = qa.y; t.z = qb.x; t.w = qb.y; const bf16x8 qf2 = __builtin_bit_cast(bf16x8, t);
                hx_[mb][0] = MFMA16(cf[0], qf2, hx_[mb][0]); hx_[mb][1] = MFMA16(cf[1], qf2, hx_[mb][1]);
            }
            __builtin_amdgcn_sched_barrier(0);
        }
#pragma unroll
        for (int mb = 0; mb < 4; ++mb) { const int l = 16 * mb + r; const float it = cINT[l], rd = ((const LAS float*)(lds + SC_RDEN))[l];
            float v[8];
#pragma unroll
            for (int vt = 0; vt < 2; ++vt)
#pragma unroll
                for (int j = 0; j < 4; ++j) v[4 * vt + j] = (hi_[mb][vt][j] + it * hx_[mb][vt][j]) * rd;
            u32x4 st; st.x = cvt_pk_bf16(v[0], v[1]); st.y = cvt_pk_bf16(v[2], v[3]); st.z = cvt_pk_bf16(v[4], v[5]); st.w = cvt_pk_bf16(v[6], v[7]);
            *(u32x4*)((char*)Vg + (size_t)c * 64 * 3072 + (zoff + mb * 49152u)) = st;
        }
        {
            bf16x8 vw[2][2];
#pragma unroll
            for (int ks = 0; ks < 2; ++ks) { const f32x4 w0 = *(const LAS f32x4*)(cW + 32 * ks + 8 * g), w1 = *(const LAS f32x4*)(cW + 32 * ks + 8 * g + 4);
#pragma unroll
                for (int vt = 0; vt < 2; ++vt) { const u32x4 t = __builtin_bit_cast(u32x4, vf[vt][ks]); u32x4 o;
                    o.x = cvt_pk_bf16(bflo(t.x) * w0[0], bfhi(t.x) * w0[1]); o.y = cvt_pk_bf16(bflo(t.y) * w0[2], bfhi(t.y) * w0[3]);
                    o.z = cvt_pk_bf16(bflo(t.z) * w1[0], bfhi(t.z) * w1[1]); o.w = cvt_pk_bf16(bflo(t.w) * w1[2], bfhi(t.w) * w1[3]); vw[vt][ks] = __builtin_bit_cast(bf16x8, o); } }
#pragma unroll
            for (int dp = 0; dp < 4; ++dp) {
                s16x4 t8[8]; const unsigned kb0 = ktb + (32 * dp) * 2, kb1 = kb0 + 32;
                tr_read8(t8, kb0, kb0 + 4 * SQ_P, kb0 + 32 * SQ_P, kb0 + 36 * SQ_P, kb1, kb1 + 4 * SQ_P, kb1 + 32 * SQ_P, kb1 + 36 * SQ_P);
#pragma unroll
                for (int dd = 0; dd < 2; ++dd) { const int db = 2 * dp + dd;
                    Cacc[db][0] = Cacc[db][0] * decay; Cacc[db][1] = Cacc[db][1] * decay;
#pragma unroll
                    for (int ks = 0; ks < 2; ++ks) {
                        const bf16x8 kf = __builtin_shufflevector(t8[4 * dd + 2 * ks], t8[4 * dd + 2 * ks + 1], 0, 1, 2, 3, 4, 5, 6, 7);
                        Cacc[db][0] = MFMA16(kf, vw[0][ks], Cacc[db][0]); Cacc[db][1] = MFMA16(kf, vw[1][ks], Cacc[db][1]);
                    } }
            }
        }
        __builtin_amdgcn_sched_barrier(0);
        float vpre = 0.f;
        if (c + 1 < 64) { SC_LOAD(c + 1); if (tid < 320) vpre = vptr[(c + 1) * cstr]; }
        __builtin_amdgcn_sched_barrier(0);
        if (is_ml) {
            const int d = tid >> 2, part = tid & 3; float s = 0.f;
#pragma unroll
            for (int j = 0; j < 16; ++j) { const int sidx = 16 * part + j; s += cW[sidx] * bf2f(*(const LAS bf16_t*)(Ks + sidx * SQ_P + d * 2)); }
            s += __shfl_xor(s, 1); s += __shfl_xor(s, 2);
            if (part == 0) { LAS float* np = (LAS float*)(lds + SC_NV) + d; *np = decay * (*np) + s; }
        }
        if (c + 1 < 64) { SC_STORE(cur ^ 1); if (tid < 320) ((LAS float*)(lds + SC_VEC + (cur ^ 1) * 1280))[tid] = vpre; }
        LBAR();
    }
#undef SC_LOAD
#undef SC_STORE
}


DI void p3b_gate(const Params& P) {
    const int tid = opaque_tid(), lane = tid & 63, sub = lane >> 4, li = lane & 15, G = gridDim.x, bx = blockIdx.x;
    unsigned char* ws = P.ws;
    const int nw = T * 6 * 2 / 4;
    for (int wv = bx * 8 + (tid >> 6); wv < nw; wv += G * 8) {
        int pair = wv * 4 + sub; const int br = pair >= T * 6; pair -= br * T * 6; const int t = pair / 6, h = pair - t * 6;
        const size_t off = (size_t)t * 1536 + h * 256 + li * 16;
        const bf16_t* hp = (const bf16_t*)(ws + (br ? WS_V2 : WS_V1)) + off; bf16_t* zp = (bf16_t*)(ws + (br ? WS_Z2 : WS_Z1)) + off; const bf16_t* op = (const bf16_t*)(ws + WS_O1) + off;
        const float* gp = (br ? P.ret_g : P.ml_g) + h * 256 + li * 16;
        const u32x4 h0 = *(const u32x4*)hp, h1 = *(const u32x4*)(hp + 8), z0 = *(const u32x4*)zp, z1 = *(const u32x4*)(zp + 8);
        u32x4 o0 = (u32x4){0u, 0u, 0u, 0u}, o1 = o0; if (!br) { o0 = *(const u32x4*)op; o1 = *(const u32x4*)(op + 8); }
        const unsigned hh[8] = {h0.x, h0.y, h0.z, h0.w, h1.x, h1.y, h1.z, h1.w}, zz[8] = {z0.x, z0.y, z0.z, z0.w, z1.x, z1.y, z1.z, z1.w}, oo[8] = {o0.x, o0.y, o0.z, o0.w, o1.x, o1.y, o1.z, o1.w};
        float hv[16], s1 = 0.f, s2 = 0.f;
#pragma unroll
        for (int e = 0; e < 16; ++e) { hv[e] = (e & 1) ? bfhi(hh[e >> 1]) : bflo(hh[e >> 1]); s1 += hv[e]; s2 += hv[e] * hv[e]; }
#pragma unroll
        for (int o = 1; o < 16; o <<= 1) { s1 += __shfl_xor(s1, o); s2 += __shfl_xor(s2, o); }
        const float mean = s1 * (1.0f / 256.0f), var = fmaxf(s2 * (1.0f / 256.0f) - mean * mean, 0.f), rstd = rsqrtf(var + EPS);
        float y[16];
#pragma unroll
        for (int q = 0; q < 4; ++q) { const f32x4 gg = *(const f32x4*)(gp + 4 * q);
#pragma unroll
            for (int j = 0; j < 4; ++j) { const int e = 4 * q + j; const float z = (e & 1) ? bfhi(zz[e >> 1]) : bflo(zz[e >> 1]); float v = (hv[e] - mean) * rstd * gg[j] * siluf_(z);
                if (!br) { const float o = (e & 1) ? bfhi(oo[e >> 1]) : bflo(oo[e >> 1]); v *= sigmoidf_(o); } y[e] = v; } }
        u32x4 a, c2; a.x = cvt_pk_bf16(y[0], y[1]); a.y = cvt_pk_bf16(y[2], y[3]); a.z = cvt_pk_bf16(y[4], y[5]); a.w = cvt_pk_bf16(y[6], y[7]);
        c2.x = cvt_pk_bf16(y[8], y[9]); c2.y = cvt_pk_bf16(y[10], y[11]); c2.z = cvt_pk_bf16(y[12], y[13]); c2.w = cvt_pk_bf16(y[14], y[15]);
        *(u32x4*)zp = a; *(u32x4*)(zp + 8) = c2;
    }
}

constexpr int AK_P = 528;
constexpr int AV_P = 544;
static_assert(256 * AV_P <= LDS_BYTES - 16, "attn LDS");
DI void attn_unit(const Params& P, LAS unsigned char* lds, int unit) {
    const int tid = opaque_tid(), lane = tid & 63, w = __builtin_amdgcn_readfirstlane(tid >> 6), r = lane & 15, g = lane >> 4, q4 = r >> 2, p4 = r & 3;
    unsigned char* ws = P.ws;
    const int b = unit >> 6, hh = (unit >> 4) & 3, qb = unit & 15;
    const size_t trow = (size_t)b * SEQ + qb * 256 + 32 * w + r;
    const bf16_t* Qp = (const bf16_t*)(ws + WS_Q3) + trow * 1024 + hh * 256;
    bf16_t* Zp = (bf16_t*)(ws + WS_Z3) + trow * 1024 + hh * 256;
    const bf16_t* Kp = (const bf16_t*)(ws + WS_MKV) + (size_t)b * 256 * 2048 + hh * 256;
    const bf16_t* Vp = Kp + 1024;
    const unsigned ldsb = (unsigned)(size_t)lds;
#pragma unroll
    for (int i = 0; i < 16; ++i) { const int pp = tid + 512 * i, row = pp >> 5, ch = pp & 31; *(LAS u32x4*)(lds + row * AK_P + ch * 16) = *(const u32x4*)(Kp + (size_t)row * 2048 + ch * 8); }
    __syncthreads();
    bf16x8 pf[2][8]; float rs[2];
#pragma unroll
    for (int mb = 0; mb < 2; ++mb) {
        bf16x8 qf[8];
#pragma unroll
        for (int ks = 0; ks < 8; ++ks) qf[ks] = *(const bf16x8*)(Qp + (size_t)mb * 16 * 1024 + 32 * ks + 8 * g);
        f32x4 s[16];
#pragma unroll
        for (int nb = 0; nb < 16; ++nb) { s[nb] = (f32x4){0.f, 0.f, 0.f, 0.f};
#pragma unroll
            for (int ks = 0; ks < 8; ++ks) { const bf16x8 kf = *(const LAS bf16x8*)(lds + (16 * nb + r) * AK_P + (32 * ks + 8 * g) * 2); s[nb] = MFMA16(kf, qf[ks], s[nb]); } __builtin_amdgcn_sched_barrier(0); }
        float mx = -3.0e38f;
#pragma unroll
        for (int nb = 0; nb < 16; ++nb) mx = fmaxf(mx, fmaxf(fmaxf(s[nb][0], s[nb][1]), fmaxf(s[nb][2], s[nb][3])));
        mx = fmaxf(mx, __shfl_xor(mx, 16)); mx = fmaxf(mx, __shfl_xor(mx, 32));
        const float sc = 0.0625f * 1.4426950408889634f; float sum = 0.f;
#pragma unroll
        for (int nb = 0; nb < 16; ++nb)
#pragma unroll
            for (int j = 0; j < 4; ++j) { const float e = __builtin_amdgcn_exp2f((s[nb][j] - mx) * sc); s[nb][j] = e; sum += e; }
        sum += __shfl_xor(sum, 16); sum += __shfl_xor(sum, 32);
        rs[mb] = 1.0f / sum;
#pragma unroll
        for (int kk = 0; kk < 8; ++kk) { u32x4 t; t.x = cvt_pk_bf16(s[2 * kk][0], s[2 * kk][1]); t.y = cvt_pk_bf16(s[2 * kk][2], s[2 * kk][3]); t.z = cvt_pk_bf16(s[2 * kk + 1][0], s[2 * kk + 1][1]); t.w = cvt_pk_bf16(s[2 * kk + 1][2], s[2 * kk + 1][3]); pf[mb][kk] = __builtin_bit_cast(bf16x8, t); }
        __builtin_amdgcn_sched_barrier(0);
    }
    __syncthreads();
#pragma unroll
    for (int i = 0; i < 16; ++i) { const int pp = tid + 512 * i, row = pp >> 5, ch = pp & 31; *(LAS u32x4*)(lds + row * AV_P + ch * 16) = *(const u32x4*)(Vp + (size_t)row * 2048 + ch * 8); }
    __syncthreads();
#pragma unroll
    for (int VG = 0; VG < 4; ++VG) {
        unsigned vb = ldsb + (4 * g + q4) * AV_P + (4 * p4) * 2; asm volatile("" : "+v"(vb));
        bf16_t* zp = Zp + 64 * VG + 4 * g;
        u32x2 zl[2][4];
#pragma unroll
        for (int mb = 0; mb < 2; ++mb)
#pragma unroll
            for (int vq = 0; vq < 4; ++vq) zl[mb][vq] = *(const u32x2*)(zp + (size_t)mb * 16 * 1024 + 16 * vq);
        f32x4 o[2][4];
#pragma unroll
        for (int vq = 0; vq < 4; ++vq) { o[0][vq] = (f32x4){0.f, 0.f, 0.f, 0.f}; o[1][vq] = (f32x4){0.f, 0.f, 0.f, 0.f};
#pragma unroll
            for (int kh = 0; kh < 2; ++kh) {
                s16x4 t8[8]; const unsigned a0 = vb + (128 * kh) * AV_P + (64 * VG + 16 * vq) * 2;
                tr_read8(t8, a0, a0 + 16 * AV_P, a0 + 32 * AV_P, a0 + 48 * AV_P, a0 + 64 * AV_P, a0 + 80 * AV_P, a0 + 96 * AV_P, a0 + 112 * AV_P);
#pragma unroll
                for (int k2 = 0; k2 < 4; ++k2) { const bf16x8 vfr = __builtin_shufflevector(t8[2 * k2], t8[2 * k2 + 1], 0, 1, 2, 3, 4, 5, 6, 7);
                    o[0][vq] = MFMA16(vfr, pf[0][4 * kh + k2], o[0][vq]); o[1][vq] = MFMA16(vfr, pf[1][4 * kh + k2], o[1][vq]); }
            } }
#pragma unroll
        for (int mb = 0; mb < 2; ++mb)
#pragma unroll
            for (int vq = 0; vq < 4; ++vq) {
                const u32x2 zz = zl[mb][vq]; const f32x4 ov = o[mb][vq];
                const float y0 = ov[0] * rs[mb] * siluf_(bflo(zz.x)), y1 = ov[1] * rs[mb] * siluf_(bfhi(zz.x)), y2 = ov[2] * rs[mb] * siluf_(bflo(zz.y)), y3 = ov[3] * rs[mb] * siluf_(bfhi(zz.y));
                unsigned st = 0u; st = __builtin_amdgcn_cvt_pk_fp8_f32(y0 * 16.f, y1 * 16.f, st, false); st = __builtin_amdgcn_cvt_pk_fp8_f32(y2 * 16.f, y3 * 16.f, st, true);
                *(unsigned*)((unsigned char*)P.out + DO_XA8 + (trow + 16 * mb) * 1024 + hh * 256 + 64 * VG + 4 * g + 16 * vq) = st;
            }
    }
    __syncthreads();
}

#define XB_TMO      128
#define XB_XCNT(j)  (256  + 64 * (j))
#define XB_XSUB(j)  (1280 + 64 * (j))
#define XB_XGEN(j)  (2304 + 64 * (j))
#define XB_TOP      3328
#define XB_TOPGEN   3392
#define XCD_BAR_WORDS 3456
#define XB_SPIN_CAP (1u << 18)
DI unsigned xb_ld(unsigned* p)              { return __hip_atomic_load(p, __ATOMIC_RELAXED, __HIP_MEMORY_SCOPE_AGENT); }
DI unsigned xb_add(unsigned* p, unsigned v) { return __hip_atomic_fetch_add(p, v, __ATOMIC_RELAXED, __HIP_MEMORY_SCOPE_AGENT); }
DI unsigned xb_xcc_id() { return (unsigned)__builtin_amdgcn_s_getreg((3 << 11) | 20) & 0xFu; }
#define XB_SPIN(cond, bar) do { unsigned _sp = 0; while (cond) { __builtin_amdgcn_s_sleep(1); \
    if ((++_sp & 255u) == 0u) { if (xb_ld(&(bar)[XB_TMO])) break; if (_sp > XB_SPIN_CAP) { atomicAdd(&(bar)[XB_TMO], 1u); break; } } } } while (0)
struct XcdBarrier { unsigned* bar; unsigned x; volatile LAS unsigned* st; };
DI XcdBarrier xcd_barrier_post(unsigned* bar, volatile LAS unsigned* st) {
    XcdBarrier b; b.bar = bar; b.x = xb_xcc_id(); b.st = st;
    if (threadIdx.x == 0) (void)xb_add(&bar[XB_XCNT(b.x)], 1u);
    return b;
}
DI void xcd_barrier_complete(unsigned* bar, unsigned x, unsigned& nloc, unsigned& nx) {
    const unsigned G = gridDim.x * gridDim.y * gridDim.z;
    unsigned sum, cnt, mine, sp = 0u;
    for (;;) {
        sum = 0u; cnt = 0u; mine = 0u;
#pragma unroll
        for (unsigned j = 0; j < 16; ++j) { const unsigned c = xb_ld(&bar[XB_XCNT(j)]); sum += c; cnt += (c > 0u) ? 1u : 0u; mine = (j == x) ? c : mine; }
        if (sum == G) break;
        __builtin_amdgcn_s_sleep(1);
        if ((++sp & 255u) == 0u) { if (xb_ld(&bar[XB_TMO])) break; if (sp > XB_SPIN_CAP) { atomicAdd(&bar[XB_TMO], 1u); break; } }
    }
    nloc = mine > 0u ? mine : 1u; nx = cnt > 0u ? cnt : 1u;
}
DI void xcd_barrier(const XcdBarrier& b) {
    asm volatile("s_waitcnt vmcnt(0)" ::: "memory");
    __syncthreads();
    if (threadIdx.x == 0) {
        unsigned* bar = b.bar;
        __builtin_amdgcn_s_waitcnt(0);
        unsigned nloc = b.st[0], nx = b.st[1];
        if (nloc == 0u) { xcd_barrier_complete(bar, b.x, nloc, nx); b.st[0] = nloc; b.st[1] = nx; }
        const unsigned old = xb_add(&bar[XB_XSUB(b.x)], 1u);
        const unsigned gen = old / nloc;
        if (old + 1u == (gen + 1u) * nloc) {
            __builtin_amdgcn_fence(__ATOMIC_RELEASE, "agent");
            asm volatile("s_waitcnt vmcnt(0)" ::: "memory");
            const unsigned og = xb_add(&bar[XB_TOP], 1u);
            const unsigned tg = og / nx;
            if (og + 1u == (tg + 1u) * nx) xb_add(&bar[XB_TOPGEN], 1u);
            else XB_SPIN(xb_ld(&bar[XB_TOPGEN]) == tg, bar);
            __builtin_amdgcn_fence(__ATOMIC_ACQUIRE, "agent");
            xb_add(&bar[XB_XGEN(b.x)], 1u);
            asm volatile("s_waitcnt vmcnt(0)" ::: "memory");
        } else {
            XB_SPIN(xb_ld(&bar[XB_XGEN(b.x)]) == gen, bar);
            __builtin_amdgcn_fence(__ATOMIC_ACQUIRE, "agent");
            asm volatile("s_waitcnt vmcnt(0)" ::: "memory");
        }
    }
    __syncthreads();
}

__global__ void __launch_bounds__(512) fwd_megakernel(Params P) {
    extern __shared__ __attribute__((aligned(16))) unsigned char smem[];
    LAS unsigned char* lds = (LAS unsigned char*)smem;
    cg::grid_group grid = cg::this_grid();
    unsigned char* ws = P.ws;
    const int G = gridDim.x, bx = blockIdx.x, tid = threadIdx.x;
    bf16_t* H = (bf16_t*)((unsigned char*)P.out + DO_H);

    if (tid < 4) ((LAS unsigned*)(lds + LDS_BYTES - 32))[tid] = 0u;
    __syncthreads();
#ifndef NO_P0
    p0_prologue(P, lds);
#endif
    grid.sync();
    const XcdBarrier xb = xcd_barrier_post((unsigned*)(ws + WS_BAR), (volatile LAS unsigned*)(lds + LDS_BYTES - 32));
    {
        { pg8::Gemm g{H, (const bf16_t*)(ws + WS_WIN), 2048}; pg8::Order S; S.init(128, NT_P1 - 26, G, bx, 0, 64, 128, PN_KV); S.skip0_lo = 6; S.skip0_n = 6; S.skip_lo = 24; S.skip_n = 16; S.skip2_lo = 46; S.skip2_n = 4;
          pg8::EpiProj E{ws, (const float*)(ws + WS_BIAS), 1 << 20, 0, 0.f};
          pg8::gemm_phase(lds, g, S, E); }
        { pg8::Gemm g{(const bf16_t*)(ws + WS_H8), (const bf16_t*)((unsigned char*)P.out + DO_WO8 - (size_t)24 * 256 * 2048), 1024}; pg8::Order S; S.init(128, 20, G, bx, 24);
          pg8::EpiProj E{ws, (const float*)(ws + WS_BIAS), 40, 6, Q8_DEQ};
          pg8::gemm_phase<2>(lds, g, S, E); }
        { pg8::Gemm g{(const bf16_t*)(ws + WS_H8), (const bf16_t*)(ws + WS_WV8 - (size_t)6 * 256 * 2048), 1024}; pg8::Order S; S.init(128, 6, G, bx, 6);
          pg8::EpiProj E{ws, (const float*)(ws + WS_BIAS), 1 << 20, 0, Q8_DEQ};
          pg8::gemm_phase<2>(lds, g, S, E); }
    }
    xcd_barrier(xb);
#ifndef NO_P2
    p2_prep(P, lds);
#endif
    xcd_barrier(xb);
    {
#ifndef NO_SCAN
        for (int it = bx; it < 96; it += G) scan_item(P, lds, it);
#endif
        if (bx >= 96 && G > 96) {
            pg8::Gemm g{(const bf16_t*)(ws + WS_H8), (const bf16_t*)((unsigned char*)P.out + DO_WG8), 1024}; pg8::Order S; S.init(128, 8, G - 96, bx - 96, 0);
            pg8::EpiGate E{ws, (const float*)(ws + WS_BIAS), Q8_DEQ};
            pg8::gemm_phase<2>(lds, g, S, E);
        }
        LAS unsigned* slot = (LAS unsigned*)(lds + LDS_BYTES - 16);
        for (;;) {
            if (tid == 0) *slot = atomicAdd((unsigned*)(ws + WS_CTL), 1u);
            __syncthreads();
            const unsigned u = *slot;
            __syncthreads();
            if (u >= 512u) break;
#ifndef NO_ATTN
            attn_unit(P, lds, (int)u);
#endif
        }
    }
    xcd_barrier(xb);
#ifndef NO_P2
    p3b_gate(P);
#endif
    xcd_barrier(xb);
    {
        pg8::Gemm g{(const bf16_t*)(ws + WS_H8), (const bf16_t*)((unsigned char*)P.out + DO_WG8), 1024}; pg8::Order S; S.init(128, 16, G, bx, 8);
        pg8::EpiGate E{ws, (const float*)(ws + WS_BIAS), Q8_DEQ};
        pg8::gemm_phase<2>(lds, g, S, E);
    }
    xcd_barrier(xb);
    {
        pg8::Order S; S.init(128, 8, G, bx, 0);
        { pg8::Gemm g{(const bf16_t*)(ws + WS_Z1), (const bf16_t*)(ws + WS_WML), 1536}; pg8::EpiMerge E{(bf16_t*)(ws + WS_MERGED), (const bf16_t*)(ws + WS_G0), 0}; pg8::gemm_phase(lds, g, S, E); }
        { pg8::Gemm g{(const bf16_t*)(ws + WS_Z2), (const bf16_t*)(ws + WS_WRET), 1536}; pg8::EpiMerge E{(bf16_t*)(ws + WS_MERGED), (const bf16_t*)(ws + WS_G12), 1}; pg8::gemm_phase(lds, g, S, E); }
        { pg8::Gemm g{(const bf16_t*)((unsigned char*)P.out + DO_XA8), (const bf16_t*)((unsigned char*)P.out + DO_WX8), 512, 0, 0x7B7B7B7B}; pg8::EpiMerge E{(bf16_t*)(ws + WS_MERGED), (const bf16_t*)(ws + WS_G12 + SZ20), 2}; pg8::gemm_phase<1>(lds, g, S, E); }
    }
    xcd_barrier(xb);
    {
        pg8::Gemm g{(const bf16_t*)(ws + WS_MERGED), (const bf16_t*)(ws + WS_WOUT), 2048}; pg8::Order S; S.init(128, 8, G, bx, 0);
        pg8::EpiOut E{(bf16_t*)(ws + WS_G0)};
        pg8::gemm_phase(lds, g, S, E);
    }
    xcd_barrier(xb);
    {
        const bf16_t* D = (const bf16_t*)(ws + WS_G0); const int lane = tid & 63, wave = tid >> 6;
        f32x4 gg[8];
#pragma unroll
        for (int i = 0; i < 8; ++i) gg[i] = *(const f32x4*)(P.fin_g + 4 * (lane + 64 * i));
        for (int row = bx * 16 + wave * 2; row < T; row += G * 16) {
            const float* x0 = P.x + (size_t)row * 2048; const float* x1 = x0 + 2048; const bf16_t* d0 = D + (size_t)row * 2048; const bf16_t* d1 = d0 + 2048;
            float* o0 = P.out + (size_t)row * 2048; float* o1 = o0 + 2048;
            f32x4 a[8], b[8]; u32x2 da[8], db[8];
#pragma unroll
            for (int i = 0; i < 8; ++i) { a[i] = *(const f32x4*)(x0 + 4 * (lane + 64 * i)); b[i] = *(const f32x4*)(x1 + 4 * (lane + 64 * i)); da[i] = *(const u32x2*)(d0 + 4 * (lane + 64 * i)); db[i] = *(const u32x2*)(d1 + 4 * (lane + 64 * i)); }
            float s0 = 0.f, s1 = 0.f;
#pragma unroll
            for (int i = 0; i < 8; ++i) {
                a[i] += (f32x4){bflo(da[i].x), bfhi(da[i].x), bflo(da[i].y), bfhi(da[i].y)}; b[i] += (f32x4){bflo(db[i].x), bfhi(db[i].x), bflo(db[i].y), bfhi(db[i].y)};
                s0 += a[i][0] * a[i][0] + a[i][1] * a[i][1] + a[i][2] * a[i][2] + a[i][3] * a[i][3]; s1 += b[i][0] * b[i][0] + b[i][1] * b[i][1] + b[i][2] * b[i][2] + b[i][3] * b[i][3]; }
            s0 = wave_sum(s0); s1 = wave_sum(s1);
            const float c0 = rsqrtf(s0 * (1.0f / 2048.0f) + EPS), c1 = rsqrtf(s1 * (1.0f / 2048.0f) + EPS);
#pragma unroll
            for (int i = 0; i < 8; ++i) { *(f32x4*)(o0 + 4 * (lane + 64 * i)) = a[i] * c0 * gg[i]; *(f32x4*)(o1 + 4 * (lane + 64 * i)) = b[i] * c1 * gg[i]; }
        }
    }
}

extern "C" void kernel_launch(void* const* d_in, const int* in_sizes, int n_in, void* d_out, int out_size, void* d_ws, size_t ws_size, hipStream_t stream) {
    static int grid = 0;
    if (grid == 0) {
        if (n_in != 17 || out_size != T * DM || ws_size < WS_END) { fprintf(stderr, "kernel_launch: unexpected shapes / workspace (%d inputs, out %d, ws %zu, need %zu)\n", n_in, out_size, ws_size, (size_t)WS_END); grid = -1; return; }
        int dev = 0, cus = 0, per_cu = 0;
        hipGetDevice(&dev); hipDeviceGetAttribute(&cus, hipDeviceAttributeMultiprocessorCount, dev);
        if (hipFuncSetAttribute((const void*)fwd_megakernel, hipFuncAttributeMaxDynamicSharedMemorySize, LDS_BYTES) != hipSuccess) { fprintf(stderr, "kernel_launch: hipFuncSetAttribute failed\n"); grid = -1; return; }
        if (hipOccupancyMaxActiveBlocksPerMultiprocessor(&per_cu, (const void*)fwd_megakernel, 512, LDS_BYTES) != hipSuccess || per_cu < 1) { fprintf(stderr, "kernel_launch: occupancy query gave %d\n", per_cu); per_cu = 1; }
        (void)hipGetLastError();
        grid = cus * 1;
    }
    if (grid < 0) return;
    Params p{};
    p.x = (const float*)d_in[0]; p.mem = (const float*)d_in[1]; p.pos = (const int*)d_in[2]; p.ln_g = (const float*)d_in[3]; p.mem_ln_g = (const float*)d_in[4];
    p.w_in = (const float*)d_in[5]; p.b_in = (const float*)d_in[6]; p.conv_w = (const float*)d_in[7]; p.conv_b = (const float*)d_in[8]; p.ml_g = (const float*)d_in[9];
    p.ret_g = (const float*)d_in[10]; p.w_kv = (const float*)d_in[11]; p.w_ml = (const float*)d_in[12]; p.w_ret = (const float*)d_in[13]; p.w_xa = (const float*)d_in[14];
    p.w_out = (const float*)d_in[15]; p.fin_g = (const float*)d_in[16]; p.out = (float*)d_out; p.ws = (unsigned char*)d_ws;
    void* args[] = {&p};
    hipError_t e = hipLaunchCooperativeKernel((const void*)fwd_megakernel, dim3(grid), dim3(512), args, LDS_BYTES, stream);
    if (e != hipSuccess) fprintf(stderr, "cooperative launch failed: %s (grid %d)\n", hipGetErrorString(e), grid);
}
```

```cpp
#include <hip/hip_runtime.h>
#include <hip/hip_cooperative_groups.h>
#include <cstdint>
#include <cstdio>
namespace cg = cooperative_groups;

#define LAS __attribute__((address_space(3)))
typedef unsigned short bf16_t;
typedef short bf16x8 __attribute__((ext_vector_type(8)));
typedef short s16x4 __attribute__((ext_vector_type(4)));
typedef float f32x4 __attribute__((ext_vector_type(4)));
typedef float f32x2 __attribute__((ext_vector_type(2)));
typedef unsigned u32x4 __attribute__((ext_vector_type(4)));
typedef unsigned u32x2 __attribute__((ext_vector_type(2)));
typedef int i32x4 __attribute__((ext_vector_type(4)));
typedef int i32x8 __attribute__((ext_vector_type(8)));
#define DI __device__ __forceinline__

constexpr int T = 32768, DM = 2048, SEQ = 4096, NB = 8;
constexpr int N_IN = 18956, NPAD = 19200;
constexpr int NT_P1 = 51;
constexpr int PN_GATE = 51;
constexpr int PN_KV = 75;
constexpr float EPS = 1e-6f;
constexpr int LDS_BYTES = 156 * 1024;

constexpr size_t WS_CTL = 0;
constexpr size_t WS_BAR = 4096;
constexpr size_t WS_SS = WS_BAR + 16384;
constexpr size_t WS_BIAS = WS_SS + (size_t)T * 4;
constexpr size_t WS_IF = WS_BIAS + 81920;
constexpr size_t WS_GS = WS_IF + (size_t)T * 16 * 4;
constexpr size_t GS_ARR = (size_t)48 * 4096;
constexpr size_t WS_GDEC = WS_GS + 5 * GS_ARR * 4;
constexpr size_t WS_RV = WS_GDEC + 48 * 64 * 4;
constexpr size_t WS_WIN = WS_RV + 16384;
constexpr size_t WS_WKV = WS_WIN + (size_t)NPAD * DM * 2;
constexpr size_t WS_WML = WS_WKV + (size_t)2048 * 2048 * 2;
constexpr size_t WS_WRET = WS_WML + (size_t)2048 * 1536 * 2;
constexpr size_t WS_WXA = WS_WRET + (size_t)2048 * 1536 * 2;
constexpr size_t WS_WOUT = WS_WXA + (size_t)2048 * 1024 * 2;
constexpr size_t WS_MKV = WS_WOUT + (size_t)2048 * 2048 * 2;
constexpr size_t WS_BIG = WS_MKV + (size_t)2048 * 2048 * 2;
constexpr size_t SZ15 = (size_t)T * 1536 * 2, SZ10 = (size_t)T * 1024 * 2;
constexpr size_t SZ20 = (size_t)T * 2048 * 2;
constexpr size_t WS_V1 = WS_BIG, WS_QK2 = WS_V1 + SZ15, WS_V2 = WS_QK2 + SZ15;
constexpr size_t WS_O1 = WS_V2 + SZ15, WS_Q3 = WS_O1 + SZ15;
constexpr size_t WS_Z1 = WS_Q3 + SZ10, WS_Z2 = WS_Z1 + SZ15, WS_Z3 = WS_Z2 + SZ15;
constexpr size_t WS_QK1 = WS_Z3 + SZ10;
constexpr size_t WS_H8 = WS_QK1 + SZ20;
constexpr size_t WS_WV8 = WS_H8 + (size_t)T * DM;
constexpr size_t WS_WZ8 = WS_WV8 + (size_t)1536 * 2048;
constexpr size_t WS_END = WS_WZ8 + (size_t)1536 * 2048;
constexpr size_t WS_G0 = WS_QK1, WS_G12 = WS_V1, WS_MERGED = WS_O1;
static_assert(2 * SZ20 <= 3 * SZ15 && SZ20 <= SZ15 + SZ10, "overlays");
constexpr size_t DO_H = 0, DO_MN = (size_t)T * DM * 2, DO_QKC = DO_MN + (size_t)2048 * 2048 * 2;
constexpr size_t DO_WG8 = DO_QKC + (size_t)T * 1536 * 2;
constexpr size_t DO_WO8 = DO_WG8 + (size_t)6144 * 2048;
constexpr size_t DO_WX8 = DO_WO8 + (size_t)5120 * 2048;
static_assert(DO_WX8 + (size_t)2048 * 1024 <= (size_t)T * DM * 4, "d_out scratch");
constexpr size_t DO_XA8 = DO_H;

struct Params {
    const float* x; const float* mem; const int* pos; const float* ln_g; const float* mem_ln_g; const float* w_in; const float* b_in;
    const float* conv_w; const float* conv_b; const float* ml_g; const float* ret_g; const float* w_kv; const float* w_ml; const float* w_ret;
    const float* w_xa; const float* w_out; const float* fin_g; float* out; unsigned char* ws;
};

typedef __bf16 bf16v2_t __attribute__((ext_vector_type(2)));
DI unsigned cvt_pk_bf16(float lo, float hi) { const f32x2 v = {lo, hi}; const bf16v2_t r = __builtin_convertvector(v, bf16v2_t); return __builtin_bit_cast(unsigned, r); }
DI float bf2f(unsigned short b) { return __uint_as_float((unsigned)b << 16); }
DI float bflo(unsigned u) { return __uint_as_float(u << 16); }
DI float bfhi(unsigned u) { return __uint_as_float(u & 0xffff0000u); }
DI float sigmoidf_(float v) { return __builtin_amdgcn_rcpf(1.0f + __builtin_amdgcn_exp2f(-1.4426950408889634f * v)); }
DI float siluf_(float v) { return v * __builtin_amdgcn_rcpf(1.0f + __builtin_amdgcn_exp2f(-1.4426950408889634f * v)); }
#define LBAR() do { asm volatile("s_waitcnt lgkmcnt(0)" ::: "memory"); __builtin_amdgcn_s_barrier(); asm volatile("" ::: "memory"); } while (0)
DI float wave_sum(float v) { for (int o = 32; o > 0; o >>= 1) v += __shfl_xor(v, o); return v; }
DI s16x4 tr_read(unsigned lds_addr) { s16x4 r; asm volatile("ds_read_b64_tr_b16 %0, %1\n\ts_waitcnt lgkmcnt(0)" : "=&v"(r) : "v"(lds_addr) : "memory"); return r; }
DI void tr_read8(s16x4 (&o)[8], unsigned a0, unsigned a1, unsigned a2, unsigned a3, unsigned a4, unsigned a5, unsigned a6, unsigned a7) {
    asm volatile("ds_read_b64_tr_b16 %0, %8\n\tds_read_b64_tr_b16 %1, %9\n\tds_read_b64_tr_b16 %2, %10\n\tds_read_b64_tr_b16 %3, %11\n\tds_read_b64_tr_b16 %4, %12\n\tds_read_b64_tr_b16 %5, %13\n\tds_read_b64_tr_b16 %6, %14\n\tds_read_b64_tr_b16 %7, %15\n\ts_waitcnt lgkmcnt(0)"
                 : "=&v"(o[0]), "=&v"(o[1]), "=&v"(o[2]), "=&v"(o[3]), "=&v"(o[4]), "=&v"(o[5]), "=&v"(o[6]), "=&v"(o[7])
                 : "v"(a0), "v"(a1), "v"(a2), "v"(a3), "v"(a4), "v"(a5), "v"(a6), "v"(a7) : "memory");
}
DI unsigned pack_i8x4(float a, float b, float c, float d, float s) {
    const int i0 = (int)rintf(fminf(fmaxf(a * s, -127.f), 127.f)), i1 = (int)rintf(fminf(fmaxf(b * s, -127.f), 127.f)), i2 = (int)rintf(fminf(fmaxf(c * s, -127.f), 127.f)), i3 = (int)rintf(fminf(fmaxf(d * s, -127.f), 127.f));
    return (unsigned)(i0 & 255) | ((unsigned)(i1 & 255) << 8) | ((unsigned)(i2 & 255) << 16) | ((unsigned)i3 << 24);
}
DI f32x4 deq_acc(f32x4 a, float qs) {
    if (qs == 0.f) return a;
    f32x4 r; r[0] = (float)__float_as_int(a[0]) * qs; r[1] = (float)__float_as_int(a[1]) * qs; r[2] = (float)__float_as_int(a[2]) * qs; r[3] = (float)__float_as_int(a[3]) * qs; return r;
}
constexpr float H8_SCALE = 32.f, W8_SCALE = 1536.f, Q8_DEQ = 1.0f / (32.f * 1536.f);
DI int opaque_tid() { int t = threadIdx.x; asm volatile("" : "+v"(t)); return t; }
#define MFMA16(a, b, c) __builtin_amdgcn_mfma_f32_16x16x32_bf16((a), (b), (c), 0, 0, 0)

namespace pg8 {
constexpr int BM = 256, BK = 64, HALF = 128, HTB = HALF * BK * 2, STAGE_BYTES = 8 * HTB, NXCD = 8, WGM = 8;
DI int lds_byte(int r, int c) { const int st = (r >> 4) * 2 + (c >> 5), rr = r & 15, cc = c & 31, ob = rr * 64 + cc * 2; return st * 1024 + (ob ^ (((ob >> 9) & 1) << 5)); }
DI void stage_rc(int b, int& R, int& C) { const int st = b / 1024, sb = b % 1024, swz = sb ^ (((sb >> 9) & 1) << 5); R = (st >> 1) * 16 + swz / 64; C = (st & 1) * 32 + (swz % 64) / 2; }
DI int perm32(int rho) { const int n = rho >> 4, i = rho & 15; return 8 * (i >> 2) + 4 * n + (i & 3); }
struct Unit { int pm, pn; };
struct Gemm { const bf16_t* A; const bf16_t* Bt; int K; int ntile = 0; int sca = 0x7F7F7F7F; };
struct Order {
    int nM, nN, nwg, G, c, pn_off, extra, pm0x, pn0x, skip0_lo, skip0_n, skip_lo, skip_n, skip2_lo, skip2_n;
    DI void init(int nM_, int nN_, int G_, int c_, int pn_off_, int extra_ = 0, int pm0x_ = 0, int pn0x_ = 0) { nM = nM_; nN = nN_; nwg = nM * nN; G = G_; c = c_; pn_off = pn_off_; extra = extra_; pm0x = pm0x_; pn0x = pn0x_; skip0_lo = 0; skip0_n = 0; skip_lo = 0; skip_n = 0; skip2_lo = 0; skip2_n = 0; }
    DI bool next(int i, Unit& u) const {
        long L = (long)i * G + c;
        if (L < nwg) {
            int wgid = (int)L; { const int q = nwg / NXCD, r = nwg % NXCD, xcd = wgid % NXCD, off = wgid / NXCD; wgid = (xcd < r ? xcd * (q + 1) : r * (q + 1) + (xcd - r) * q) + off; }
            const int nig = WGM * nN, gid = wgid / nig, fm = gid * WGM, gsz = (nM - fm) < WGM ? (nM - fm) : WGM;
            u.pm = fm + ((wgid % nig) % gsz); u.pn = pn_off + (wgid % nig) / gsz; if (skip0_n && u.pn >= skip0_lo) u.pn += skip0_n; if (skip_n && u.pn >= skip_lo) u.pn += skip_n; if (skip2_n && u.pn >= skip2_lo) u.pn += skip2_n; return true;
        }
        L -= nwg; if (L >= extra) return false;
        u.pm = pm0x + (int)(L >> 3); u.pn = pn0x + (int)(L & 7); return true;
    }
};

template <int MODE = 0, class Epi>
DI void gemm_phase(LAS unsigned char* lds, const Gemm g, const Order& S, const Epi& E) {
    constexpr bool FP8 = (MODE == 1);
    const int tid = opaque_tid(), wid = __builtin_amdgcn_readfirstlane(tid >> 6), lane = tid & 63, wr = wid >> 2, wc = wid & 3, fr = lane & 15, fq = lane >> 4;
    const int K = g.K, nt = g.ntile ? g.ntile : K / BK;
    unsigned voffA[2], voffB[2];
#pragma unroll
    for (int i = 0; i < 2; ++i) { int R, C; stage_rc(tid * 16 + i * 8192, R, C); const int Rb = (R & ~31) + perm32(R & 31);
        voffA[i] = (unsigned)(R * K + C) * 2u; voffB[i] = (unsigned)(Rb * K + C) * 2u; }
    const size_t kstep = (size_t)(BK * 2);
    const size_t hstep = (size_t)HALF * K * 2;
    const size_t tstep = 2 * hstep;
    const unsigned ldsw = (unsigned)wid * 1024u;
    const int aoff = lds_byte(wr * 64 + fr, fq * 8), boff = lds_byte(wc * 32 + fr, fq * 8);
#define PG8_SA(b, h) (((b) * 2 + (h)) * HTB)
#define PG8_SB(b, h) ((4 + (b) * 2 + (h)) * HTB)
#define PG8_STAGE(bufoff, gbase, voff) do { _Pragma("unroll") for (int _i = 0; _i < 2; ++_i) \
        __builtin_amdgcn_global_load_lds((const unsigned*)((const char*)(gbase) + (voff)[_i]), (LAS unsigned*)(lds + (bufoff) + ldsw + _i * 8192), 16, 0, 0); } while (0)
#define PG8_LD16(off) (*(const LAS i32x4*)(lds + (off)))
#define PG8_LDA(dst, b, h) do { if constexpr (FP8) { _Pragma("unroll") for (int m = 0; m < 4; ++m) dst##8[m] = __builtin_shufflevector(PG8_LD16(PG8_SA(b, h) + aoff + m * 2048), PG8_LD16(PG8_SA(b, h) + aoff + m * 2048 + 1024), 0, 1, 2, 3, 4, 5, 6, 7); } \
        else { _Pragma("unroll") for (int m = 0; m < 4; ++m) _Pragma("unroll") for (int k = 0; k < 2; ++k) dst[m][k] = *(const LAS bf16x8*)(lds + PG8_SA(b, h) + aoff + m * 2048 + k * 1024); } } while (0)
#define PG8_LDB(dst, b, h) do { if constexpr (FP8) { _Pragma("unroll") for (int n = 0; n < 2; ++n) dst##8[n] = __builtin_shufflevector(PG8_LD16(PG8_SB(b, h) + boff + n * 2048), PG8_LD16(PG8_SB(b, h) + boff + n * 2048 + 1024), 0, 1, 2, 3, 4, 5, 6, 7); } \
        else { _Pragma("unroll") for (int n = 0; n < 2; ++n) _Pragma("unroll") for (int k = 0; k < 2; ++k) dst[n][k] = *(const LAS bf16x8*)(lds + PG8_SB(b, h) + boff + n * 2048 + k * 1024); } } while (0)
#define PG8_MMA(ai, bj, At, Bt) do { __builtin_amdgcn_s_setprio(1); \
        if constexpr (FP8) { _Pragma("unroll") for (int m = 0; m < 4; ++m) _Pragma("unroll") for (int n = 0; n < 2; ++n) \
            asm volatile("v_mfma_scale_f32_16x16x128_f8f6f4 %0, %1, %2, %0, %3, %4 op_sel_hi:[0,0,0]" : "+v"(acc[ai][bj][m][n]) : "v"(Bt##8[n]), "v"(At##8[m]), "v"(sc_w), "v"(sc_1)); } \
        else if constexpr (MODE == 2) { _Pragma("unroll") for (int m = 0; m < 4; ++m) _Pragma("unroll") for (int n = 0; n < 2; ++n) _Pragma("unroll") for (int k = 0; k < 2; ++k) \
            acc[ai][bj][m][n] = __builtin_bit_cast(f32x4, __builtin_amdgcn_mfma_i32_16x16x64_i8(__builtin_bit_cast(i32x4, Bt[n][k]), __builtin_bit_cast(i32x4, At[m][k]), __builtin_bit_cast(i32x4, acc[ai][bj][m][n]), 0, 0, 0)); } \
        else { _Pragma("unroll") for (int m = 0; m < 4; ++m) _Pragma("unroll") for (int n = 0; n < 2; ++n) _Pragma("unroll") for (int k = 0; k < 2; ++k) \
            acc[ai][bj][m][n] = __builtin_amdgcn_mfma_f32_16x16x32_bf16(Bt[n][k], At[m][k], acc[ai][bj][m][n], 0, 0, 0); } \
        __builtin_amdgcn_s_setprio(0); } while (0)
#define PG8_WAIT_V(n) asm volatile("s_waitcnt vmcnt(" #n ")" ::: "memory")
#define PG8_WAIT_L(n) asm volatile("s_waitcnt lgkmcnt(" #n ")" ::: "memory")
#define PG8_BAR __builtin_amdgcn_s_barrier()
#define PG8_SCHED __builtin_amdgcn_sched_barrier(0)
    Unit cur, nxt; int ui = 0;
    if (!S.next(0, cur)) return;
    f32x4 acc[2][2][4][2];
#pragma unroll
    for (int a = 0; a < 2; ++a)
#pragma unroll
        for (int b = 0; b < 2; ++b)
#pragma unroll
            for (int m = 0; m < 4; ++m)
#pragma unroll
                for (int n = 0; n < 2; ++n) acc[a][b][m][n] = (f32x4){0.f, 0.f, 0.f, 0.f};
    bf16x8 At[4][2], B0[2][2], B1[2][2];
    const int sc_w = 0x79797979, sc_1 = g.sca;
    i32x8 At8[4], B08[2], B18[2];
    const char* cA = (const char*)g.A + (size_t)cur.pm * tstep; const char* cB = (const char*)g.Bt + (size_t)cur.pn * tstep;
    PG8_STAGE(PG8_SB(0, 0), cB, voffB); PG8_STAGE(PG8_SB(0, 1), cB + hstep, voffB); PG8_STAGE(PG8_SA(0, 0), cA, voffA); PG8_STAGE(PG8_SA(0, 1), cA + hstep, voffA);
    if (wr == 1) PG8_BAR;
    PG8_WAIT_V(2); PG8_BAR;
    PG8_STAGE(PG8_SB(1, 0), cB + kstep, voffB); PG8_STAGE(PG8_SA(1, 0), cA + kstep, voffA); PG8_STAGE(PG8_SB(1, 1), cB + hstep + kstep, voffB);
    PG8_WAIT_V(6); PG8_BAR;
    for (;;) {
        const bool has_next = S.next(ui + 1, nxt);
        const char* nA = has_next ? (const char*)g.A + (size_t)nxt.pm * tstep : cA; const char* nB = has_next ? (const char*)g.Bt + (size_t)nxt.pn * tstep : cB;
        for (int t = 0; t < nt; t += 2) {
            const bool last = (t == nt - 2);
            const char* a1 = cA + (size_t)(t + 1) * kstep;
            const char* a2 = last ? nA : cA + (size_t)(t + 2) * kstep; const char* b2 = last ? nB : cB + (size_t)(t + 2) * kstep;
            const char* a3 = a2 + kstep; const char* b3 = b2 + kstep;
            PG8_LDB(B0, 0, 0); PG8_LDB(B1, 0, 1); PG8_SCHED; PG8_LDA(At, 0, 0); PG8_STAGE(PG8_SA(1, 1), a1 + hstep, voffA);
            PG8_WAIT_V(8); PG8_WAIT_L(0); PG8_BAR; PG8_MMA(0, 0, At, B0); PG8_MMA(0, 1, At, B1); PG8_BAR; PG8_SCHED;
            PG8_LDA(At, 0, 1); PG8_STAGE(PG8_SB(0, 0), b2, voffB); PG8_STAGE(PG8_SB(0, 1), b2 + hstep, voffB); PG8_STAGE(PG8_SA(0, 0), a2, voffA);
            PG8_WAIT_V(8); PG8_WAIT_L(0); PG8_BAR; PG8_MMA(1, 0, At, B0); PG8_MMA(1, 1, At, B1); PG8_BAR; PG8_SCHED;
            PG8_LDB(B0, 1, 0); PG8_LDB(B1, 1, 1); PG8_SCHED; PG8_LDA(At, 1, 0); PG8_STAGE(PG8_SA(0, 1), a2 + hstep, voffA);
            PG8_WAIT_V(8); PG8_WAIT_L(0); PG8_BAR; PG8_MMA(0, 0, At, B0); PG8_MMA(0, 1, At, B1); PG8_BAR; PG8_SCHED;
            PG8_LDA(At, 1, 1); PG8_STAGE(PG8_SB(1, 0), b3, voffB); PG8_STAGE(PG8_SB(1, 1), b3 + hstep, voffB); PG8_STAGE(PG8_SA(1, 0), a3, voffA);
            PG8_WAIT_V(8); PG8_WAIT_L(0); PG8_BAR; PG8_MMA(1, 0, At, B0); PG8_MMA(1, 1, At, B1); PG8_BAR; PG8_SCHED;
        }
        if (wr == 0) PG8_BAR;
        if constexpr (FP8) asm volatile("s_nop 15\n\ts_nop 15" ::: "memory");
        E(acc, cur, wr, wc, fr, fq);
        if (!has_next) break;
#pragma unroll
        for (int a = 0; a < 2; ++a)
#pragma unroll
            for (int b = 0; b < 2; ++b)
#pragma unroll
                for (int m = 0; m < 4; ++m)
#pragma unroll
                    for (int n = 0; n < 2; ++n) acc[a][b][m][n] = (f32x4){0.f, 0.f, 0.f, 0.f};
        cur = nxt; cA = nA; cB = nB; ++ui;
        if (wr == 1) PG8_BAR;
    }
    PG8_WAIT_V(0);
    PG8_BAR;
#undef PG8_SA
#undef PG8_SB
#undef PG8_STAGE
#undef PG8_LDA
#undef PG8_LD16
#undef PG8_LDB
#undef PG8_MMA
#undef PG8_WAIT_V
#undef PG8_WAIT_L
#undef PG8_BAR
#undef PG8_SCHED
}
typedef f32x4 Acc[2][2][4][2];

struct EpiProj {
    unsigned char* ws; const float* bias; int shift_lo, shift; float qs;
    DI void operator()(const Acc& acc, const Unit& u, int wr, int wc, int fr, int fq) const {
        int row0 = u.pm * BM + wr * 64 + fr; const int pn = u.pn >= shift_lo ? u.pn + shift : u.pn;
        bf16_t* base; int ldc, ct; const float* bp = bias + pn * BM;
        if (u.pm >= 128) { base = (bf16_t*)(ws + WS_MKV); ldc = 2048; ct = pn - PN_KV; row0 -= T; bp = nullptr; }
        else if (pn < 6) { base = (bf16_t*)(ws + WS_QK1); ldc = 1536; ct = pn; }
        else if (pn < 12) { base = (bf16_t*)(ws + WS_V1); ldc = 1536; ct = pn - 6; }
        else if (pn < 18) { base = (bf16_t*)(ws + WS_QK2); ldc = 1536; ct = pn - 12; }
        else if (pn < 24) { base = (bf16_t*)(ws + WS_V2); ldc = 1536; ct = pn - 18; }
        else if (pn < 30) { base = (bf16_t*)(ws + WS_O1); ldc = 1536; ct = pn - 24; }
        else if (pn < 34) { base = (bf16_t*)(ws + WS_Q3); ldc = 1024; ct = pn - 30; }
        else if (pn < 40) { base = (bf16_t*)(ws + WS_Z1); ldc = 1536; ct = pn - 34; }
        else if (pn < 46) { base = (bf16_t*)(ws + WS_Z2); ldc = 1536; ct = pn - 40; }
        else if (pn < 50) { base = (bf16_t*)(ws + WS_Z3); ldc = 1024; ct = pn - 46; }
        else {
            if (wc == 0 && fq < 2) {
                float* IFp = (float*)(ws + WS_IF);
                const f32x4 b0 = *(const f32x4*)(bp + 8 * fq), b1 = *(const f32x4*)(bp + 8 * fq + 4);
#pragma unroll
                for (int ai = 0; ai < 2; ++ai)
#pragma unroll
                    for (int m = 0; m < 4; ++m) { float* rp = IFp + (size_t)(row0 + ai * HALF + m * 16) * 16 + 8 * fq;
                        *(f32x4*)rp = acc[ai][0][m][0] + b0; *(f32x4*)(rp + 4) = acc[ai][0][m][1] + b1; }
            }
            return;
        }
        const int col0 = ct * BM + wc * 32 + 8 * fq, bc0 = wc * 32 + 8 * fq;
        f32x4 bv[2][2];
#pragma unroll
        for (int bj = 0; bj < 2; ++bj)
#pragma unroll
            for (int n = 0; n < 2; ++n) bv[bj][n] = bp ? *(const f32x4*)(bp + bc0 + bj * HALF + 4 * n) : (f32x4){0.f, 0.f, 0.f, 0.f};
#pragma unroll
        for (int ai = 0; ai < 2; ++ai)
#pragma unroll
            for (int m = 0; m < 4; ++m) { bf16_t* rowp = base + (size_t)(row0 + ai * HALF + m * 16) * ldc + col0;
#pragma unroll
                for (int bj = 0; bj < 2; ++bj) { const f32x4 v0 = deq_acc(acc[ai][bj][m][0], qs) + bv[bj][0], v1 = deq_acc(acc[ai][bj][m][1], qs) + bv[bj][1];
                    u32x4 w; w.x = cvt_pk_bf16(v0[0], v0[1]); w.y = cvt_pk_bf16(v0[2], v0[3]); w.z = cvt_pk_bf16(v1[0], v1[1]); w.w = cvt_pk_bf16(v1[2], v1[3]);
                    *(u32x4*)(rowp + bj * HALF) = w; } }
    }
};
struct EpiGate {
    unsigned char* ws; const float* bias; float qs;
    DI void operator()(const Acc& acc, const Unit& u, int wr, int wc, int fr, int fq) const {
        const int row0 = u.pm * BM + wr * 64 + fr; const float* bp = bias + (PN_GATE + u.pn) * BM + wc * 32 + 8 * fq;
        const int ct = u.pn, gi = ct >> 3; bf16_t* G = (bf16_t*)(ws + (gi == 0 ? WS_G0 : WS_G12 + (size_t)(gi - 1) * SZ20));
        const int col0 = (ct & 7) * BM + wc * 32 + 8 * fq;
        f32x4 bv[2][2];
#pragma unroll
        for (int bj = 0; bj < 2; ++bj)
#pragma unroll
            for (int n = 0; n < 2; ++n) bv[bj][n] = *(const f32x4*)(bp + bj * HALF + 4 * n);
#pragma unroll
        for (int ai = 0; ai < 2; ++ai)
#pragma unroll
            for (int m = 0; m < 4; ++m) { bf16_t* rowp = G + (size_t)(row0 + ai * HALF + m * 16) * 2048 + col0;
#pragma unroll
                for (int bj = 0; bj < 2; ++bj) { f32x4 v0 = deq_acc(acc[ai][bj][m][0], qs) + bv[bj][0], v1 = deq_acc(acc[ai][bj][m][1], qs) + bv[bj][1];
#pragma unroll
                    for (int e = 0; e < 4; ++e) { v0[e] = sigmoidf_(v0[e]); v1[e] = sigmoidf_(v1[e]); }
                    u32x4 w; w.x = cvt_pk_bf16(v0[0], v0[1]); w.y = cvt_pk_bf16(v0[2], v0[3]); w.z = cvt_pk_bf16(v1[0], v1[1]); w.w = cvt_pk_bf16(v1[2], v1[3]);
                    *(u32x4*)(rowp + bj * HALF) = w; } }
    }
};
struct EpiMerge {
    bf16_t* merged; const bf16_t* G; int gi;
    DI void operator()(const Acc& acc, const Unit& u, int wr, int wc, int fr, int fq) const {
        const int row0 = u.pm * BM + wr * 64 + fr, col0 = u.pn * BM + wc * 32 + 8 * fq;
#pragma unroll
        for (int ai = 0; ai < 2; ++ai)
#pragma unroll
            for (int m = 0; m < 4; ++m) { const size_t r = (size_t)(row0 + ai * HALF + m * 16);
#pragma unroll
                for (int bj = 0; bj < 2; ++bj) {
                    const u32x4 gv = *(const u32x4*)(G + r * 2048 + col0 + bj * HALF);
                    bf16_t* mp = merged + r * 2048 + col0 + bj * HALF;
                    const f32x4 a0 = acc[ai][bj][m][0], a1 = acc[ai][bj][m][1];
                    float o[8] = {a0[0] * bflo(gv.x), a0[1] * bfhi(gv.x), a0[2] * bflo(gv.y), a0[3] * bfhi(gv.y), a1[0] * bflo(gv.z), a1[1] * bfhi(gv.z), a1[2] * bflo(gv.w), a1[3] * bfhi(gv.w)};
                    if (gi > 0) { const u32x4 pv = __builtin_nontemporal_load((const u32x4*)mp);
                        o[0] += bflo(pv.x); o[1] += bfhi(pv.x); o[2] += bflo(pv.y); o[3] += bfhi(pv.y); o[4] += bflo(pv.z); o[5] += bfhi(pv.z); o[6] += bflo(pv.w); o[7] += bfhi(pv.w); }
                    u32x4 w; w.x = cvt_pk_bf16(o[0], o[1]); w.y = cvt_pk_bf16(o[2], o[3]); w.z = cvt_pk_bf16(o[4], o[5]); w.w = cvt_pk_bf16(o[6], o[7]);
                    *(u32x4*)mp = w; } }
    }
};
struct EpiOut {
    bf16_t* D;
    DI void operator()(const Acc& acc, const Unit& u, int wr, int wc, int fr, int fq) const {
        const int row0 = u.pm * BM + wr * 64 + fr, col0 = u.pn * BM + wc * 32 + 8 * fq;
#pragma unroll
        for (int ai = 0; ai < 2; ++ai)
#pragma unroll
            for (int m = 0; m < 4; ++m) { bf16_t* rowp = D + (size_t)(row0 + ai * HALF + m * 16) * 2048 + col0;
#pragma unroll
                for (int bj = 0; bj < 2; ++bj) { const f32x4 v0 = acc[ai][bj][m][0], v1 = acc[ai][bj][m][1];
                    u32x4 w; w.x = cvt_pk_bf16(v0[0], v0[1]); w.y = cvt_pk_bf16(v0[2], v0[3]); w.z = cvt_pk_bf16(v1[0], v1[1]); w.w = cvt_pk_bf16(v1[2], v1[3]);
                    *(u32x4*)(rowp + bj * HALF) = w; } }
    }
};
}

DI int src_col_of(int n) {
    if (n < 3072) return n;
    if (n < 4608) return n - 3072 + 6156;
    if (n < 6144) return n - 4608 + 7692;
    if (n < 7680) return n - 6144 + 3072;
    if (n < 8704) return n - 7680 + 10764;
    if (n < 10240) return n - 8704 + 4608;
    if (n < 11776) return n - 10240 + 9228;
    if (n < 12800) return n - 11776 + 11788;
    if (n < 12812) return n - 12800 + 6144;
    if (n < 13056) return -1;
    return n - 13056 + 12812;
}
struct TpItem { const float* W; bf16_t* WT; unsigned char* W8; int Nsrc, K, n0, k0, remap, n8, m8; };
DI bool tp_decode(const Params& P, int it, TpItem& t) {
    constexpr int I_IN = 300 * 8, I_KV = 32 * 8, I_ML = 32 * 6, I_RET = 32 * 6, I_XA = 32 * 4, I_OUT = 32 * 8;
    unsigned char* ws = P.ws; int r = it; t.remap = 0; t.W8 = nullptr; t.n8 = 0; t.m8 = 2;
    if (r < I_IN) { t.W = P.w_in; t.WT = (bf16_t*)(ws + WS_WIN); t.Nsrc = N_IN; t.K = 2048; t.n0 = (r >> 3) * 64; t.k0 = (r & 7) * 256; t.remap = 1;
        if (t.n0 >= 1536 && t.n0 < 3072) { t.W8 = ws + WS_WV8; t.n8 = t.n0 - 1536; }
        else if (t.n0 >= 10240 && t.n0 < 11776) { t.W8 = ws + WS_WZ8; t.n8 = t.n0 - 10240; }
        else if (t.n0 >= 6144 && t.n0 < 10240) { t.W8 = (unsigned char*)P.out + DO_WO8; t.n8 = t.n0 - 6144; }
        else if (t.n0 >= 11776 && t.n0 < 12800) { t.W8 = (unsigned char*)P.out + DO_WO8; t.n8 = t.n0 - 11776 + 4096; }
        else if (t.n0 >= 13056) { t.W8 = (unsigned char*)P.out + DO_WG8; t.n8 = t.n0 - 13056; }
        return true; } r -= I_IN;
    if (r < I_KV) { t.W = P.w_kv; t.WT = (bf16_t*)(ws + WS_WKV); t.Nsrc = 2048; t.K = 2048; t.n0 = (r >> 3) * 64; t.k0 = (r & 7) * 256; return true; } r -= I_KV;
    if (r < I_ML) { t.W = P.w_ml; t.WT = (bf16_t*)(ws + WS_WML); t.Nsrc = 2048; t.K = 1536; t.n0 = (r / 6) * 64; t.k0 = (r % 6) * 256; return true; } r -= I_ML;
    if (r < I_RET) { t.W = P.w_ret; t.WT = (bf16_t*)(ws + WS_WRET); t.Nsrc = 2048; t.K = 1536; t.n0 = (r / 6) * 64; t.k0 = (r % 6) * 256; return true; } r -= I_RET;
    if (r < I_XA) { t.W = P.w_xa; t.WT = (bf16_t*)(ws + WS_WXA); t.Nsrc = 2048; t.K = 1024; t.n0 = (r >> 2) * 64; t.k0 = (r & 3) * 256; t.W8 = (unsigned char*)P.out + DO_WX8; t.n8 = t.n0; t.m8 = 1; return true; } r -= I_XA;
    if (r < I_OUT) { t.W = P.w_out; t.WT = (bf16_t*)(ws + WS_WOUT); t.Nsrc = 2048; t.K = 2048; t.n0 = (r >> 3) * 64; t.k0 = (r & 7) * 256; return true; }
    return false;
}
DI void tp_load(const TpItem& t, int tid, f32x4 (&v)[8]) {
    const int nq = tid & 15, kk0 = tid >> 4; const int src = t.remap ? src_col_of(t.n0 + 4 * nq) : (t.n0 + 4 * nq);
#pragma unroll
    for (int i = 0; i < 8; ++i) v[i] = src >= 0 ? *(const f32x4*)(t.W + (size_t)(t.k0 + kk0 + 32 * i) * t.Nsrc + src) : (f32x4){0.f, 0.f, 0.f, 0.f};
}
DI void p0_transposes(const Params& P, LAS unsigned char* lds) {
    const int tid = opaque_tid(), G = gridDim.x, bx = blockIdx.x, nq = tid & 15, kk0 = tid >> 4;
    LAS bf16_t* tile = (LAS bf16_t*)lds;
    TpItem cur, nxt; f32x4 v[8];
    int it = bx; bool have = tp_decode(P, it, cur);
    if (have) tp_load(cur, tid, v);
    while (have) {
        if (cur.W8) {
#pragma unroll
            for (int i = 0; i < 8; ++i) { const int kk = kk0 + 32 * i; unsigned q = 0u;
                if (cur.m8 == 2) q = pack_i8x4(v[i][0], v[i][1], v[i][2], v[i][3], W8_SCALE);
                else { q = __builtin_amdgcn_cvt_pk_fp8_f32(v[i][0] * 64.f, v[i][1] * 64.f, q, false); q = __builtin_amdgcn_cvt_pk_fp8_f32(v[i][2] * 64.f, v[i][3] * 64.f, q, true); }
#pragma unroll
                for (int e = 0; e < 4; ++e) *(LAS unsigned char*)(lds + (4 * nq + e) * 272 + kk) = (unsigned char)(q >> (8 * e)); }
        } else {
#pragma unroll
            for (int i = 0; i < 8; ++i) { const int kk = kk0 + 32 * i;
#pragma unroll
                for (int e = 0; e < 4; ++e) tile[(4 * nq + e) * 264 + kk] = (bf16_t)(cvt_pk_bf16(v[i][e], 0.f) & 0xffffu); }
        }
        __syncthreads();
        it += G; const bool hn = tp_decode(P, it, nxt);
        if (hn) tp_load(nxt, tid, v);
        if (cur.W8) {
#pragma unroll
            for (int j = 0; j < 2; ++j) { const int p = tid + 512 * j, n2 = p >> 4, kq = p & 15; const u32x4 tv = *(const LAS u32x4*)(lds + n2 * 272 + kq * 16); *(u32x4*)(cur.W8 + (size_t)(cur.n8 + n2) * cur.K + cur.k0 + 16 * kq) = tv; }
        } else {
#pragma unroll
            for (int j = 0; j < 4; ++j) { const int p = tid + 512 * j, n2 = p >> 5, kq = p & 31; const u32x4 tv = *(const LAS u32x4*)(lds + n2 * 528 + kq * 16); *(u32x4*)(cur.WT + (size_t)(cur.n0 + n2) * cur.K + cur.k0 + 8 * kq) = tv; }
        }
        __syncthreads();
        cur = nxt; have = hn;
    }
}
DI void rms_row(const float* xr, const float* g, bf16_t* o, unsigned char* o8, int lane) {
    f32x4 v[8]; float s = 0.f;
#pragma unroll
    for (int i = 0; i < 8; ++i) { v[i] = *(const f32x4*)(xr + 4 * (lane + 64 * i)); s += v[i][0] * v[i][0] + v[i][1] * v[i][1] + v[i][2] * v[i][2] + v[i][3] * v[i][3]; }
    s = wave_sum(s); const float sc = rsqrtf(s * (1.0f / 2048.0f) + EPS);
#pragma unroll
    for (int i = 0; i < 8; ++i) { const f32x4 gg = *(const f32x4*)(g + 4 * (lane + 64 * i)); const f32x4 y = v[i] * sc * gg;
        u32x2 w; w.x = cvt_pk_bf16(y[0], y[1]); w.y = cvt_pk_bf16(y[2], y[3]); *(u32x2*)(o + 4 * (lane + 64 * i)) = w;
        if (o8) *(unsigned*)(o8 + 4 * (lane + 64 * i)) = pack_i8x4(y[0], y[1], y[2], y[3], H8_SCALE); }
}
DI void p0_prologue(const Params& P, LAS unsigned char* lds) {
    const int tid = opaque_tid(), lane = tid & 63, wave = tid >> 6, G = gridDim.x, bx = blockIdx.x;
    unsigned char* ws = P.ws;
    if (bx == 0 && tid < 64) ((unsigned*)(ws + WS_CTL))[tid] = 0u;
    if (bx == 0) for (int i = tid; i < 3456; i += 512) ((unsigned*)(ws + WS_BAR))[i] = 0u;
    for (int i = bx * 512 + tid; i < T; i += G * 512) ((float*)(ws + WS_SS))[i] = 0.f;
    for (int i = bx * 512 + tid; i < NPAD; i += G * 512) { const int s = src_col_of(i); ((float*)(ws + WS_BIAS))[i] = s >= 0 ? P.b_in[s] : 0.f; }
    bf16_t* H = (bf16_t*)((unsigned char*)P.out + DO_H);
    for (int r = bx * 8 + wave; r < T + 2048; r += G * 8) {
        if (r < T) rms_row(P.x + (size_t)r * DM, P.ln_g, H + (size_t)r * DM, ws + WS_H8 + (size_t)r * DM, lane);
        else rms_row(P.mem + (size_t)(r - T) * DM, P.mem_ln_g, H + (size_t)r * DM, nullptr, lane);
    }
    p0_transposes(P, lds);
}

DI float logsigmoidf_(float v) { return fminf(v, 0.f) - log1pf(expf(-fabsf(v))); }
DI void p2_gates_wg(const Params& P, int bh, LAS unsigned char* lds) {
    const int tid = opaque_tid(), lane = tid & 63, wave = tid >> 6;
    unsigned char* ws = P.ws; const int b = bh / 6, h = bh % 6;
    const float* IFp = (const float*)(ws + WS_IF) + (size_t)b * SEQ * 16;
    float* A1 = (float*)(ws + WS_GS) + (size_t)bh * SEQ; float* IB = A1 + GS_ARR; float* INTER = IB + GS_ARR; float* EDEN = INTER + GS_ARR; float* W = EDEN + GS_ARR;
    float* DEC = (float*)(ws + WS_GDEC) + bh * 64;
    LAS f32x2* AB = (LAS f32x2*)lds;
    float iv[8], fv[8], bbv[8], ibv[8], mxv[8], gv[8], mxa[8];
#pragma unroll
    for (int k = 0; k < 8; ++k) { const int t = (wave * 8 + k) * 64 + lane; iv[k] = IFp[(size_t)t * 16 + h]; fv[k] = IFp[(size_t)t * 16 + 6 + h]; }
#pragma unroll
    for (int k = 0; k < 8; ++k) {
        float bb = logsigmoidf_(fv[k]);
#pragma unroll
        for (int o = 1; o < 64; o <<= 1) { const float u = __shfl_up(bb, o); if (lane >= o) bb += u; }
        const float g = __shfl(bb, 63), ib = iv[k] - bb;
        float mx = ib;
#pragma unroll
        for (int o = 1; o < 64; o <<= 1) { const float u = __shfl_up(mx, o); if (lane >= o) mx = fmaxf(mx, u); }
        const float mxall = __shfl(mx, 63);
        bbv[k] = bb; ibv[k] = ib; mxv[k] = mx; gv[k] = g; mxa[k] = mxall;
        if (lane == 0) AB[wave * 8 + k] = (f32x2){g, g + mxall};
        __builtin_amdgcn_sched_barrier(0);
    }
    __syncthreads();
    float m = 0.f;
    for (int c = 0; c < wave * 8; ++c) { const f32x2 ab = AB[c]; m = fmaxf(m + ab.x, ab.y); }
#pragma unroll
    for (int k = 0; k < 8; ++k) {
        const int c = wave * 8 + k, t = c * 64 + lane;
        const float log_inter = bbv[k] + m, m_row = fmaxf(log_inter, bbv[k] + mxv[k]);
        const float m_new = fmaxf(gv[k] + m, gv[k] + mxa[k]);
        A1[t] = bbv[k] - m_row; IB[t] = ibv[k]; INTER[t] = expf(log_inter - m_row); EDEN[t] = expf(-m_row); W[t] = expf(gv[k] + ibv[k] - m_new);
        if (lane == 0) DEC[c] = expf(gv[k] + m - m_new);
        m = m_new;
        __builtin_amdgcn_sched_barrier(0);
    }
    __syncthreads();
}
DI void p2_prep(const Params& P, LAS unsigned char* lds) {
    const int tid = opaque_tid(), lane = tid & 63, wave = tid >> 6, G = gridDim.x, bx = blockIdx.x;
    unsigned char* ws = P.ws;
    for (int it = bx; it < 48; it += G) p2_gates_wg(P, it, lds);
    if (bx == (G > 48 ? 48 : 0) && tid < 6 * 64) {
        const int h = tid >> 6, l = tid & 63; const float lg = logf(1.0f - exp2f(-5.0f - (float)h));
        float* RV = (float*)(ws + WS_RV) + h * 5 * 64;
        RV[l] = (float)l * lg; RV[64 + l] = -(float)l * lg; RV[128 + l] = expf((float)(l + 1) * lg); RV[192 + l] = 1.0f; RV[256 + l] = expf((float)(63 - l) * lg);
        if (l == 0) ((float*)(ws + WS_RV))[6 * 5 * 64 + h] = expf(64.0f * lg);
    }
    const bf16_t* QK1 = (const bf16_t*)(ws + WS_QK1); bf16_t* QKC = (bf16_t*)((unsigned char*)P.out + DO_QKC);
    for (int idx = bx * 512 + tid; idx < (T / 16) * 192; idx += G * 512) {
        const int rb = idx / 192, cgp = idx % 192, r0 = rb * 16, c0 = cgp * 8;
        float w[4][8], bz[8], u[3][8];
#pragma unroll
        for (int k = 0; k < 4; ++k) { const f32x4 a = *(const f32x4*)(P.conv_w + k * 1536 + c0), b = *(const f32x4*)(P.conv_w + k * 1536 + c0 + 4);
            w[k][0] = a[0]; w[k][1] = a[1]; w[k][2] = a[2]; w[k][3] = a[3]; w[k][4] = b[0]; w[k][5] = b[1]; w[k][6] = b[2]; w[k][7] = b[3]; }
        { const f32x4 a = *(const f32x4*)(P.conv_b + c0), b = *(const f32x4*)(P.conv_b + c0 + 4); bz[0] = a[0]; bz[1] = a[1]; bz[2] = a[2]; bz[3] = a[3]; bz[4] = b[0]; bz[5] = b[1]; bz[6] = b[2]; bz[7] = b[3]; }
        const bool hist = (r0 & (SEQ - 1)) != 0;
#pragma unroll
        for (int k = 0; k < 3; ++k) {
            u32x4 v = (u32x4){0u, 0u, 0u, 0u}; if (hist) v = *(const u32x4*)(QK1 + (size_t)(r0 - 3 + k) * 1536 + c0);
            u[k][0] = bflo(v.x); u[k][1] = bfhi(v.x); u[k][2] = bflo(v.y); u[k][3] = bfhi(v.y); u[k][4] = bflo(v.z); u[k][5] = bfhi(v.z); u[k][6] = bflo(v.w); u[k][7] = bfhi(v.w); }
        const float sc = c0 < 768 ? 0.08838834764831845f : 1.0f;
        for (int rh = 0; rh < 16; rh += 8) {
        u32x4 rows[8];
#pragma unroll
        for (int r = 0; r < 8; ++r) rows[r] = *(const u32x4*)(QK1 + (size_t)(r0 + rh + r) * 1536 + c0);
#pragma unroll
        for (int rr = 0; rr < 8; ++rr) { const int r = rh + rr;
            const u32x4 v = rows[rr];
            const float cu[8] = {bflo(v.x), bfhi(v.x), bflo(v.y), bfhi(v.y), bflo(v.z), bfhi(v.z), bflo(v.w), bfhi(v.w)};
            float y[8];
#pragma unroll
            for (int e = 0; e < 8; ++e) { const float a = bz[e] + w[0][e] * u[0][e] + w[1][e] * u[1][e] + w[2][e] * u[2][e] + w[3][e] * cu[e]; y[e] = siluf_(a) * sc; u[0][e] = u[1][e]; u[1][e] = u[2][e]; u[2][e] = cu[e]; }
            u32x4 o; o.x = cvt_pk_bf16(y[0], y[1]); o.y = cvt_pk_bf16(y[2], y[3]); o.z = cvt_pk_bf16(y[4], y[5]); o.w = cvt_pk_bf16(y[6], y[7]);
            *(u32x4*)(QKC + (size_t)(r0 + r) * 1536 + c0) = o;
        }
        }
    }
    bf16_t* QK2 = (bf16_t*)(ws + WS_QK2);
    for (int idx = bx * 512 + tid; idx < T * 8; idx += G * 512) {
        const int tok = idx >> 3, dg = idx & 7; const float pos = (float)P.pos[tok];
        float cs[8], sn[8];
#pragma unroll
        for (int j = 0; j < 8; ++j) { const float fr = exp2f(-(float)(dg * 8 + j) * (13.287712379549449f / 64.0f)); const float ang = pos * fr;
            double rev = (double)ang * 0.15915494309189535; rev -= rint(rev); const float rf = (float)rev;
            sn[j] = __builtin_amdgcn_sinf(rf); cs[j] = __builtin_amdgcn_cosf(rf); }
        for (int hg = 0; hg < 4; ++hg) {
            u32x4 la[3], lb[3];
#pragma unroll
            for (int k = 0; k < 3; ++k) { const bf16_t* p = QK2 + (size_t)tok * 1536 + (hg * 3 + k) * 128 + dg * 8; la[k] = *(const u32x4*)p; lb[k] = *(const u32x4*)(p + 64); }
#pragma unroll
            for (int k = 0; k < 3; ++k) {
                bf16_t* p = QK2 + (size_t)tok * 1536 + (hg * 3 + k) * 128 + dg * 8; const float sc = hg >= 2 ? 0.08838834764831845f : 1.0f;
                const u32x4 a = la[k], b = lb[k];
                const float t1[8] = {bflo(a.x), bfhi(a.x), bflo(a.y), bfhi(a.y), bflo(a.z), bfhi(a.z), bflo(a.w), bfhi(a.w)};
                const float t2[8] = {bflo(b.x), bfhi(b.x), bflo(b.y), bfhi(b.y), bflo(b.z), bfhi(b.z), bflo(b.w), bfhi(b.w)};
                float o1[8], o2[8];
#pragma unroll
                for (int j = 0; j < 8; ++j) { o1[j] = (t1[j] * cs[j] - t2[j] * sn[j]) * sc; o2[j] = (t1[j] * sn[j] + t2[j] * cs[j]) * sc; }
                u32x4 x1, x2; x1.x = cvt_pk_bf16(o1[0], o1[1]); x1.y = cvt_pk_bf16(o1[2], o1[3]); x1.z = cvt_pk_bf16(o1[4], o1[5]); x1.w = cvt_pk_bf16(o1[6], o1[7]);
                x2.x = cvt_pk_bf16(o2[0], o2[1]); x2.y = cvt_pk_bf16(o2[2], o2[3]); x2.z = cvt_pk_bf16(o2[4], o2[5]); x2.w = cvt_pk_bf16(o2[6], o2[7]);
                *(u32x4*)p = x1; *(u32x4*)(p + 64) = x2;
            }
        }
    }
}

constexpr int SQ_P = 272, SV_P = 528, ST_P = 144;
constexpr int SC_STAGE = 64 * SQ_P * 2 + 64 * SV_P;
constexpr int SC_ST = 2 * SC_STAGE;
constexpr int SC_NV = SC_ST + 64 * ST_P;
constexpr int SC_RDEN = SC_NV + 512;
constexpr int SC_LNP = SC_RDEN + 256;
constexpr int SC_VEC = SC_LNP + 4096;
constexpr int SC_GAIN = SC_VEC + 2560;
constexpr int SC_END = SC_GAIN + 1024;
static_assert(SC_END <= LDS_BYTES, "scan LDS");

DI void scan_item(const Params& P, LAS unsigned char* lds, int item) {
    const int tid = opaque_tid(), lane = tid & 63, w = __builtin_amdgcn_readfirstlane(tid >> 6), r = lane & 15, g = lane >> 4, q4 = r >> 2, p4 = r & 3;
    unsigned char* ws = P.ws;
    const bool is_ml = item < 48; const int bh = is_ml ? item : item - 48, b = bh / 6, h = bh % 6;
    const bf16_t* Qg = (is_ml ? (const bf16_t*)((unsigned char*)P.out + DO_QKC) : (const bf16_t*)(ws + WS_QK2)) + (size_t)b * SEQ * 1536 + h * 128;
    const bf16_t* Kg = Qg + 768;
    bf16_t* Vg = (bf16_t*)(ws + (is_ml ? WS_V1 : WS_V2)) + (size_t)b * SEQ * 1536 + h * 256;
    const float* vbase; const float* vDEC; int cstr, dstr; size_t vstr;
    if (is_ml) { vbase = (const float*)(ws + WS_GS) + (size_t)bh * SEQ; vstr = GS_ARR; vDEC = (const float*)(ws + WS_GDEC) + bh * 64; cstr = 64; dstr = 1; }
    else { vbase = (const float*)(ws + WS_RV) + h * 320; vstr = 64; vDEC = (const float*)(ws + WS_RV) + 6 * 320 + h; cstr = 0; dstr = 0; }
    const float* vptr = vbase + (size_t)(tid >> 6) * vstr + (tid & 63);
    const unsigned ldsb = (unsigned)(size_t)lds;
    f32x4 Cacc[8][2];
#pragma unroll
    for (int i = 0; i < 8; ++i) { Cacc[i][0] = (f32x4){0.f, 0.f, 0.f, 0.f}; Cacc[i][1] = (f32x4){0.f, 0.f, 0.f, 0.f}; }
    if (tid < 128) ((LAS float*)(lds + SC_NV))[tid] = 0.f;
    if (tid < 64) ((LAS float*)(lds + SC_RDEN))[tid] = 1.0f;
    u32x4 pq[2], pk[2], pv[4];
    unsigned qoff = (unsigned)(tid >> 4) * 3072u + (unsigned)(tid & 15) * 16u, voff = (unsigned)(tid >> 5) * 3072u + (unsigned)(tid & 31) * 16u, zoff = (unsigned)r * 3072u + (unsigned)(32 * w + 8 * g) * 2u;
#define SC_LOAD(c) do { const size_t cb = (size_t)(c) * 64 * 3072; const char* qb_ = (const char*)Qg + cb; const char* kb_ = (const char*)Kg + cb; const char* vb_ = (const char*)Vg + cb; \
        _Pragma("unroll") for (int i = 0; i < 2; ++i) { pq[i] = *(const u32x4*)(qb_ + (qoff + i * 98304u)); pk[i] = *(const u32x4*)(kb_ + (qoff + i * 98304u)); } \
        _Pragma("unroll") for (int i = 0; i < 4; ++i) { pv[i] = *(const u32x4*)(vb_ + (voff + i * 49152u)); } } while (0)
#define SC_STORE(st) do { LAS unsigned char* sb = lds + (st) * SC_STAGE; \
        _Pragma("unroll") for (int i = 0; i < 2; ++i) { const int pp = tid + 512 * i, row = pp >> 4, ch = pp & 15; *(LAS u32x4*)(sb + row * SQ_P + ch * 16) = pq[i]; *(LAS u32x4*)(sb + 64 * SQ_P + row * SQ_P + ch * 16) = pk[i]; } \
        _Pragma("unroll") for (int i = 0; i < 4; ++i) { const int pp = tid + 512 * i, row = pp >> 5, ch = pp & 31; *(LAS u32x4*)(sb + 128 * SQ_P + row * SV_P + ch * 16) = pv[i]; } } while (0)
    SC_LOAD(0); SC_STORE(0);
    if (tid < 320) ((LAS float*)(lds + SC_VEC))[tid] = vptr[0];
    __syncthreads();

    for (int c = 0; c < 64; ++c) {
        const int cur = c & 1;
        asm volatile("" : "+v"(qoff), "+v"(voff), "+v"(zoff));
        LAS unsigned char* Qs = lds + cur * SC_STAGE; LAS unsigned char* Ks = Qs + 64 * SQ_P; LAS unsigned char* Vs = Qs + 128 * SQ_P;
        const unsigned KsA = ldsb + cur * SC_STAGE + 64 * SQ_P, VsA = ldsb + cur * SC_STAGE + 128 * SQ_P;
        const LAS float* cA1 = (const LAS float*)(lds + SC_VEC + cur * 1280); const LAS float* cIB = cA1 + 64; const LAS float* cINT = cA1 + 128; const LAS float* cEDEN = cA1 + 192; const LAS float* cW = cA1 + 256;
        const float decay = vDEC[c * dstr];
        {
            const int mb = w >> 1, l = 16 * mb + r; const float a1 = cA1[l];
            bf16x8 qf[4];
#pragma unroll
            for (int ks = 0; ks < 4; ++ks) qf[ks] = *(const LAS bf16x8*)(Qs + l * SQ_P + (32 * ks + 8 * g) * 2);
#pragma unroll
            for (int nn = 0; nn < 2; ++nn) {
                const int nb = 2 * (w & 1) + nn; u32x2 o = (u32x2){0u, 0u};
                if (nb <= mb) {
                    f32x4 s = (f32x4){0.f, 0.f, 0.f, 0.f};
#pragma unroll
                    for (int ks = 0; ks < 4; ++ks) { const bf16x8 kf = *(const LAS bf16x8*)(Ks + (16 * nb + r) * SQ_P + (32 * ks + 8 * g) * 2); s = MFMA16(kf, qf[ks], s); }
                    const f32x4 ib = *(const LAS f32x4*)(cIB + 16 * nb + 4 * g);
                    float d[4];
#pragma unroll
                    for (int j = 0; j < 4; ++j) { const int sidx = 16 * nb + 4 * g + j; d[j] = (sidx <= l) ? s[j] * __expf(a1 + ib[j]) : 0.f; }
                    o.x = cvt_pk_bf16(d[0], d[1]); o.y = cvt_pk_bf16(d[2], d[3]);
                }
                *(LAS u32x2*)(lds + SC_ST + l * ST_P + (16 * nb + 4 * g) * 2) = o;
            }
        }
        LBAR();
        if (is_ml) {
            const int l = tid >> 3, part = tid & 7;
            const u32x4 sv = *(const LAS u32x4*)(lds + SC_ST + l * ST_P + part * 16);
            float ssum = bflo(sv.x) + bfhi(sv.x) + bflo(sv.y) + bfhi(sv.y) + bflo(sv.z) + bfhi(sv.z) + bflo(sv.w) + bfhi(sv.w);
            const u32x4 q0 = *(const LAS u32x4*)(Qs + l * SQ_P + part * 32), q1 = *(const LAS u32x4*)(Qs + l * SQ_P + part * 32 + 16);
            const LAS f32x4* nv = (const LAS f32x4*)(lds + SC_NV + part * 64);
            const f32x4 n0 = nv[0], n1 = nv[1], n2 = nv[2], n3 = nv[3];
            float qn = bflo(q0.x) * n0[0] + bfhi(q0.x) * n0[1] + bflo(q0.y) * n0[2] + bfhi(q0.y) * n0[3] + bflo(q0.z) * n1[0] + bfhi(q0.z) * n1[1] + bflo(q0.w) * n1[2] + bfhi(q0.w) * n1[3]
                     + bflo(q1.x) * n2[0] + bfhi(q1.x) * n2[1] + bflo(q1.y) * n2[2] + bfhi(q1.y) * n2[3] + bflo(q1.z) * n3[0] + bfhi(q1.z) * n3[1] + bflo(q1.w) * n3[2] + bfhi(q1.w) * n3[3];
            float val = ssum + cINT[l] * qn;
            val += __shfl_xor(val, 1); val += __shfl_xor(val, 2); val += __shfl_xor(val, 4);
            if (part == 0) ((LAS float*)(lds + SC_RDEN))[l] = 1.0f / fmaxf(fabsf(val), cEDEN[l]);
        }
        __builtin_amdgcn_sched_barrier(0);
        LBAR();
        bf16x8 vf[2][2];
        unsigned vtb = VsA + (8 * g + q4) * SV_P + (32 * w + 8 * p4) * 2; asm volatile("" : "+v"(vtb));
        unsigned ktb = KsA + (8 * g + q4) * SQ_P + (4 * p4) * 2; asm volatile("" : "+v"(ktb));
        { s16x4 t8[8];
          tr_read8(t8, vtb, vtb + 4 * SV_P, vtb + 32 * SV_P, vtb + 36 * SV_P, vtb + 8, vtb + 8 + 4 * SV_P, vtb + 8 + 32 * SV_P, vtb + 8 + 36 * SV_P);
          vf[0][0] = __builtin_shufflevector(t8[0], t8[1], 0, 1, 2, 3, 4, 5, 6, 7); vf[0][1] = __builtin_shufflevector(t8[2], t8[3], 0, 1, 2, 3, 4, 5, 6, 7);
          vf[1][0] = __builtin_shufflevector(t8[4], t8[5], 0, 1, 2, 3, 4, 5, 6, 7); vf[1][1] = __builtin_shufflevector(t8[6], t8[7], 0, 1, 2, 3, 4, 5, 6, 7); }
        f32x4 hi_[4][2], hx_[4][2];
#pragma unroll
        for (int mb = 0; mb < 4; ++mb)
#pragma unroll
            for (int vt = 0; vt < 2; ++vt) { hi_[mb][vt] = (f32x4){0.f, 0.f, 0.f, 0.f}; hx_[mb][vt] = (f32x4){0.f, 0.f, 0.f, 0.f}; }
#pragma unroll
        for (int mb = 0; mb < 4; ++mb)
#pragma unroll
            for (int ks = 0; ks < 2; ++ks) {
                if (ks == 1 && mb < 2) continue;
                const bf16x8 sf = *(const LAS bf16x8*)(lds + SC_ST + (16 * mb + r) * ST_P + (32 * ks + 8 * g) * 2);
                hi_[mb][0] = MFMA16(vf[0][ks], sf, hi_[mb][0]); hi_[mb][1] = MFMA16(vf[1][ks], sf, hi_[mb][1]);
            }
#pragma unroll
        for (int p = 0; p < 4; ++p) {
            bf16x8 cf[2];
#pragma unroll
            for (int vt = 0; vt < 2; ++vt) { u32x4 t; const f32x4 c0 = Cacc[2 * p][vt], c1 = Cacc[2 * p + 1][vt];
                t.x = cvt_pk_bf16(c0[0], c0[1]); t.y = cvt_pk_bf16(c0[2], c0[3]); t.z = cvt_pk_bf16(c1[0], c1[1]); t.w = cvt_pk_bf16(c1[2], c1[3]); cf[vt] = __builtin_bit_cast(bf16x8, t); }
#pragma unroll
            for (int mb = 0; mb < 4; ++mb) {
                const u32x2 qa = *(const LAS u32x2*)(Qs + (16 * mb + r) * SQ_P + (32 * p + 4 * g) * 2), qb = *(const LAS u32x2*)(Qs + (16 * mb + r) * SQ_P + (32 * p + 16 + 4 * g) * 2);
                u32x4 t; t.x = qa.x; t.y = qa.y; t.z = qb.x; t.w = qb.y; const bf16x8 qf2 = __builtin_bit_cast(bf16x8, t);
                hx_[mb][0] = MFMA16(cf[0], qf2, hx_[mb][0]); hx_[mb][1] = MFMA16(cf[1], qf2, hx_[mb][1]);
            }
            __builtin_amdgcn_sched_barrier(0);
        }
#pragma unroll
        for (int mb = 0; mb < 4; ++mb) { const int l = 16 * mb + r; const float it = cINT[l], rd = ((const LAS float*)(lds + SC_RDEN))[l];
            float v[8];
#pragma unroll
            for (int vt = 0; vt < 2; ++vt)
#pragma unroll
                for (int j = 0; j < 4; ++j) v[4 * vt + j] = (hi_[mb][vt][j] + it * hx_[mb][vt][j]) * rd;
            u32x4 st; st.x = cvt_pk_bf16(v[0], v[1]); st.y = cvt_pk_bf16(v[2], v[3]); st.z = cvt_pk_bf16(v[4], v[5]); st.w = cvt_pk_bf16(v[6], v[7]);
            *(u32x4*)((char*)Vg + (size_t)c * 64 * 3072 + (zoff + mb * 49152u)) = st;
        }
        {
            bf16x8 vw[2][2];
#pragma unroll
            for (int ks = 0; ks < 2; ++ks) { const f32x4 w0 = *(const LAS f32x4*)(cW + 32 * ks + 8 * g), w1 = *(const LAS f32x4*)(cW + 32 * ks + 8 * g + 4);
#pragma unroll
                for (int vt = 0; vt < 2; ++vt) { const u32x4 t = __builtin_bit_cast(u32x4, vf[vt][ks]); u32x4 o;
                    o.x = cvt_pk_bf16(bflo(t.x) * w0[0], bfhi(t.x) * w0[1]); o.y = cvt_pk_bf16(bflo(t.y) * w0[2], bfhi(t.y) * w0[3]);
                    o.z = cvt_pk_bf16(bflo(t.z) * w1[0], bfhi(t.z) * w1[1]); o.w = cvt_pk_bf16(bflo(t.w) * w1[2], bfhi(t.w) * w1[3]); vw[vt][ks] = __builtin_bit_cast(bf16x8, o); } }
#pragma unroll
            for (int dp = 0; dp < 4; ++dp) {
                s16x4 t8[8]; const unsigned kb0 = ktb + (32 * dp) * 2, kb1 = kb0 + 32;
                tr_read8(t8, kb0, kb0 + 4 * SQ_P, kb0 + 32 * SQ_P, kb0 + 36 * SQ_P, kb1, kb1 + 4 * SQ_P, kb1 + 32 * SQ_P, kb1 + 36 * SQ_P);
#pragma unroll
                for (int dd = 0; dd < 2; ++dd) { const int db = 2 * dp + dd;
                    Cacc[db][0] = Cacc[db][0] * decay; Cacc[db][1] = Cacc[db][1] * decay;
#pragma unroll
                    for (int ks = 0; ks < 2; ++ks) {
                        const bf16x8 kf = __builtin_shufflevector(t8[4 * dd + 2 * ks], t8[4 * dd + 2 * ks + 1], 0, 1, 2, 3, 4, 5, 6, 7);
                        Cacc[db][0] = MFMA16(kf, vw[0][ks], Cacc[db][0]); Cacc[db][1] = MFMA16(kf, vw[1][ks], Cacc[db][1]);
                    } }
            }
        }
        __builtin_amdgcn_sched_barrier(0);
        float vpre = 0.f;
        if (c + 1 < 64) { SC_LOAD(c + 1); if (tid < 320) vpre = vptr[(c + 1) * cstr]; }
        __builtin_amdgcn_sched_barrier(0);
        if (is_ml) {
            const int d = tid >> 2, part = tid & 3; float s = 0.f;
#pragma unroll
            for (int j = 0; j < 16; ++j) { const int sidx = 16 * part + j; s += cW[sidx] * bf2f(*(const LAS bf16_t*)(Ks + sidx * SQ_P + d * 2)); }
            s += __shfl_xor(s, 1); s += __shfl_xor(s, 2);
            if (part == 0) { LAS float* np = (LAS float*)(lds + SC_NV) + d; *np = decay * (*np) + s; }
        }
        if (c + 1 < 64) { SC_STORE(cur ^ 1); if (tid < 320) ((LAS float*)(lds + SC_VEC + (cur ^ 1) * 1280))[tid] = vpre; }
        LBAR();
    }
#undef SC_LOAD
#undef SC_STORE
}


DI void p3b_gate(const Params& P) {
    const int tid = opaque_tid(), lane = tid & 63, sub = lane >> 4, li = lane & 15, G = gridDim.x, bx = blockIdx.x;
    unsigned char* ws = P.ws;
    const int nw = T * 6 * 2 / 4;
    for (int wv = bx * 8 + (tid >> 6); wv < nw; wv += G * 8) {
        int pair = wv * 4 + sub; const int br = pair >= T * 6; pair -= br * T * 6; const int t = pair / 6, h = pair - t * 6;
        const size_t off = (size_t)t * 1536 + h * 256 + li * 16;
        const bf16_t* hp = (const bf16_t*)(ws + (br ? WS_V2 : WS_V1)) + off; bf16_t* zp = (bf16_t*)(ws + (br ? WS_Z2 : WS_Z1)) + off; const bf16_t* op = (const bf16_t*)(ws + WS_O1) + off;
        const float* gp = (br ? P.ret_g : P.ml_g) + h * 256 + li * 16;
        const u32x4 h0 = *(const u32x4*)hp, h1 = *(const u32x4*)(hp + 8), z0 = *(const u32x4*)zp, z1 = *(const u32x4*)(zp + 8);
        u32x4 o0 = (u32x4){0u, 0u, 0u, 0u}, o1 = o0; if (!br) { o0 = *(const u32x4*)op; o1 = *(const u32x4*)(op + 8); }
        const unsigned hh[8] = {h0.x, h0.y, h0.z, h0.w, h1.x, h1.y, h1.z, h1.w}, zz[8] = {z0.x, z0.y, z0.z, z0.w, z1.x, z1.y, z1.z, z1.w}, oo[8] = {o0.x, o0.y, o0.z, o0.w, o1.x, o1.y, o1.z, o1.w};
        float hv[16], s1 = 0.f, s2 = 0.f;
#pragma unroll
        for (int e = 0; e < 16; ++e) { hv[e] = (e & 1) ? bfhi(hh[e >> 1]) : bflo(hh[e >> 1]); s1 += hv[e]; s2 += hv[e] * hv[e]; }
#pragma unroll
        for (int o = 1; o < 16; o <<= 1) { s1 += __shfl_xor(s1, o); s2 += __shfl_xor(s2, o); }
        const float mean = s1 * (1.0f / 256.0f), var = fmaxf(s2 * (1.0f / 256.0f) - mean * mean, 0.f), rstd = rsqrtf(var + EPS);
        float y[16];
#pragma unroll
        for (int q = 0; q < 4; ++q) { const f32x4 gg = *(const f32x4*)(gp + 4 * q);
#pragma unroll
            for (int j = 0; j < 4; ++j) { const int e = 4 * q + j; const float z = (e & 1) ? bfhi(zz[e >> 1]) : bflo(zz[e >> 1]); float v = (hv[e] - mean) * rstd * gg[j] * siluf_(z);
                if (!br) { const float o = (e & 1) ? bfhi(oo[e >> 1]) : bflo(oo[e >> 1]); v *= sigmoidf_(o); } y[e] = v; } }
        u32x4 a, c2; a.x = cvt_pk_bf16(y[0], y[1]); a.y = cvt_pk_bf16(y[2], y[3]); a.z = cvt_pk_bf16(y[4], y[5]); a.w = cvt_pk_bf16(y[6], y[7]);
        c2.x = cvt_pk_bf16(y[8], y[9]); c2.y = cvt_pk_bf16(y[10], y[11]); c2.z = cvt_pk_bf16(y[12], y[13]); c2.w = cvt_pk_bf16(y[14], y[15]);
        *(u32x4*)zp = a; *(u32x4*)(zp + 8) = c2;
    }
}

constexpr int AK_P = 528;
constexpr int AV_P = 544;
static_assert(256 * AV_P <= LDS_BYTES - 16, "attn LDS");
DI void attn_unit(const Params& P, LAS unsigned char* lds, int unit) {
    const int tid = opaque_tid(), lane = tid & 63, w = __builtin_amdgcn_readfirstlane(tid >> 6), r = lane & 15, g = lane >> 4, q4 = r >> 2, p4 = r & 3;
    unsigned char* ws = P.ws;
    const int b = unit >> 6, hh = (unit >> 4) & 3, qb = unit & 15;
    const size_t trow = (size_t)b * SEQ + qb * 256 + 32 * w + r;
    const bf16_t* Qp = (const bf16_t*)(ws + WS_Q3) + trow * 1024 + hh * 256;
    bf16_t* Zp = (bf16_t*)(ws + WS_Z3) + trow * 1024 + hh * 256;
    const bf16_t* Kp = (const bf16_t*)(ws + WS_MKV) + (size_t)b * 256 * 2048 + hh * 256;
    const bf16_t* Vp = Kp + 1024;
    const unsigned ldsb = (unsigned)(size_t)lds;
#pragma unroll
    for (int i = 0; i < 16; ++i) { const int pp = tid + 512 * i, row = pp >> 5, ch = pp & 31; *(LAS u32x4*)(lds + row * AK_P + ch * 16) = *(const u32x4*)(Kp + (size_t)row * 2048 + ch * 8); }
    __syncthreads();
    bf16x8 pf[2][8]; float rs[2];
#pragma unroll
    for (int mb = 0; mb < 2; ++mb) {
        bf16x8 qf[8];
#pragma unroll
        for (int ks = 0; ks < 8; ++ks) qf[ks] = *(const bf16x8*)(Qp + (size_t)mb * 16 * 1024 + 32 * ks + 8 * g);
        f32x4 s[16];
#pragma unroll
        for (int nb = 0; nb < 16; ++nb) { s[nb] = (f32x4){0.f, 0.f, 0.f, 0.f};
#pragma unroll
            for (int ks = 0; ks < 8; ++ks) { const bf16x8 kf = *(const LAS bf16x8*)(lds + (16 * nb + r) * AK_P + (32 * ks + 8 * g) * 2); s[nb] = MFMA16(kf, qf[ks], s[nb]); } __builtin_amdgcn_sched_barrier(0); }
        float mx = -3.0e38f;
#pragma unroll
        for (int nb = 0; nb < 16; ++nb) mx = fmaxf(mx, fmaxf(fmaxf(s[nb][0], s[nb][1]), fmaxf(s[nb][2], s[nb][3])));
        mx = fmaxf(mx, __shfl_xor(mx, 16)); mx = fmaxf(mx, __shfl_xor(mx, 32));
        const float sc = 0.0625f * 1.4426950408889634f; float sum = 0.f;
#pragma unroll
        for (int nb = 0; nb < 16; ++nb)
#pragma unroll
            for (int j = 0; j < 4; ++j) { const float e = __builtin_amdgcn_exp2f((s[nb][j] - mx) * sc); s[nb][j] = e; sum += e; }
        sum += __shfl_xor(sum, 16); sum += __shfl_xor(sum, 32);
        rs[mb] = 1.0f / sum;
#pragma unroll
        for (int kk = 0; kk < 8; ++kk) { u32x4 t; t.x = cvt_pk_bf16(s[2 * kk][0], s[2 * kk][1]); t.y = cvt_pk_bf16(s[2 * kk][2], s[2 * kk][3]); t.z = cvt_pk_bf16(s[2 * kk + 1][0], s[2 * kk + 1][1]); t.w = cvt_pk_bf16(s[2 * kk + 1][2], s[2 * kk + 1][3]); pf[mb][kk] = __builtin_bit_cast(bf16x8, t); }
        __builtin_amdgcn_sched_barrier(0);
    }
    __syncthreads();
#pragma unroll
    for (int i = 0; i < 16; ++i) { const int pp = tid + 512 * i, row = pp >> 5, ch = pp & 31; *(LAS u32x4*)(lds + row * AV_P + ch * 16) = *(const u32x4*)(Vp + (size_t)row * 2048 + ch * 8); }
    __syncthreads();
#pragma unroll
    for (int VG = 0; VG < 4; ++VG) {
        unsigned vb = ldsb + (4 * g + q4) * AV_P + (4 * p4) * 2; asm volatile("" : "+v"(vb));
        bf16_t* zp = Zp + 64 * VG + 4 * g;
        u32x2 zl[2][4];
#pragma unroll
        for (int mb = 0; mb < 2; ++mb)
#pragma unroll
            for (int vq = 0; vq < 4; ++vq) zl[mb][vq] = *(const u32x2*)(zp + (size_t)mb * 16 * 1024 + 16 * vq);
        f32x4 o[2][4];
#pragma unroll
        for (int vq = 0; vq < 4; ++vq) { o[0][vq] = (f32x4){0.f, 0.f, 0.f, 0.f}; o[1][vq] = (f32x4){0.f, 0.f, 0.f, 0.f};
#pragma unroll
            for (int kh = 0; kh < 2; ++kh) {
                s16x4 t8[8]; const unsigned a0 = vb + (128 * kh) * AV_P + (64 * VG + 16 * vq) * 2;
                tr_read8(t8, a0, a0 + 16 * AV_P, a0 + 32 * AV_P, a0 + 48 * AV_P, a0 + 64 * AV_P, a0 + 80 * AV_P, a0 + 96 * AV_P, a0 + 112 * AV_P);
#pragma unroll
                for (int k2 = 0; k2 < 4; ++k2) { const bf16x8 vfr = __builtin_shufflevector(t8[2 * k2], t8[2 * k2 + 1], 0, 1, 2, 3, 4, 5, 6, 7);
                    o[0][vq] = MFMA16(vfr, pf[0][4 * kh + k2], o[0][vq]); o[1][vq] = MFMA16(vfr, pf[1][4 * kh + k2], o[1][vq]); }
            } }
#pragma unroll
        for (int mb = 0; mb < 2; ++mb)
#pragma unroll
            for (int vq = 0; vq < 4; ++vq) {
                const u32x2 zz = zl[mb][vq]; const f32x4 ov = o[mb][vq];
                const float y0 = ov[0] * rs[mb] * siluf_(bflo(zz.x)), y1 = ov[1] * rs[mb] * siluf_(bfhi(zz.x)), y2 = ov[2] * rs[mb] * siluf_(bflo(zz.y)), y3 = ov[3] * rs[mb] * siluf_(bfhi(zz.y));
                unsigned st = 0u; st = __builtin_amdgcn_cvt_pk_fp8_f32(y0 * 16.f, y1 * 16.f, st, false); st = __builtin_amdgcn_cvt_pk_fp8_f32(y2 * 16.f, y3 * 16.f, st, true);
                *(unsigned*)((unsigned char*)P.out + DO_XA8 + (trow + 16 * mb) * 1024 + hh * 256 + 64 * VG + 4 * g + 16 * vq) = st;
            }
    }
    __syncthreads();
}

#define XB_TMO      128
#define XB_XCNT(j)  (256  + 64 * (j))
#define XB_XSUB(j)  (1280 + 64 * (j))
#define XB_XGEN(j)  (2304 + 64 * (j))
#define XB_TOP      3328
#define XB_TOPGEN   3392
#define XCD_BAR_WORDS 3456
#define XB_SPIN_CAP (1u << 18)
DI unsigned xb_ld(unsigned* p)              { return __hip_atomic_load(p, __ATOMIC_RELAXED, __HIP_MEMORY_SCOPE_AGENT); }
DI unsigned xb_add(unsigned* p, unsigned v) { return __hip_atomic_fetch_add(p, v, __ATOMIC_RELAXED, __HIP_MEMORY_SCOPE_AGENT); }
DI unsigned xb_xcc_id() { return (unsigned)__builtin_amdgcn_s_getreg((3 << 11) | 20) & 0xFu; }
#define XB_SPIN(cond, bar) do { unsigned _sp = 0; while (cond) { __builtin_amdgcn_s_sleep(1); \
    if ((++_sp & 255u) == 0u) { if (xb_ld(&(bar)[XB_TMO])) break; if (_sp > XB_SPIN_CAP) { atomicAdd(&(bar)[XB_TMO], 1u); break; } } } } while (0)
struct XcdBarrier { unsigned* bar; unsigned x; volatile LAS unsigned* st; };
DI XcdBarrier xcd_barrier_post(unsigned* bar, volatile LAS unsigned* st) {
    XcdBarrier b; b.bar = bar; b.x = xb_xcc_id(); b.st = st;
    if (threadIdx.x == 0) (void)xb_add(&bar[XB_XCNT(b.x)], 1u);
    return b;
}
DI void xcd_barrier_complete(unsigned* bar, unsigned x, unsigned& nloc, unsigned& nx) {
    const unsigned G = gridDim.x * gridDim.y * gridDim.z;
    unsigned sum, cnt, mine, sp = 0u;
    for (;;) {
        sum = 0u; cnt = 0u; mine = 0u;
#pragma unroll
        for (unsigned j = 0; j < 16; ++j) { const unsigned c = xb_ld(&bar[XB_XCNT(j)]); sum += c; cnt += (c > 0u) ? 1u : 0u; mine = (j == x) ? c : mine; }
        if (sum == G) break;
        __builtin_amdgcn_s_sleep(1);
        if ((++sp & 255u) == 0u) { if (xb_ld(&bar[XB_TMO])) break; if (sp > XB_SPIN_CAP) { atomicAdd(&bar[XB_TMO], 1u); break; } }
    }
    nloc = mine > 0u ? mine : 1u; nx = cnt > 0u ? cnt : 1u;
}
DI void xcd_barrier(const XcdBarrier& b) {
    asm volatile("s_waitcnt vmcnt(0)" ::: "memory");
    __syncthreads();
    if (threadIdx.x == 0) {
        unsigned* bar = b.bar;
        __builtin_amdgcn_s_waitcnt(0);
        unsigned nloc = b.st[0], nx = b.st[1];
        if (nloc == 0u) { xcd_barrier_complete(bar, b.x, nloc, nx); b.st[0] = nloc; b.st[1] = nx; }
        const unsigned old = xb_add(&bar[XB_XSUB(b.x)], 1u);
        const unsigned gen = old / nloc;
        if (old + 1u == (gen + 1u) * nloc) {
            __builtin_amdgcn_fence(__ATOMIC_RELEASE, "agent");
            asm volatile("s_waitcnt vmcnt(0)" ::: "memory");
            const unsigned og = xb_add(&bar[XB_TOP], 1u);
            const unsigned tg = og / nx;
            if (og + 1u == (tg + 1u) * nx) xb_add(&bar[XB_TOPGEN], 1u);
            else XB_SPIN(xb_ld(&bar[XB_TOPGEN]) == tg, bar);
            __builtin_amdgcn_fence(__ATOMIC_ACQUIRE, "agent");
            xb_add(&bar[XB_XGEN(b.x)], 1u);
            asm volatile("s_waitcnt vmcnt(0)" ::: "memory");
        } else {
            XB_SPIN(xb_ld(&bar[XB_XGEN(b.x)]) == gen, bar);
            __builtin_amdgcn_fence(__ATOMIC_ACQUIRE, "agent");
            asm volatile("s_waitcnt vmcnt(0)" ::: "memory");
        }
    }
    __syncthreads();
}

__global__ void __launch_bounds__(512) fwd_megakernel(Params P) {
    extern __shared__ __attribute__((aligned(16))) unsigned char smem[];
    LAS unsigned char* lds = (LAS unsigned char*)smem;
    cg::grid_group grid = cg::this_grid();
    unsigned char* ws = P.ws;
    const int G = gridDim.x, bx = blockIdx.x, tid = threadIdx.x;
    bf16_t* H = (bf16_t*)((unsigned char*)P.out + DO_H);

    if (tid < 4) ((LAS unsigned*)(lds + LDS_BYTES - 32))[tid] = 0u;
    __syncthreads();
#ifndef NO_P0
    p0_prologue(P, lds);
#endif
    grid.sync();
    const XcdBarrier xb = xcd_barrier_post((unsigned*)(ws + WS_BAR), (volatile LAS unsigned*)(lds + LDS_BYTES - 32));
    {
        { pg8::Gemm g{H, (const bf16_t*)(ws + WS_WIN), 2048}; pg8::Order S; S.init(128, NT_P1 - 32, G, bx, 0, 64, 128, PN_KV); S.skip0_lo = 6; S.skip0_n = 6; S.skip_lo = 24; S.skip_n = 26;
          pg8::EpiProj E{ws, (const float*)(ws + WS_BIAS), 1 << 20, 0, 0.f};
          pg8::gemm_phase(lds, g, S, E); }
        { pg8::Gemm g{(const bf16_t*)(ws + WS_H8), (const bf16_t*)((unsigned char*)P.out + DO_WO8 - (size_t)24 * 256 * 2048), 1024}; pg8::Order S; S.init(128, 20, G, bx, 24);
          pg8::EpiProj E{ws, (const float*)(ws + WS_BIAS), 40, 6, Q8_DEQ};
          pg8::gemm_phase<2>(lds, g, S, E); }
        { pg8::Gemm g{(const bf16_t*)(ws + WS_H8), (const bf16_t*)(ws + WS_WV8 - (size_t)6 * 256 * 2048), 1024}; pg8::Order S; S.init(128, 6, G, bx, 6);
          pg8::EpiProj E{ws, (const float*)(ws + WS_BIAS), 1 << 20, 0, Q8_DEQ};
          pg8::gemm_phase<2>(lds, g, S, E); }
        { pg8::Gemm g{(const bf16_t*)(ws + WS_H8), (const bf16_t*)(ws + WS_WZ8 - (size_t)40 * 256 * 2048), 1024}; pg8::Order S; S.init(128, 6, G, bx, 40);
          pg8::EpiProj E{ws, (const float*)(ws + WS_BIAS), 1 << 20, 0, Q8_DEQ};
          pg8::gemm_phase<2>(lds, g, S, E); }
    }
    xcd_barrier(xb);
#ifndef NO_P2
    p2_prep(P, lds);
#endif
    xcd_barrier(xb);
    {
#ifndef NO_SCAN
        for (int it = bx; it < 96; it += G) scan_item(P, lds, it);
#endif
        if (bx >= 96 && G > 96) {
            pg8::Gemm g{(const bf16_t*)(ws + WS_H8), (const bf16_t*)((unsigned char*)P.out + DO_WG8), 1024}; pg8::Order S; S.init(128, 8, G - 96, bx - 96, 0);
            pg8::EpiGate E{ws, (const float*)(ws + WS_BIAS), Q8_DEQ};
            pg8::gemm_phase<2>(lds, g, S, E);
        }
        LAS unsigned* slot = (LAS unsigned*)(lds + LDS_BYTES - 16);
        for (;;) {
            if (tid == 0) *slot = atomicAdd((unsigned*)(ws + WS_CTL), 1u);
            __syncthreads();
            const unsigned u = *slot;
            __syncthreads();
            if (u >= 512u) break;
#ifndef NO_ATTN
            attn_unit(P, lds, (int)u);
#endif
        }
    }
    xcd_barrier(xb);
#ifndef NO_P2
    p3b_gate(P);
#endif
    xcd_barrier(xb);
    {
        pg8::Gemm g{(const bf16_t*)(ws + WS_H8), (const bf16_t*)((unsigned char*)P.out + DO_WG8), 1024}; pg8::Order S; S.init(128, 16, G, bx, 8);
        pg8::EpiGate E{ws, (const float*)(ws + WS_BIAS), Q8_DEQ};
        pg8::gemm_phase<2>(lds, g, S, E);
    }
    xcd_barrier(xb);
    {
        pg8::Order S; S.init(128, 8, G, bx, 0);
        { pg8::Gemm g{(const bf16_t*)(ws + WS_Z1), (const bf16_t*)(ws + WS_WML), 1536}; pg8::EpiMerge E{(bf16_t*)(ws + WS_MERGED), (const bf16_t*)(ws + WS_G0), 0}; pg8::gemm_phase(lds, g, S, E); }
        { pg8::Gemm g{(const bf16_t*)(ws + WS_Z2), (const bf16_t*)(ws + WS_WRET), 1536}; pg8::EpiMerge E{(bf16_t*)(ws + WS_MERGED), (const bf16_t*)(ws + WS_G12), 1}; pg8::gemm_phase(lds, g, S, E); }
        { pg8::Gemm g{(const bf16_t*)((unsigned char*)P.out + DO_XA8), (const bf16_t*)((unsigned char*)P.out + DO_WX8), 512, 0, 0x7B7B7B7B}; pg8::EpiMerge E{(bf16_t*)(ws + WS_MERGED), (const bf16_t*)(ws + WS_G12 + SZ20), 2}; pg8::gemm_phase<1>(lds, g, S, E); }
    }
    xcd_barrier(xb);
    {
        pg8::Gemm g{(const bf16_t*)(ws + WS_MERGED), (const bf16_t*)(ws + WS_WOUT), 2048}; pg8::Order S; S.init(128, 8, G, bx, 0);
        pg8::EpiOut E{(bf16_t*)(ws + WS_G0)};
        pg8::gemm_phase(lds, g, S, E);
    }
    xcd_barrier(xb);
    {
        const bf16_t* D = (const bf16_t*)(ws + WS_G0); const int lane = tid & 63, wave = tid >> 6;
        f32x4 gg[8];
#pragma unroll
        for (int i = 0; i < 8; ++i) gg[i] = *(const f32x4*)(P.fin_g + 4 * (lane + 64 * i));
        for (int row = bx * 16 + wave * 2; row < T; row += G * 16) {
            const float* x0 = P.x + (size_t)row * 2048; const float* x1 = x0 + 2048; const bf16_t* d0 = D + (size_t)row * 2048; const bf16_t* d1 = d0 + 2048;
            float* o0 = P.out + (size_t)row * 2048; float* o1 = o0 + 2048;
            f32x4 a[8], b[8]; u32x2 da[8], db[8];
#pragma unroll
            for (int i = 0; i < 8; ++i) { a[i] = *(const f32x4*)(x0 + 4 * (lane + 64 * i)); b[i] = *(const f32x4*)(x1 + 4 * (lane + 64 * i)); da[i] = *(const u32x2*)(d0 + 4 * (lane + 64 * i)); db[i] = *(const u32x2*)(d1 + 4 * (lane + 64 * i)); }
            float s0 = 0.f, s1 = 0.f;
#pragma unroll
            for (int i = 0; i < 8; ++i) {
                a[i] += (f32x4){bflo(da[i].x), bfhi(da[i].x), bflo(da[i].y), bfhi(da[i].y)}; b[i] += (f32x4){bflo(db[i].x), bfhi(db[i].x), bflo(db[i].y), bfhi(db[i].y)};
                s0 += a[i][0] * a[i][0] + a[i][1] * a[i][1] + a[i][2] * a[i][2] + a[i][3] * a[i][3]; s1 += b[i][0] * b[i][0] + b[i][1] * b[i][1] + b[i][2] * b[i][2] + b[i][3] * b[i][3]; }
            s0 = wave_sum(s0); s1 = wave_sum(s1);
            const float c0 = rsqrtf(s0 * (1.0f / 2048.0f) + EPS), c1 = rsqrtf(s1 * (1.0f / 2048.0f) + EPS);
#pragma unroll
            for (int i = 0; i < 8; ++i) { *(f32x4*)(o0 + 4 * (lane + 64 * i)) = a[i] * c0 * gg[i]; *(f32x4*)(o1 + 4 * (lane + 64 * i)) = b[i] * c1 * gg[i]; }
        }
    }
}

extern "C" void kernel_launch(void* const* d_in, const int* in_sizes, int n_in, void* d_out, int out_size, void* d_ws, size_t ws_size, hipStream_t stream) {
    static int grid = 0;
    if (grid == 0) {
        if (n_in != 17 || out_size != T * DM || ws_size < WS_END) { fprintf(stderr, "kernel_launch: unexpected shapes / workspace (%d inputs, out %d, ws %zu, need %zu)\n", n_in, out_size, ws_size, (size_t)WS_END); grid = -1; return; }
        int dev = 0, cus = 0, per_cu = 0;
        hipGetDevice(&dev); hipDeviceGetAttribute(&cus, hipDeviceAttributeMultiprocessorCount, dev);
        if (hipFuncSetAttribute((const void*)fwd_megakernel, hipFuncAttributeMaxDynamicSharedMemorySize, LDS_BYTES) != hipSuccess) { fprintf(stderr, "kernel_launch: hipFuncSetAttribute failed\n"); grid = -1; return; }
        if (hipOccupancyMaxActiveBlocksPerMultiprocessor(&per_cu, (const void*)fwd_megakernel, 512, LDS_BYTES) != hipSuccess || per_cu < 1) { fprintf(stderr, "kernel_launch: occupancy query gave %d\n", per_cu); per_cu = 1; }
        (void)hipGetLastError();
        grid = cus * 1;
    }
    if (grid < 0) return;
    Params p{};
    p.x = (const float*)d_in[0]; p.mem = (const float*)d_in[1]; p.pos = (const int*)d_in[2]; p.ln_g = (const float*)d_in[3]; p.mem_ln_g = (const float*)d_in[4];
    p.w_in = (const float*)d_in[5]; p.b_in = (const float*)d_in[6]; p.conv_w = (const float*)d_in[7]; p.conv_b = (const float*)d_in[8]; p.ml_g = (const float*)d_in[9];
    p.ret_g = (const float*)d_in[10]; p.w_kv = (const float*)d_in[11]; p.w_ml = (const float*)d_in[12]; p.w_ret = (const float*)d_in[13]; p.w_xa = (const float*)d_in[14];
    p.w_out = (const float*)d_in[15]; p.fin_g = (const float*)d_in[16]; p.out = (float*)d_out; p.ws = (unsigned char*)d_ws;
    void* args[] = {&p};
    hipError_t e = hipLaunchCooperativeKernel((const void*)fwd_megakernel, dim3(grid), dim3(512), args, LDS_BYTES, stream);
    if (e != hipSuccess) fprintf(stderr, "cooperative launch failed: %s (grid %d)\n", hipGetErrorString(e), grid);
}
```

```cpp
#include <hip/hip_runtime.h>
#include <hip/hip_cooperative_groups.h>
#include <cstdint>
#include <cstdio>
namespace cg = cooperative_groups;

#define LAS __attribute__((address_space(3)))
typedef unsigned short bf16_t;
typedef short bf16x8 __attribute__((ext_vector_type(8)));
typedef short s16x4 __attribute__((ext_vector_type(4)));
typedef float f32x4 __attribute__((ext_vector_type(4)));
typedef float f32x2 __attribute__((ext_vector_type(2)));
typedef unsigned u32x4 __attribute__((ext_vector_type(4)));
typedef unsigned u32x2 __attribute__((ext_vector_type(2)));
typedef int i32x4 __attribute__((ext_vector_type(4)));
typedef int i32x8 __attribute__((ext_vector_type(8)));
#define DI __device__ __forceinline__

constexpr int T = 32768, DM = 2048, SEQ = 4096, NB = 8;
constexpr int N_IN = 18956, NPAD = 19200;
constexpr int NT_P1 = 51;
constexpr int PN_GATE = 51;
constexpr int PN_KV = 75;
constexpr float EPS = 1e-6f;
constexpr int LDS_BYTES = 156 * 1024;

constexpr size_t WS_CTL = 0;
constexpr size_t WS_BAR = 4096;
constexpr size_t WS_SS = WS_BAR + 16384;
constexpr size_t WS_BIAS = WS_SS + (size_t)T * 4;
constexpr size_t WS_IF = WS_BIAS + 81920;
constexpr size_t WS_GS = WS_IF + (size_t)T * 16 * 4;
constexpr size_t GS_ARR = (size_t)48 * 4096;
constexpr size_t WS_GDEC = WS_GS + 5 * GS_ARR * 4;
constexpr size_t WS_RV = WS_GDEC + 48 * 64 * 4;
constexpr size_t WS_WIN = WS_RV + 16384;
constexpr size_t WS_WKV = WS_WIN + (size_t)NPAD * DM * 2;
constexpr size_t WS_WML = WS_WKV + (size_t)2048 * 2048 * 2;
constexpr size_t WS_WRET = WS_WML + (size_t)2048 * 1536 * 2;
constexpr size_t WS_WXA = WS_WRET + (size_t)2048 * 1536 * 2;
constexpr size_t WS_WOUT = WS_WXA + (size_t)2048 * 1024 * 2;
constexpr size_t WS_MKV = WS_WOUT + (size_t)2048 * 2048 * 2;
constexpr size_t WS_BIG = WS_MKV + (size_t)2048 * 2048 * 2;
constexpr size_t SZ15 = (size_t)T * 1536 * 2, SZ10 = (size_t)T * 1024 * 2;
constexpr size_t SZ20 = (size_t)T * 2048 * 2;
constexpr size_t WS_V1 = WS_BIG, WS_QK2 = WS_V1 + SZ15, WS_V2 = WS_QK2 + SZ15;
constexpr size_t WS_O1 = WS_V2 + SZ15, WS_Q3 = WS_O1 + SZ15;
constexpr size_t WS_Z1 = WS_Q3 + SZ10, WS_Z2 = WS_Z1 + SZ15, WS_Z3 = WS_Z2 + SZ15;
constexpr size_t WS_QK1 = WS_Z3 + SZ10;
constexpr size_t WS_H8 = WS_QK1 + SZ20;
constexpr size_t WS_WV8 = WS_H8 + (size_t)T * DM;
constexpr size_t WS_WZ8 = WS_WV8 + (size_t)1536 * 2048;
constexpr size_t WS_END = WS_WZ8 + (size_t)1536 * 2048;
constexpr size_t WS_G0 = WS_QK1, WS_G12 = WS_V1, WS_MERGED = WS_O1;
static_assert(2 * SZ20 <= 3 * SZ15 && SZ20 <= SZ15 + SZ10, "overlays");
constexpr size_t DO_H = 0, DO_MN = (size_t)T * DM * 2, DO_QKC = DO_MN + (size_t)2048 * 2048 * 2;
constexpr size_t DO_WG8 = DO_QKC + (size_t)T * 1536 * 2;
constexpr size_t DO_WO8 = DO_WG8 + (size_t)6144 * 2048;
constexpr size_t DO_WX8 = DO_WO8 + (size_t)5120 * 2048;
static_assert(DO_WX8 + (size_t)2048 * 1024 <= (size_t)T * DM * 4, "d_out scratch");
constexpr size_t DO_XA8 = DO_H;

struct Params {
    const float* x; const float* mem; const int* pos; const float* ln_g; const float* mem_ln_g; const float* w_in; const float* b_in;
    const float* conv_w; const float* conv_b; const float* ml_g; const float* ret_g; const float* w_kv; const float* w_ml; const float* w_ret;
    const float* w_xa; const float* w_out; const float* fin_g; float* out; unsigned char* ws;
};

typedef __bf16 bf16v2_t __attribute__((ext_vector_type(2)));
DI unsigned cvt_pk_bf16(float lo, float hi) { const f32x2 v = {lo, hi}; const bf16v2_t r = __builtin_convertvector(v, bf16v2_t); return __builtin_bit_cast(unsigned, r); }
DI float bf2f(unsigned short b) { return __uint_as_float((unsigned)b << 16); }
DI float bflo(unsigned u) { return __uint_as_float(u << 16); }
DI float bfhi(unsigned u) { return __uint_as_float(u & 0xffff0000u); }
DI float sigmoidf_(float v) { return __builtin_amdgcn_rcpf(1.0f + __builtin_amdgcn_exp2f(-1.4426950408889634f * v)); }
DI float siluf_(float v) { return v * __builtin_amdgcn_rcpf(1.0f + __builtin_amdgcn_exp2f(-1.4426950408889634f * v)); }
#define LBAR() do { asm volatile("s_waitcnt lgkmcnt(0)" ::: "memory"); __builtin_amdgcn_s_barrier(); asm volatile("" ::: "memory"); } while (0)
DI float wave_sum(float v) { for (int o = 32; o > 0; o >>= 1) v += __shfl_xor(v, o); return v; }
DI s16x4 tr_read(unsigned lds_addr) { s16x4 r; asm volatile("ds_read_b64_tr_b16 %0, %1\n\ts_waitcnt lgkmcnt(0)" : "=&v"(r) : "v"(lds_addr) : "memory"); return r; }
DI void tr_read8(s16x4 (&o)[8], unsigned a0, unsigned a1, unsigned a2, unsigned a3, unsigned a4, unsigned a5, unsigned a6, unsigned a7) {
    asm volatile("ds_read_b64_tr_b16 %0, %8\n\tds_read_b64_tr_b16 %1, %9\n\tds_read_b64_tr_b16 %2, %10\n\tds_read_b64_tr_b16 %3, %11\n\tds_read_b64_tr_b16 %4, %12\n\tds_read_b64_tr_b16 %5, %13\n\tds_read_b64_tr_b16 %6, %14\n\tds_read_b64_tr_b16 %7, %15\n\ts_waitcnt lgkmcnt(0)"
                 : "=&v"(o[0]), "=&v"(o[1]), "=&v"(o[2]), "=&v"(o[3]), "=&v"(o[4]), "=&v"(o[5]), "=&v"(o[6]), "=&v"(o[7])
                 : "v"(a0), "v"(a1), "v"(a2), "v"(a3), "v"(a4), "v"(a5), "v"(a6), "v"(a7) : "memory");
}
DI unsigned pack_i8x4(float a, float b, float c, float d, float s) {
    const int i0 = (int)rintf(fminf(fmaxf(a * s, -127.f), 127.f)), i1 = (int)rintf(fminf(fmaxf(b * s, -127.f), 127.f)), i2 = (int)rintf(fminf(fmaxf(c * s, -127.f), 127.f)), i3 = (int)rintf(fminf(fmaxf(d * s, -127.f), 127.f));
    return (unsigned)(i0 & 255) | ((unsigned)(i1 & 255) << 8) | ((unsigned)(i2 & 255) << 16) | ((unsigned)i3 << 24);
}
DI f32x4 deq_acc(f32x4 a, float qs) {
    if (qs == 0.f) return a;
    f32x4 r; r[0] = (float)__float_as_int(a[0]) * qs; r[1] = (float)__float_as_int(a[1]) * qs; r[2] = (float)__float_as_int(a[2]) * qs; r[3] = (float)__float_as_int(a[3]) * qs; return r;
}
constexpr float H8_SCALE = 32.f, W8_SCALE = 1536.f, Q8_DEQ = 1.0f / (32.f * 1536.f);
DI int opaque_tid() { int t = threadIdx.x; asm volatile("" : "+v"(t)); return t; }
#define MFMA16(a, b, c) __builtin_amdgcn_mfma_f32_16x16x32_bf16((a), (b), (c), 0, 0, 0)

namespace pg8 {
constexpr int BM = 256, BK = 64, HALF = 128, HTB = HALF * BK * 2, STAGE_BYTES = 8 * HTB, NXCD = 8, WGM = 8;
DI int lds_byte(int r, int c) { const int st = (r >> 4) * 2 + (c >> 5), rr = r & 15, cc = c & 31, ob = rr * 64 + cc * 2; return st * 1024 + (ob ^ (((ob >> 9) & 1) << 5)); }
DI void stage_rc(int b, int& R, int& C) { const int st = b / 1024, sb = b % 1024, swz = sb ^ (((sb >> 9) & 1) << 5); R = (st >> 1) * 16 + swz / 64; C = (st & 1) * 32 + (swz % 64) / 2; }
DI int perm32(int rho) { const int n = rho >> 4, i = rho & 15; return 8 * (i >> 2) + 4 * n + (i & 3); }
struct Unit { int pm, pn; };
struct Gemm { const bf16_t* A; const bf16_t* Bt; int K; int ntile = 0; int sca = 0x7F7F7F7F; };
struct Order {
    int nM, nN, nwg, G, c, pn_off, extra, pm0x, pn0x, skip0_lo, skip0_n, skip_lo, skip_n, skip2_lo, skip2_n;
    DI void init(int nM_, int nN_, int G_, int c_, int pn_off_, int extra_ = 0, int pm0x_ = 0, int pn0x_ = 0) { nM = nM_; nN = nN_; nwg = nM * nN; G = G_; c = c_; pn_off = pn_off_; extra = extra_; pm0x = pm0x_; pn0x = pn0x_; skip0_lo = 0; skip0_n = 0; skip_lo = 0; skip_n = 0; skip2_lo = 0; skip2_n = 0; }
    DI bool next(int i, Unit& u) const {
        long L = (long)i * G + c;
        if (L < nwg) {
            int wgid = (int)L; { const int q = nwg / NXCD, r = nwg % NXCD, xcd = wgid % NXCD, off = wgid / NXCD; wgid = (xcd < r ? xcd * (q + 1) : r * (q + 1) + (xcd - r) * q) + off; }
            const int nig = WGM * nN, gid = wgid / nig, fm = gid * WGM, gsz = (nM - fm) < WGM ? (nM - fm) : WGM;
            u.pm = fm + ((wgid % nig) % gsz); u.pn = pn_off + (wgid % nig) / gsz; if (skip0_n && u.pn >= skip0_lo) u.pn += skip0_n; if (skip_n && u.pn >= skip_lo) u.pn += skip_n; if (skip2_n && u.pn >= skip2_lo) u.pn += skip2_n; return true;
        }
        L -= nwg; if (L >= extra) return false;
        u.pm = pm0x + (int)(L >> 3); u.pn = pn0x + (int)(L & 7); return true;
    }
};

template <int MODE = 0, class Epi>
DI void gemm_phase(LAS unsigned char* lds, const Gemm g, const Order& S, const Epi& E) {
    constexpr bool FP8 = (MODE == 1);
    const int tid = opaque_tid(), wid = __builtin_amdgcn_readfirstlane(tid >> 6), lane = tid & 63, wr = wid >> 2, wc = wid & 3, fr = lane & 15, fq = lane >> 4;
    const int K = g.K, nt = g.ntile ? g.ntile : K / BK;
    unsigned voffA[2], voffB[2];
#pragma unroll
    for (int i = 0; i < 2; ++i) { int R, C; stage_rc(tid * 16 + i * 8192, R, C); const int Rb = (R & ~31) + perm32(R & 31);
        voffA[i] = (unsigned)(R * K + C) * 2u; voffB[i] = (unsigned)(Rb * K + C) * 2u; }
    const size_t kstep = (size_t)(BK * 2);
    const size_t hstep = (size_t)HALF * K * 2;
    const size_t tstep = 2 * hstep;
    const unsigned ldsw = (unsigned)wid * 1024u;
    const int aoff = lds_byte(wr * 64 + fr, fq * 8), boff = lds_byte(wc * 32 + fr, fq * 8);
#define PG8_SA(b, h) (((b) * 2 + (h)) * HTB)
#define PG8_SB(b, h) ((4 + (b) * 2 + (h)) * HTB)
#define PG8_STAGE(bufoff, gbase, voff) do { _Pragma("unroll") for (int _i = 0; _i < 2; ++_i) \
        __builtin_amdgcn_global_load_lds((const unsigned*)((const char*)(gbase) + (voff)[_i]), (LAS unsigned*)(lds + (bufoff) + ldsw + _i * 8192), 16, 0, 0); } while (0)
#define PG8_LD16(off) (*(const LAS i32x4*)(lds + (off)))
#define PG8_LDA(dst, b, h) do { if constexpr (FP8) { _Pragma("unroll") for (int m = 0; m < 4; ++m) dst##8[m] = __builtin_shufflevector(PG8_LD16(PG8_SA(b, h) + aoff + m * 2048), PG8_LD16(PG8_SA(b, h) + aoff + m * 2048 + 1024), 0, 1, 2, 3, 4, 5, 6, 7); } \
        else { _Pragma("unroll") for (int m = 0; m < 4; ++m) _Pragma("unroll") for (int k = 0; k < 2; ++k) dst[m][k] = *(const LAS bf16x8*)(lds + PG8_SA(b, h) + aoff + m * 2048 + k * 1024); } } while (0)
#define PG8_LDB(dst, b, h) do { if constexpr (FP8) { _Pragma("unroll") for (int n = 0; n < 2; ++n) dst##8[n] = __builtin_shufflevector(PG8_LD16(PG8_SB(b, h) + boff + n * 2048), PG8_LD16(PG8_SB(b, h) + boff + n * 2048 + 1024), 0, 1, 2, 3, 4, 5, 6, 7); } \
        else { _Pragma("unroll") for (int n = 0; n < 2; ++n) _Pragma("unroll") for (int k = 0; k < 2; ++k) dst[n][k] = *(const LAS bf16x8*)(lds + PG8_SB(b, h) + boff + n * 2048 + k * 1024); } } while (0)
#define PG8_MMA(ai, bj, At, Bt) do { __builtin_amdgcn_s_setprio(1); \
        if constexpr (FP8) { _Pragma("unroll") for (int m = 0; m < 4; ++m) _Pragma("unroll") for (int n = 0; n < 2; ++n) \
            asm volatile("v_mfma_scale_f32_16x16x128_f8f6f4 %0, %1, %2, %0, %3, %4 op_sel_hi:[0,0,0]" : "+v"(acc[ai][bj][m][n]) : "v"(Bt##8[n]), "v"(At##8[m]), "v"(sc_w), "v"(sc_1)); } \
        else if constexpr (MODE == 2) { _Pragma("unroll") for (int m = 0; m < 4; ++m) _Pragma("unroll") for (int n = 0; n < 2; ++n) _Pragma("unroll") for (int k = 0; k < 2; ++k) \
            acc[ai][bj][m][n] = __builtin_bit_cast(f32x4, __builtin_amdgcn_mfma_i32_16x16x64_i8(__builtin_bit_cast(i32x4, Bt[n][k]), __builtin_bit_cast(i32x4, At[m][k]), __builtin_bit_cast(i32x4, acc[ai][bj][m][n]), 0, 0, 0)); } \
        else { _Pragma("unroll") for (int m = 0; m < 4; ++m) _Pragma("unroll") for (int n = 0; n < 2; ++n) _Pragma("unroll") for (int k = 0; k < 2; ++k) \
            acc[ai][bj][m][n] = __builtin_amdgcn_mfma_f32_16x16x32_bf16(Bt[n][k], At[m][k], acc[ai][bj][m][n], 0, 0, 0); } \
        __builtin_amdgcn_s_setprio(0); } while (0)
#define PG8_WAIT_V(n) asm volatile("s_waitcnt vmcnt(" #n ")" ::: "memory")
#define PG8_WAIT_L(n) asm volatile("s_waitcnt lgkmcnt(" #n ")" ::: "memory")
#define PG8_BAR __builtin_amdgcn_s_barrier()
#define PG8_SCHED __builtin_amdgcn_sched_barrier(0)
    Unit cur, nxt; int ui = 0;
    if (!S.next(0, cur)) return;
    f32x4 acc[2][2][4][2];
#pragma unroll
    for (int a = 0; a < 2; ++a)
#pragma unroll
        for (int b = 0; b < 2; ++b)
#pragma unroll
            for (int m = 0; m < 4; ++m)
#pragma unroll
                for (int n = 0; n < 2; ++n) acc[a][b][m][n] = (f32x4){0.f, 0.f, 0.f, 0.f};
    bf16x8 At[4][2], B0[2][2], B1[2][2];
    const int sc_w = 0x79797979, sc_1 = g.sca;
    i32x8 At8[4], B08[2], B18[2];
    const char* cA = (const char*)g.A + (size_t)cur.pm * tstep; const char* cB = (const char*)g.Bt + (size_t)cur.pn * tstep;
    PG8_STAGE(PG8_SB(0, 0), cB, voffB); PG8_STAGE(PG8_SB(0, 1), cB + hstep, voffB); PG8_STAGE(PG8_SA(0, 0), cA, voffA); PG8_STAGE(PG8_SA(0, 1), cA + hstep, voffA);
    if (wr == 1) PG8_BAR;
    PG8_WAIT_V(2); PG8_BAR;
    PG8_STAGE(PG8_SB(1, 0), cB + kstep, voffB); PG8_STAGE(PG8_SA(1, 0), cA + kstep, voffA); PG8_STAGE(PG8_SB(1, 1), cB + hstep + kstep, voffB);
    PG8_WAIT_V(6); PG8_BAR;
    for (;;) {
        const bool has_next = S.next(ui + 1, nxt);
        const char* nA = has_next ? (const char*)g.A + (size_t)nxt.pm * tstep : cA; const char* nB = has_next ? (const char*)g.Bt + (size_t)nxt.pn * tstep : cB;
        for (int t = 0; t < nt; t += 2) {
            const bool last = (t == nt - 2);
            const char* a1 = cA + (size_t)(t + 1) * kstep;
            const char* a2 = last ? nA : cA + (size_t)(t + 2) * kstep; const char* b2 = last ? nB : cB + (size_t)(t + 2) * kstep;
            const char* a3 = a2 + kstep; const char* b3 = b2 + kstep;
            PG8_LDB(B0, 0, 0); PG8_LDB(B1, 0, 1); PG8_SCHED; PG8_LDA(At, 0, 0); PG8_STAGE(PG8_SA(1, 1), a1 + hstep, voffA);
            PG8_WAIT_V(8); PG8_WAIT_L(0); PG8_BAR; PG8_MMA(0, 0, At, B0); PG8_MMA(0, 1, At, B1); PG8_BAR; PG8_SCHED;
            PG8_LDA(At, 0, 1); PG8_STAGE(PG8_SB(0, 0), b2, voffB); PG8_STAGE(PG8_SB(0, 1), b2 + hstep, voffB); PG8_STAGE(PG8_SA(0, 0), a2, voffA);
            PG8_WAIT_V(8); PG8_WAIT_L(0); PG8_BAR; PG8_MMA(1, 0, At, B0); PG8_MMA(1, 1, At, B1); PG8_BAR; PG8_SCHED;
            PG8_LDB(B0, 1, 0); PG8_LDB(B1, 1, 1); PG8_SCHED; PG8_LDA(At, 1, 0); PG8_STAGE(PG8_SA(0, 1), a2 + hstep, voffA);
            PG8_WAIT_V(8); PG8_WAIT_L(0); PG8_BAR; PG8_MMA(0, 0, At, B0); PG8_MMA(0, 1, At, B1); PG8_BAR; PG8_SCHED;
            PG8_LDA(At, 1, 1); PG8_STAGE(PG8_SB(1, 0), b3, voffB); PG8_STAGE(PG8_SB(1, 1), b3 + hstep, voffB); PG8_STAGE(PG8_SA(1, 0), a3, voffA);
            PG8_WAIT_V(8); PG8_WAIT_L(0); PG8_BAR; PG8_MMA(1, 0, At, B0); PG8_MMA(1, 1, At, B1); PG8_BAR; PG8_SCHED;
        }
        if (wr == 0) PG8_BAR;
        if constexpr (FP8) asm volatile("s_nop 15\n\ts_nop 15" ::: "memory");
        E(acc, cur, wr, wc, fr, fq);
        if (!has_next) break;
#pragma unroll
        for (int a = 0; a < 2; ++a)
#pragma unroll
            for (int b = 0; b < 2; ++b)
#pragma unroll
                for (int m = 0; m < 4; ++m)
#pragma unroll
                    for (int n = 0; n < 2; ++n) acc[a][b][m][n] = (f32x4){0.f, 0.f, 0.f, 0.f};
        cur = nxt; cA = nA; cB = nB; ++ui;
        if (wr == 1) PG8_BAR;
    }
    PG8_WAIT_V(0);
    PG8_BAR;
#undef PG8_SA
#undef PG8_SB
#undef PG8_STAGE
#undef PG8_LDA
#undef PG8_LD16
#undef PG8_LDB
#undef PG8_MMA
#undef PG8_WAIT_V
#undef PG8_WAIT_L
#undef PG8_BAR
#undef PG8_SCHED
}
typedef f32x4 Acc[2][2][4][2];

struct EpiProj {
    unsigned char* ws; const float* bias; int shift_lo, shift; float qs;
    DI void operator()(const Acc& acc, const Unit& u, int wr, int wc, int fr, int fq) const {
        int row0 = u.pm * BM + wr * 64 + fr; const int pn = u.pn >= shift_lo ? u.pn + shift : u.pn;
        bf16_t* base; int ldc, ct; const float* bp = bias + pn * BM;
        if (u.pm >= 128) { base = (bf16_t*)(ws + WS_MKV); ldc = 2048; ct = pn - PN_KV; row0 -= T; bp = nullptr; }
        else if (pn < 6) { base = (bf16_t*)(ws + WS_QK1); ldc = 1536; ct = pn; }
        else if (pn < 12) { base = (bf16_t*)(ws + WS_V1); ldc = 1536; ct = pn - 6; }
        else if (pn < 18) { base = (bf16_t*)(ws + WS_QK2); ldc = 1536; ct = pn - 12; }
        else if (pn < 24) { base = (bf16_t*)(ws + WS_V2); ldc = 1536; ct = pn - 18; }
        else if (pn < 30) { base = (bf16_t*)(ws + WS_O1); ldc = 1536; ct = pn - 24; }
        else if (pn < 34) { base = (bf16_t*)(ws + WS_Q3); ldc = 1024; ct = pn - 30; }
        else if (pn < 40) { base = (bf16_t*)(ws + WS_Z1); ldc = 1536; ct = pn - 34; }
        else if (pn < 46) { base = (bf16_t*)(ws + WS_Z2); ldc = 1536; ct = pn - 40; }
        else if (pn < 50) { base = (bf16_t*)(ws + WS_Z3); ldc = 1024; ct = pn - 46; }
        else {
            if (wc == 0 && fq < 2) {
                float* IFp = (float*)(ws + WS_IF);
                const f32x4 b0 = *(const f32x4*)(bp + 8 * fq), b1 = *(const f32x4*)(bp + 8 * fq + 4);
#pragma unroll
                for (int ai = 0; ai < 2; ++ai)
#pragma unroll
                    for (int m = 0; m < 4; ++m) { float* rp = IFp + (size_t)(row0 + ai * HALF + m * 16) * 16 + 8 * fq;
                        *(f32x4*)rp = acc[ai][0][m][0] + b0; *(f32x4*)(rp + 4) = acc[ai][0][m][1] + b1; }
            }
            return;
        }
        const int col0 = ct * BM + wc * 32 + 8 * fq, bc0 = wc * 32 + 8 * fq;
        f32x4 bv[2][2];
#pragma unroll
        for (int bj = 0; bj < 2; ++bj)
#pragma unroll
            for (int n = 0; n < 2; ++n) bv[bj][n] = bp ? *(const f32x4*)(bp + bc0 + bj * HALF + 4 * n) : (f32x4){0.f, 0.f, 0.f, 0.f};
#pragma unroll
        for (int ai = 0; ai < 2; ++ai)
#pragma unroll
            for (int m = 0; m < 4; ++m) { bf16_t* rowp = base + (size_t)(row0 + ai * HALF + m * 16) * ldc + col0;
#pragma unroll
                for (int bj = 0; bj < 2; ++bj) { const f32x4 v0 = deq_acc(acc[ai][bj][m][0], qs) + bv[bj][0], v1 = deq_acc(acc[ai][bj][m][1], qs) + bv[bj][1];
                    u32x4 w; w.x = cvt_pk_bf16(v0[0], v0[1]); w.y = cvt_pk_bf16(v0[2], v0[3]); w.z = cvt_pk_bf16(v1[0], v1[1]); w.w = cvt_pk_bf16(v1[2], v1[3]);
                    *(u32x4*)(rowp + bj * HALF) = w; } }
    }
};
struct EpiGate {
    unsigned char* ws; const float* bias; float qs;
    DI void operator()(const Acc& acc, const Unit& u, int wr, int wc, int fr, int fq) const {
        const int row0 = u.pm * BM + wr * 64 + fr; const float* bp = bias + (PN_GATE + u.pn) * BM + wc * 32 + 8 * fq;
        const int ct = u.pn, gi = ct >> 3; bf16_t* G = (bf16_t*)(ws + (gi == 0 ? WS_G0 : WS_G12 + (size_t)(gi - 1) * SZ20));
        const int col0 = (ct & 7) * BM + wc * 32 + 8 * fq;
        f32x4 bv[2][2];
#pragma unroll
        for (int bj = 0; bj < 2; ++bj)
#pragma unroll
            for (int n = 0; n < 2; ++n) bv[bj][n] = *(const f32x4*)(bp + bj * HALF + 4 * n);
#pragma unroll
        for (int ai = 0; ai < 2; ++ai)
#pragma unroll
            for (int m = 0; m < 4; ++m) { bf16_t* rowp = G + (size_t)(row0 + ai * HALF + m * 16) * 2048 + col0;
#pragma unroll
                for (int bj = 0; bj < 2; ++bj) { f32x4 v0 = deq_acc(acc[ai][bj][m][0], qs) + bv[bj][0], v1 = deq_acc(acc[ai][bj][m][1], qs) + bv[bj][1];
#pragma unroll
                    for (int e = 0; e < 4; ++e) { v0[e] = sigmoidf_(v0[e]); v1[e] = sigmoidf_(v1[e]); }
                    u32x4 w; w.x = cvt_pk_bf16(v0[0], v0[1]); w.y = cvt_pk_bf16(v0[2], v0[3]); w.z = cvt_pk_bf16(v1[0], v1[1]); w.w = cvt_pk_bf16(v1[2], v1[3]);
                    *(u32x4*)(rowp + bj * HALF) = w; } }
    }
};
struct EpiMerge {
    bf16_t* merged; const bf16_t* G; int gi;
    DI void operator()(const Acc& acc, const Unit& u, int wr, int wc, int fr, int fq) const {
        const int row0 = u.pm * BM + wr * 64 + fr, col0 = u.pn * BM + wc * 32 + 8 * fq;
#pragma unroll
        for (int ai = 0; ai < 2; ++ai)
#pragma unroll
            for (int m = 0; m < 4; ++m) { const size_t r = (size_t)(row0 + ai * HALF + m * 16);
#pragma unroll
                for (int bj = 0; bj < 2; ++bj) {
                    const u32x4 gv = *(const u32x4*)(G + r * 2048 + col0 + bj * HALF);
                    bf16_t* mp = merged + r * 2048 + col0 + bj * HALF;
                    const f32x4 a0 = acc[ai][bj][m][0], a1 = acc[ai][bj][m][1];
                    float o[8] = {a0[0] * bflo(gv.x), a0[1] * bfhi(gv.x), a0[2] * bflo(gv.y), a0[3] * bfhi(gv.y), a1[0] * bflo(gv.z), a1[1] * bfhi(gv.z), a1[2] * bflo(gv.w), a1[3] * bfhi(gv.w)};
                    if (gi > 0) { const u32x4 pv = __builtin_nontemporal_load((const u32x4*)mp);
                        o[0] += bflo(pv.x); o[1] += bfhi(pv.x); o[2] += bflo(pv.y); o[3] += bfhi(pv.y); o[4] += bflo(pv.z); o[5] += bfhi(pv.z); o[6] += bflo(pv.w); o[7] += bfhi(pv.w); }
                    u32x4 w; w.x = cvt_pk_bf16(o[0], o[1]); w.y = cvt_pk_bf16(o[2], o[3]); w.z = cvt_pk_bf16(o[4], o[5]); w.w = cvt_pk_bf16(o[6], o[7]);
                    *(u32x4*)mp = w; } }
    }
};
struct EpiOut {
    bf16_t* D;
    DI void operator()(const Acc& acc, const Unit& u, int wr, int wc, int fr, int fq) const {
        const int row0 = u.pm * BM + wr * 64 + fr, col0 = u.pn * BM + wc * 32 + 8 * fq;
#pragma unroll
        for (int ai = 0; ai < 2; ++ai)
#pragma unroll
            for (int m = 0; m < 4; ++m) { bf16_t* rowp = D + (size_t)(row0 + ai * HALF + m * 16) * 2048 + col0;
#pragma unroll
                for (int bj = 0; bj < 2; ++bj) { const f32x4 v0 = acc[ai][bj][m][0], v1 = acc[ai][bj][m][1];
                    u32x4 w; w.x = cvt_pk_bf16(v0[0], v0[1]); w.y = cvt_pk_bf16(v0[2], v0[3]); w.z = cvt_pk_bf16(v1[0], v1[1]); w.w = cvt_pk_bf16(v1[2], v1[3]);
                    *(u32x4*)(rowp + bj * HALF) = w; } }
    }
};
}

DI int src_col_of(int n) {
    if (n < 3072) return n;
    if (n < 4608) return n - 3072 + 6156;
    if (n < 6144) return n - 4608 + 7692;
    if (n < 7680) return n - 6144 + 3072;
    if (n < 8704) return n - 7680 + 10764;
    if (n < 10240) return n - 8704 + 4608;
    if (n < 11776) return n - 10240 + 9228;
    if (n < 12800) return n - 11776 + 11788;
    if (n < 12812) return n - 12800 + 6144;
    if (n < 13056) return -1;
    return n - 13056 + 12812;
}
struct TpItem { const float* W; bf16_t* WT; unsigned char* W8; int Nsrc, K, n0, k0, remap, n8, m8; };
DI bool tp_decode(const Params& P, int it, TpItem& t) {
    constexpr int I_IN = 300 * 8, I_KV = 32 * 8, I_ML = 32 * 6, I_RET = 32 * 6, I_XA = 32 * 4, I_OUT = 32 * 8;
    unsigned char* ws = P.ws; int r = it; t.remap = 0; t.W8 = nullptr; t.n8 = 0; t.m8 = 2;
    if (r < I_IN) { t.W = P.w_in; t.WT = (bf16_t*)(ws + WS_WIN); t.Nsrc = N_IN; t.K = 2048; t.n0 = (r >> 3) * 64; t.k0 = (r & 7) * 256; t.remap = 1;
        if (t.n0 < 1536) { t.W8 = (unsigned char*)P.out + DO_QKC; t.n8 = t.n0; }
        else if (t.n0 >= 1536 && t.n0 < 3072) { t.W8 = ws + WS_WV8; t.n8 = t.n0 - 1536; }
        else if (t.n0 >= 10240 && t.n0 < 11776) { t.W8 = ws + WS_WZ8; t.n8 = t.n0 - 10240; }
        else if (t.n0 >= 6144 && t.n0 < 10240) { t.W8 = (unsigned char*)P.out + DO_WO8; t.n8 = t.n0 - 6144; }
        else if (t.n0 >= 11776 && t.n0 < 12800) { t.W8 = (unsigned char*)P.out + DO_WO8; t.n8 = t.n0 - 11776 + 4096; }
        else if (t.n0 >= 13056) { t.W8 = (unsigned char*)P.out + DO_WG8; t.n8 = t.n0 - 13056; }
        return true; } r -= I_IN;
    if (r < I_KV) { t.W = P.w_kv; t.WT = (bf16_t*)(ws + WS_WKV); t.Nsrc = 2048; t.K = 2048; t.n0 = (r >> 3) * 64; t.k0 = (r & 7) * 256; return true; } r -= I_KV;
    if (r < I_ML) { t.W = P.w_ml; t.WT = (bf16_t*)(ws + WS_WML); t.Nsrc = 2048; t.K = 1536; t.n0 = (r / 6) * 64; t.k0 = (r % 6) * 256; return true; } r -= I_ML;
    if (r < I_RET) { t.W = P.w_ret; t.WT = (bf16_t*)(ws + WS_WRET); t.Nsrc = 2048; t.K = 1536; t.n0 = (r / 6) * 64; t.k0 = (r % 6) * 256; return true; } r -= I_RET;
    if (r < I_XA) { t.W = P.w_xa; t.WT = (bf16_t*)(ws + WS_WXA); t.Nsrc = 2048; t.K = 1024; t.n0 = (r >> 2) * 64; t.k0 = (r & 3) * 256; t.W8 = (unsigned char*)P.out + DO_WX8; t.n8 = t.n0; t.m8 = 1; return true; } r -= I_XA;
    if (r < I_OUT) { t.W = P.w_out; t.WT = (bf16_t*)(ws + WS_WOUT); t.Nsrc = 2048; t.K = 2048; t.n0 = (r >> 3) * 64; t.k0 = (r & 7) * 256; return true; }
    return false;
}
DI void tp_load(const TpItem& t, int tid, f32x4 (&v)[8]) {
    const int nq = tid & 15, kk0 = tid >> 4; const int src = t.remap ? src_col_of(t.n0 + 4 * nq) : (t.n0 + 4 * nq);
#pragma unroll
    for (int i = 0; i < 8; ++i) v[i] = src >= 0 ? *(const f32x4*)(t.W + (size_t)(t.k0 + kk0 + 32 * i) * t.Nsrc + src) : (f32x4){0.f, 0.f, 0.f, 0.f};
}
DI void p0_transposes(const Params& P, LAS unsigned char* lds) {
    const int tid = opaque_tid(), G = gridDim.x, bx = blockIdx.x, nq = tid & 15, kk0 = tid >> 4;
    LAS bf16_t* tile = (LAS bf16_t*)lds;
    TpItem cur, nxt; f32x4 v[8];
    int it = bx; bool have = tp_decode(P, it, cur);
    if (have) tp_load(cur, tid, v);
    while (have) {
        if (cur.W8) {
#pragma unroll
            for (int i = 0; i < 8; ++i) { const int kk = kk0 + 32 * i; unsigned q = 0u;
                if (cur.m8 == 2) q = pack_i8x4(v[i][0], v[i][1], v[i][2], v[i][3], W8_SCALE);
                else { q = __builtin_amdgcn_cvt_pk_fp8_f32(v[i][0] * 64.f, v[i][1] * 64.f, q, false); q = __builtin_amdgcn_cvt_pk_fp8_f32(v[i][2] * 64.f, v[i][3] * 64.f, q, true); }
#pragma unroll
                for (int e = 0; e < 4; ++e) *(LAS unsigned char*)(lds + (4 * nq + e) * 272 + kk) = (unsigned char)(q >> (8 * e)); }
        } else {
#pragma unroll
            for (int i = 0; i < 8; ++i) { const int kk = kk0 + 32 * i;
#pragma unroll
                for (int e = 0; e < 4; ++e) tile[(4 * nq + e) * 264 + kk] = (bf16_t)(cvt_pk_bf16(v[i][e], 0.f) & 0xffffu); }
        }
        __syncthreads();
        it += G; const bool hn = tp_decode(P, it, nxt);
        if (hn) tp_load(nxt, tid, v);
        if (cur.W8) {
#pragma unroll
            for (int j = 0; j < 2; ++j) { const int p = tid + 512 * j, n2 = p >> 4, kq = p & 15; const u32x4 tv = *(const LAS u32x4*)(lds + n2 * 272 + kq * 16); *(u32x4*)(cur.W8 + (size_t)(cur.n8 + n2) * cur.K + cur.k0 + 16 * kq) = tv; }
        } else {
#pragma unroll
            for (int j = 0; j < 4; ++j) { const int p = tid + 512 * j, n2 = p >> 5, kq = p & 31; const u32x4 tv = *(const LAS u32x4*)(lds + n2 * 528 + kq * 16); *(u32x4*)(cur.WT + (size_t)(cur.n0 + n2) * cur.K + cur.k0 + 8 * kq) = tv; }
        }
        __syncthreads();
        cur = nxt; have = hn;
    }
}
DI void rms_row(const float* xr, const float* g, bf16_t* o, unsigned char* o8, int lane) {
    f32x4 v[8]; float s = 0.f;
#pragma unroll
    for (int i = 0; i < 8; ++i) { v[i] = *(const f32x4*)(xr + 4 * (lane + 64 * i)); s += v[i][0] * v[i][0] + v[i][1] * v[i][1] + v[i][2] * v[i][2] + v[i][3] * v[i][3]; }
    s = wave_sum(s); const float sc = rsqrtf(s * (1.0f / 2048.0f) + EPS);
#pragma unroll
    for (int i = 0; i < 8; ++i) { const f32x4 gg = *(const f32x4*)(g + 4 * (lane + 64 * i)); const f32x4 y = v[i] * sc * gg;
        u32x2 w; w.x = cvt_pk_bf16(y[0], y[1]); w.y = cvt_pk_bf16(y[2], y[3]); *(u32x2*)(o + 4 * (lane + 64 * i)) = w;
        if (o8) *(unsigned*)(o8 + 4 * (lane + 64 * i)) = pack_i8x4(y[0], y[1], y[2], y[3], H8_SCALE); }
}
DI void p0_prologue(const Params& P, LAS unsigned char* lds) {
    const int tid = opaque_tid(), lane = tid & 63, wave = tid >> 6, G = gridDim.x, bx = blockIdx.x;
    unsigned char* ws = P.ws;
    if (bx == 0 && tid < 64) ((unsigned*)(ws + WS_CTL))[tid] = 0u;
    if (bx == 0) for (int i = tid; i < 3456; i += 512) ((unsigned*)(ws + WS_BAR))[i] = 0u;
    for (int i = bx * 512 + tid; i < T; i += G * 512) ((float*)(ws + WS_SS))[i] = 0.f;
    for (int i = bx * 512 + tid; i < NPAD; i += G * 512) { const int s = src_col_of(i); ((float*)(ws + WS_BIAS))[i] = s >= 0 ? P.b_in[s] : 0.f; }
    bf16_t* H = (bf16_t*)((unsigned char*)P.out + DO_H);
    for (int r = bx * 8 + wave; r < T + 2048; r += G * 8) {
        if (r < T) rms_row(P.x + (size_t)r * DM, P.ln_g, H + (size_t)r * DM, ws + WS_H8 + (size_t)r * DM, lane);
        else rms_row(P.mem + (size_t)(r - T) * DM, P.mem_ln_g, H + (size_t)r * DM, nullptr, lane);
    }
    p0_transposes(P, lds);
}

DI float logsigmoidf_(float v) { return fminf(v, 0.f) - log1pf(expf(-fabsf(v))); }
DI void p2_gates_wg(const Params& P, int bh, LAS unsigned char* lds) {
    const int tid = opaque_tid(), lane = tid & 63, wave = tid >> 6;
    unsigned char* ws = P.ws; const int b = bh / 6, h = bh % 6;
    const float* IFp = (const float*)(ws + WS_IF) + (size_t)b * SEQ * 16;
    float* A1 = (float*)(ws + WS_GS) + (size_t)bh * SEQ; float* IB = A1 + GS_ARR; float* INTER = IB + GS_ARR; float* EDEN = INTER + GS_ARR; float* W = EDEN + GS_ARR;
    float* DEC = (float*)(ws + WS_GDEC) + bh * 64;
    LAS f32x2* AB = (LAS f32x2*)lds;
    float iv[8], fv[8], bbv[8], ibv[8], mxv[8], gv[8], mxa[8];
#pragma unroll
    for (int k = 0; k < 8; ++k) { const int t = (wave * 8 + k) * 64 + lane; iv[k] = IFp[(size_t)t * 16 + h]; fv[k] = IFp[(size_t)t * 16 + 6 + h]; }
#pragma unroll
    for (int k = 0; k < 8; ++k) {
        float bb = logsigmoidf_(fv[k]);
#pragma unroll
        for (int o = 1; o < 64; o <<= 1) { const float u = __shfl_up(bb, o); if (lane >= o) bb += u; }
        const float g = __shfl(bb, 63), ib = iv[k] - bb;
        float mx = ib;
#pragma unroll
        for (int o = 1; o < 64; o <<= 1) { const float u = __shfl_up(mx, o); if (lane >= o) mx = fmaxf(mx, u); }
        const float mxall = __shfl(mx, 63);
        bbv[k] = bb; ibv[k] = ib; mxv[k] = mx; gv[k] = g; mxa[k] = mxall;
        if (lane == 0) AB[wave * 8 + k] = (f32x2){g, g + mxall};
        __builtin_amdgcn_sched_barrier(0);
    }
    __syncthreads();
    float m = 0.f;
    for (int c = 0; c < wave * 8; ++c) { const f32x2 ab = AB[c]; m = fmaxf(m + ab.x, ab.y); }
#pragma unroll
    for (int k = 0; k < 8; ++k) {
        const int c = wave * 8 + k, t = c * 64 + lane;
        const float log_inter = bbv[k] + m, m_row = fmaxf(log_inter, bbv[k] + mxv[k]);
        const float m_new = fmaxf(gv[k] + m, gv[k] + mxa[k]);
        A1[t] = bbv[k] - m_row; IB[t] = ibv[k]; INTER[t] = expf(log_inter - m_row); EDEN[t] = expf(-m_row); W[t] = expf(gv[k] + ibv[k] - m_new);
        if (lane == 0) DEC[c] = expf(gv[k] + m - m_new);
        m = m_new;
        __builtin_amdgcn_sched_barrier(0);
    }
    __syncthreads();
}
DI void p2_prep(const Params& P, LAS unsigned char* lds) {
    const int tid = opaque_tid(), lane = tid & 63, wave = tid >> 6, G = gridDim.x, bx = blockIdx.x;
    unsigned char* ws = P.ws;
    for (int it = bx; it < 48; it += G) p2_gates_wg(P, it, lds);
    if (bx == (G > 48 ? 48 : 0) && tid < 6 * 64) {
        const int h = tid >> 6, l = tid & 63; const float lg = logf(1.0f - exp2f(-5.0f - (float)h));
        float* RV = (float*)(ws + WS_RV) + h * 5 * 64;
        RV[l] = (float)l * lg; RV[64 + l] = -(float)l * lg; RV[128 + l] = expf((float)(l + 1) * lg); RV[192 + l] = 1.0f; RV[256 + l] = expf((float)(63 - l) * lg);
        if (l == 0) ((float*)(ws + WS_RV))[6 * 5 * 64 + h] = expf(64.0f * lg);
    }
    const bf16_t* QK1 = (const bf16_t*)(ws + WS_QK1); bf16_t* QKC = (bf16_t*)((unsigned char*)P.out + DO_QKC);
    for (int idx = bx * 512 + tid; idx < (T / 16) * 192; idx += G * 512) {
        const int rb = idx / 192, cgp = idx % 192, r0 = rb * 16, c0 = cgp * 8;
        float w[4][8], bz[8], u[3][8];
#pragma unroll
        for (int k = 0; k < 4; ++k) { const f32x4 a = *(const f32x4*)(P.conv_w + k * 1536 + c0), b = *(const f32x4*)(P.conv_w + k * 1536 + c0 + 4);
            w[k][0] = a[0]; w[k][1] = a[1]; w[k][2] = a[2]; w[k][3] = a[3]; w[k][4] = b[0]; w[k][5] = b[1]; w[k][6] = b[2]; w[k][7] = b[3]; }
        { const f32x4 a = *(const f32x4*)(P.conv_b + c0), b = *(const f32x4*)(P.conv_b + c0 + 4); bz[0] = a[0]; bz[1] = a[1]; bz[2] = a[2]; bz[3] = a[3]; bz[4] = b[0]; bz[5] = b[1]; bz[6] = b[2]; bz[7] = b[3]; }
        const bool hist = (r0 & (SEQ - 1)) != 0;
#pragma unroll
        for (int k = 0; k < 3; ++k) {
            u32x4 v = (u32x4){0u, 0u, 0u, 0u}; if (hist) v = *(const u32x4*)(QK1 + (size_t)(r0 - 3 + k) * 1536 + c0);
            u[k][0] = bflo(v.x); u[k][1] = bfhi(v.x); u[k][2] = bflo(v.y); u[k][3] = bfhi(v.y); u[k][4] = bflo(v.z); u[k][5] = bfhi(v.z); u[k][6] = bflo(v.w); u[k][7] = bfhi(v.w); }
        const float sc = c0 < 768 ? 0.08838834764831845f : 1.0f;
        for (int rh = 0; rh < 16; rh += 8) {
        u32x4 rows[8];
#pragma unroll
        for (int r = 0; r < 8; ++r) rows[r] = *(const u32x4*)(QK1 + (size_t)(r0 + rh + r) * 1536 + c0);
#pragma unroll
        for (int rr = 0; rr < 8; ++rr) { const int r = rh + rr;
            const u32x4 v = rows[rr];
            const float cu[8] = {bflo(v.x), bfhi(v.x), bflo(v.y), bfhi(v.y), bflo(v.z), bfhi(v.z), bflo(v.w), bfhi(v.w)};
            float y[8];
#pragma unroll
            for (int e = 0; e < 8; ++e) { const float a = bz[e] + w[0][e] * u[0][e] + w[1][e] * u[1][e] + w[2][e] * u[2][e] + w[3][e] * cu[e]; y[e] = siluf_(a) * sc; u[0][e] = u[1][e]; u[1][e] = u[2][e]; u[2][e] = cu[e]; }
            u32x4 o; o.x = cvt_pk_bf16(y[0], y[1]); o.y = cvt_pk_bf16(y[2], y[3]); o.z = cvt_pk_bf16(y[4], y[5]); o.w = cvt_pk_bf16(y[6], y[7]);
            *(u32x4*)(QKC + (size_t)(r0 + r) * 1536 + c0) = o;
        }
        }
    }
    bf16_t* QK2 = (bf16_t*)(ws + WS_QK2);
    for (int idx = bx * 512 + tid; idx < T * 8; idx += G * 512) {
        const int tok = idx >> 3, dg = idx & 7; const float pos = (float)P.pos[tok];
        float cs[8], sn[8];
#pragma unroll
        for (int j = 0; j < 8; ++j) { const float fr = exp2f(-(float)(dg * 8 + j) * (13.287712379549449f / 64.0f)); const float ang = pos * fr;
            double rev = (double)ang * 0.15915494309189535; rev -= rint(rev); const float rf = (float)rev;
            sn[j] = __builtin_amdgcn_sinf(rf); cs[j] = __builtin_amdgcn_cosf(rf); }
        for (int hg = 0; hg < 4; ++hg) {
            u32x4 la[3], lb[3];
#pragma unroll
            for (int k = 0; k < 3; ++k) { const bf16_t* p = QK2 + (size_t)tok * 1536 + (hg * 3 + k) * 128 + dg * 8; la[k] = *(const u32x4*)p; lb[k] = *(const u32x4*)(p + 64); }
#pragma unroll
            for (int k = 0; k < 3; ++k) {
                bf16_t* p = QK2 + (size_t)tok * 1536 + (hg * 3 + k) * 128 + dg * 8; const float sc = hg >= 2 ? 0.08838834764831845f : 1.0f;
                const u32x4 a = la[k], b = lb[k];
                const float t1[8] = {bflo(a.x), bfhi(a.x), bflo(a.y), bfhi(a.y), bflo(a.z), bfhi(a.z), bflo(a.w), bfhi(a.w)};
                const float t2[8] = {bflo(b.x), bfhi(b.x), bflo(b.y), bfhi(b.y), bflo(b.z), bfhi(b.z), bflo(b.w), bfhi(b.w)};
                float o1[8], o2[8];
#pragma unroll
                for (int j = 0; j < 8; ++j) { o1[j] = (t1[j] * cs[j] - t2[j] * sn[j]) * sc; o2[j] = (t1[j] * sn[j] + t2[j] * cs[j]) * sc; }
                u32x4 x1, x2; x1.x = cvt_pk_bf16(o1[0], o1[1]); x1.y = cvt_pk_bf16(o1[2], o1[3]); x1.z = cvt_pk_bf16(o1[4], o1[5]); x1.w = cvt_pk_bf16(o1[6], o1[7]);
                x2.x = cvt_pk_bf16(o2[0], o2[1]); x2.y = cvt_pk_bf16(o2[2], o2[3]); x2.z = cvt_pk_bf16(o2[4], o2[5]); x2.w = cvt_pk_bf16(o2[6], o2[7]);
                *(u32x4*)p = x1; *(u32x4*)(p + 64) = x2;
            }
        }
    }
}

constexpr int SQ_P = 272, SV_P = 528, ST_P = 144;
constexpr int SC_STAGE = 64 * SQ_P * 2 + 64 * SV_P;
constexpr int SC_ST = 2 * SC_STAGE;
constexpr int SC_NV = SC_ST + 64 * ST_P;
constexpr int SC_RDEN = SC_NV + 512;
constexpr int SC_LNP = SC_RDEN + 256;
constexpr int SC_VEC = SC_LNP + 4096;
constexpr int SC_GAIN = SC_VEC + 2560;
constexpr int SC_END = SC_GAIN + 1024;
static_assert(SC_END <= LDS_BYTES, "scan LDS");

DI void scan_item(const Params& P, LAS unsigned char* lds, int item) {
    const int tid = opaque_tid(), lane = tid & 63, w = __builtin_amdgcn_readfirstlane(tid >> 6), r = lane & 15, g = lane >> 4, q4 = r >> 2, p4 = r & 3;
    unsigned char* ws = P.ws;
    const bool is_ml = item < 48; const int bh = is_ml ? item : item - 48, b = bh / 6, h = bh % 6;
    const bf16_t* Qg = (is_ml ? (const bf16_t*)((unsigned char*)P.out + DO_QKC) : (const bf16_t*)(ws + WS_QK2)) + (size_t)b * SEQ * 1536 + h * 128;
    const bf16_t* Kg = Qg + 768;
    bf16_t* Vg = (bf16_t*)(ws + (is_ml ? WS_V1 : WS_V2)) + (size_t)b * SEQ * 1536 + h * 256;
    const float* vbase; const float* vDEC; int cstr, dstr; size_t vstr;
    if (is_ml) { vbase = (const float*)(ws + WS_GS) + (size_t)bh * SEQ; vstr = GS_ARR; vDEC = (const float*)(ws + WS_GDEC) + bh * 64; cstr = 64; dstr = 1; }
    else { vbase = (const float*)(ws + WS_RV) + h * 320; vstr = 64; vDEC = (const float*)(ws + WS_RV) + 6 * 320 + h; cstr = 0; dstr = 0; }
    const float* vptr = vbase + (size_t)(tid >> 6) * vstr + (tid & 63);
    const unsigned ldsb = (unsigned)(size_t)lds;
    f32x4 Cacc[8][2];
#pragma unroll
    for (int i = 0; i < 8; ++i) { Cacc[i][0] = (f32x4){0.f, 0.f, 0.f, 0.f}; Cacc[i][1] = (f32x4){0.f, 0.f, 0.f, 0.f}; }
    if (tid < 128) ((LAS float*)(lds + SC_NV))[tid] = 0.f;
    if (tid < 64) ((LAS float*)(lds + SC_RDEN))[tid] = 1.0f;
    u32x4 pq[2], pk[2], pv[4];
    unsigned qoff = (unsigned)(tid >> 4) * 3072u + (unsigned)(tid & 15) * 16u, voff = (unsigned)(tid >> 5) * 3072u + (unsigned)(tid & 31) * 16u, zoff = (unsigned)r * 3072u + (unsigned)(32 * w + 8 * g) * 2u;
#define SC_LOAD(c) do { const size_t cb = (size_t)(c) * 64 * 3072; const char* qb_ = (const char*)Qg + cb; const char* kb_ = (const char*)Kg + cb; const char* vb_ = (const char*)Vg + cb; \
        _Pragma("unroll") for (int i = 0; i < 2; ++i) { pq[i] = *(const u32x4*)(qb_ + (qoff + i * 98304u)); pk[i] = *(const u32x4*)(kb_ + (qoff + i * 98304u)); } \
        _Pragma("unroll") for (int i = 0; i < 4; ++i) { pv[i] = *(const u32x4*)(vb_ + (voff + i * 49152u)); } } while (0)
#define SC_STORE(st) do { LAS unsigned char* sb = lds + (st) * SC_STAGE; \
        _Pragma("unroll") for (int i = 0; i < 2; ++i) { const int pp = tid + 512 * i, row = pp >> 4, ch = pp & 15; *(LAS u32x4*)(sb + row * SQ_P + ch * 16) = pq[i]; *(LAS u32x4*)(sb + 64 * SQ_P + row * SQ_P + ch * 16) = pk[i]; } \
        _Pragma("unroll") for (int i = 0; i < 4; ++i) { const int pp = tid + 512 * i, row = pp >> 5, ch = pp & 31; *(LAS u32x4*)(sb + 128 * SQ_P + row * SV_P + ch * 16) = pv[i]; } } while (0)
    SC_LOAD(0); SC_STORE(0);
    if (tid < 320) ((LAS float*)(lds + SC_VEC))[tid] = vptr[0];
    __syncthreads();

    for (int c = 0; c < 64; ++c) {
        const int cur = c & 1;
        asm volatile("" : "+v"(qoff), "+v"(voff), "+v"(zoff));
        LAS unsigned char* Qs = lds + cur * SC_STAGE; LAS unsigned char* Ks = Qs + 64 * SQ_P; LAS unsigned char* Vs = Qs + 128 * SQ_P;
        const unsigned KsA = ldsb + cur * SC_STAGE + 64 * SQ_P, VsA = ldsb + cur * SC_STAGE + 128 * SQ_P;
        const LAS float* cA1 = (const LAS float*)(lds + SC_VEC + cur * 1280); const LAS float* cIB = cA1 + 64; const LAS float* cINT = cA1 + 128; const LAS float* cEDEN = cA1 + 192; const LAS float* cW = cA1 + 256;
        const float decay = vDEC[c * dstr];
        {
            const int mb = w >> 1, l = 16 * mb + r; const float a1 = cA1[l];
            bf16x8 qf[4];
#pragma unroll
            for (int ks = 0; ks < 4; ++ks) qf[ks] = *(const LAS bf16x8*)(Qs + l * SQ_P + (32 * ks + 8 * g) * 2);
#pragma unroll
            for (int nn = 0; nn < 2; ++nn) {
                const int nb = 2 * (w & 1) + nn; u32x2 o = (u32x2){0u, 0u};
                if (nb <= mb) {
                    f32x4 s = (f32x4){0.f, 0.f, 0.f, 0.f};
#pragma unroll
                    for (int ks = 0; ks < 4; ++ks) { const bf16x8 kf = *(const LAS bf16x8*)(Ks + (16 * nb + r) * SQ_P + (32 * ks + 8 * g) * 2); s = MFMA16(kf, qf[ks], s); }
                    const f32x4 ib = *(const LAS f32x4*)(cIB + 16 * nb + 4 * g);
                    float d[4];
#pragma unroll
                    for (int j = 0; j < 4; ++j) { const int sidx = 16 * nb + 4 * g + j; d[j] = (sidx <= l) ? s[j] * __expf(a1 + ib[j]) : 0.f; }
                    o.x = cvt_pk_bf16(d[0], d[1]); o.y = cvt_pk_bf16(d[2], d[3]);
                }
                *(LAS u32x2*)(lds + SC_ST + l * ST_P + (16 * nb + 4 * g) * 2) = o;
            }
        }
        LBAR();
        if (is_ml) {
            const int l = tid >> 3, part = tid & 7;
            const u32x4 sv = *(const LAS u32x4*)(lds + SC_ST + l * ST_P + part * 16);
            float ssum = bflo(sv.x) + bfhi(sv.x) + bflo(sv.y) + bfhi(sv.y) + bflo(sv.z) + bfhi(sv.z) + bflo(sv.w) + bfhi(sv.w);
            const u32x4 q0 = *(const LAS u32x4*)(Qs + l * SQ_P + part * 32), q1 = *(const LAS u32x4*)(Qs + l * SQ_P + part * 32 + 16);
            const LAS f32x4* nv = (const LAS f32x4*)(lds + SC_NV + part * 64);
            const f32x4 n0 = nv[0], n1 = nv[1], n2 = nv[2], n3 = nv[3];
            float qn = bflo(q0.x) * n0[0] + bfhi(q0.x) * n0[1] + bflo(q0.y) * n0[2] + bfhi(q0.y) * n0[3] + bflo(q0.z) * n1[0] + bfhi(q0.z) * n1[1] + bflo(q0.w) * n1[2] + bfhi(q0.w) * n1[3]
                     + bflo(q1.x) * n2[0] + bfhi(q1.x) * n2[1] + bflo(q1.y) * n2[2] + bfhi(q1.y) * n2[3] + bflo(q1.z) * n3[0] + bfhi(q1.z) * n3[1] + bflo(q1.w) * n3[2] + bfhi(q1.w) * n3[3];
            float val = ssum + cINT[l] * qn;
            val += __shfl_xor(val, 1); val += __shfl_xor(val, 2); val += __shfl_xor(val, 4);
            if (part == 0) ((LAS float*)(lds + SC_RDEN))[l] = 1.0f / fmaxf(fabsf(val), cEDEN[l]);
        }
        __builtin_amdgcn_sched_barrier(0);
        LBAR();
        bf16x8 vf[2][2];
        unsigned vtb = VsA + (8 * g + q4) * SV_P + (32 * w + 8 * p4) * 2; asm volatile("" : "+v"(vtb));
        unsigned ktb = KsA + (8 * g + q4) * SQ_P + (4 * p4) * 2; asm volatile("" : "+v"(ktb));
        { s16x4 t8[8];
          tr_read8(t8, vtb, vtb + 4 * SV_P, vtb + 32 * SV_P, vtb + 36 * SV_P, vtb + 8, vtb + 8 + 4 * SV_P, vtb + 8 + 32 * SV_P, vtb + 8 + 36 * SV_P);
          vf[0][0] = __builtin_shufflevector(t8[0], t8[1], 0, 1, 2, 3, 4, 5, 6, 7); vf[0][1] = __builtin_shufflevector(t8[2], t8[3], 0, 1, 2, 3, 4, 5, 6, 7);
          vf[1][0] = __builtin_shufflevector(t8[4], t8[5], 0, 1, 2, 3, 4, 5, 6, 7); vf[1][1] = __builtin_shufflevector(t8[6], t8[7], 0, 1, 2, 3, 4, 5, 6, 7); }
        f32x4 hi_[4][2], hx_[4][2];
#pragma unroll
        for (int mb = 0; mb < 4; ++mb)
#pragma unroll
            for (int vt = 0; vt < 2; ++vt) { hi_[mb][vt] = (f32x4){0.f, 0.f, 0.f, 0.f}; hx_[mb][vt] = (f32x4){0.f, 0.f, 0.f, 0.f}; }
#pragma unroll
        for (int mb = 0; mb < 4; ++mb)
#pragma unroll
            for (int ks = 0; ks < 2; ++ks) {
                if (ks == 1 && mb < 2) continue;
                const bf16x8 sf = *(const LAS bf16x8*)(lds + SC_ST + (16 * mb + r) * ST_P + (32 * ks + 8 * g) * 2);
                hi_[mb][0] = MFMA16(vf[0][ks], sf, hi_[mb][0]); hi_[mb][1] = MFMA16(vf[1][ks], sf, hi_[mb][1]);
            }
#pragma unroll
        for (int p = 0; p < 4; ++p) {
            bf16x8 cf[2];
#pragma unroll
            for (int vt = 0; vt < 2; ++vt) { u32x4 t; const f32x4 c0 = Cacc[2 * p][vt], c1 = Cacc[2 * p + 1][vt];
                t.x = cvt_pk_bf16(c0[0], c0[1]); t.y = cvt_pk_bf16(c0[2], c0[3]); t.z = cvt_pk_bf16(c1[0], c1[1]); t.w = cvt_pk_bf16(c1[2], c1[3]); cf[vt] = __builtin_bit_cast(bf16x8, t); }
#pragma unroll
            for (int mb = 0; mb < 4; ++mb) {
                const u32x2 qa = *(const LAS u32x2*)(Qs + (16 * mb + r) * SQ_P + (32 * p + 4 * g) * 2), qb = *(const LAS u32x2*)(Qs + (16 * mb + r) * SQ_P + (32 * p + 16 + 4 * g) * 2);
                u32x4 t; t.x = qa.x; t.y = qa.y; t.z = qb.x; t.w = qb.y; const bf16x8 qf2 = __builtin_bit_cast(bf16x8, t);
                hx_[mb][0] = MFMA16(cf[0], qf2, hx_[mb][0]); hx_[mb][1] = MFMA16(cf[1], qf2, hx_[mb][1]);
            }
            __builtin_amdgcn_sched_barrier(0);
        }
#pragma unroll
        for (int mb = 0; mb < 4; ++mb) { const int l = 16 * mb + r; const float it = cINT[l], rd = ((const LAS float*)(lds + SC_RDEN))[l];
            float v[8];
#pragma unroll
            for (int vt = 0; vt < 2; ++vt)
#pragma unroll
                for (int j = 0; j < 4; ++j) v[4 * vt + j] = (hi_[mb][vt][j] + it * hx_[mb][vt][j]) * rd;
            u32x4 st; st.x = cvt_pk_bf16(v[0], v[1]); st.y = cvt_pk_bf16(v[2], v[3]); st.z = cvt_pk_bf16(v[4], v[5]); st.w = cvt_pk_bf16(v[6], v[7]);
            *(u32x4*)((char*)Vg + (size_t)c * 64 * 3072 + (zoff + mb * 49152u)) = st;
        }
        {
            bf16x8 vw[2][2];
#pragma unroll
            for (int ks = 0; ks < 2; ++ks) { const f32x4 w0 = *(const LAS f32x4*)(cW + 32 * ks + 8 * g), w1 = *(const LAS f32x4*)(cW + 32 * ks + 8 * g + 4);
#pragma unroll
                for (int vt = 0; vt < 2; ++vt) { const u32x4 t = __builtin_bit_cast(u32x4, vf[vt][ks]); u32x4 o;
                    o.x = cvt_pk_bf16(bflo(t.x) * w0[0], bfhi(t.x) * w0[1]); o.y = cvt_pk_bf16(bflo(t.y) * w0[2], bfhi(t.y) * w0[3]);
                    o.z = cvt_pk_bf16(bflo(t.z) * w1[0], bfhi(t.z) * w1[1]); o.w = cvt_pk_bf16(bflo(t.w) * w1[2], bfhi(t.w) * w1[3]); vw[vt][ks] = __builtin_bit_cast(bf16x8, o); } }
#pragma unroll
            for (int dp = 0; dp < 4; ++dp) {
                s16x4 t8[8]; const unsigned kb0 = ktb + (32 * dp) * 2, kb1 = kb0 + 32;
                tr_read8(t8, kb0, kb0 + 4 * SQ_P, kb0 + 32 * SQ_P, kb0 + 36 * SQ_P, kb1, kb1 + 4 * SQ_P, kb1 + 32 * SQ_P, kb1 + 36 * SQ_P);
#pragma unroll
                for (int dd = 0; dd < 2; ++dd) { const int db = 2 * dp + dd;
                    Cacc[db][0] = Cacc[db][0] * decay; Cacc[db][1] = Cacc[db][1] * decay;
#pragma unroll
                    for (int ks = 0; ks < 2; ++ks) {
                        const bf16x8 kf = __builtin_shufflevector(t8[4 * dd + 2 * ks], t8[4 * dd + 2 * ks + 1], 0, 1, 2, 3, 4, 5, 6, 7);
                        Cacc[db][0] = MFMA16(kf, vw[0][ks], Cacc[db][0]); Cacc[db][1] = MFMA16(kf, vw[1][ks], Cacc[db][1]);
                    } }
            }
        }
        __builtin_amdgcn_sched_barrier(0);
        float vpre = 0.f;
        if (c + 1 < 64) { SC_LOAD(c + 1); if (tid < 320) vpre = vptr[(c + 1) * cstr]; }
        __builtin_amdgcn_sched_barrier(0);
        if (is_ml) {
            const int d = tid >> 2, part = tid & 3; float s = 0.f;
#pragma unroll
            for (int j = 0; j < 16; ++j) { const int sidx = 16 * part + j; s += cW[sidx] * bf2f(*(const LAS bf16_t*)(Ks + sidx * SQ_P + d * 2)); }
            s += __shfl_xor(s, 1); s += __shfl_xor(s, 2);
            if (part == 0) { LAS float* np = (LAS float*)(lds + SC_NV) + d; *np = decay * (*np) + s; }
        }
        if (c + 1 < 64) { SC_STORE(cur ^ 1); if (tid < 320) ((LAS float*)(lds + SC_VEC + (cur ^ 1) * 1280))[tid] = vpre; }
        LBAR();
    }
#undef SC_LOAD
#undef SC_STORE
}


DI void p3b_gate(const Params& P) {
    const int tid = opaque_tid(), lane = tid & 63, sub = lane >> 4, li = lane & 15, G = gridDim.x, bx = blockIdx.x;
    unsigned char* ws = P.ws;
    const int nw = T * 6 * 2 / 4;
    for (int wv = bx * 8 + (tid >> 6); wv < nw; wv += G * 8) {
        int pair = wv * 4 + sub; const int br = pair >= T * 6; pair -= br * T * 6; const int t = pair / 6, h = pair - t * 6;
        const size_t off = (size_t)t * 1536 + h * 256 + li * 16;
        const bf16_t* hp = (const bf16_t*)(ws + (br ? WS_V2 : WS_V1)) + off; bf16_t* zp = (bf16_t*)(ws + (br ? WS_Z2 : WS_Z1)) + off; const bf16_t* op = (const bf16_t*)(ws + WS_O1) + off;
        const float* gp = (br ? P.ret_g : P.ml_g) + h * 256 + li * 16;
        const u32x4 h0 = *(const u32x4*)hp, h1 = *(const u32x4*)(hp + 8), z0 = *(const u32x4*)zp, z1 = *(const u32x4*)(zp + 8);
        u32x4 o0 = (u32x4){0u, 0u, 0u, 0u}, o1 = o0; if (!br) { o0 = *(const u32x4*)op; o1 = *(const u32x4*)(op + 8); }
        const unsigned hh[8] = {h0.x, h0.y, h0.z, h0.w, h1.x, h1.y, h1.z, h1.w}, zz[8] = {z0.x, z0.y, z0.z, z0.w, z1.x, z1.y, z1.z, z1.w}, oo[8] = {o0.x, o0.y, o0.z, o0.w, o1.x, o1.y, o1.z, o1.w};
        float hv[16], s1 = 0.f, s2 = 0.f;
#pragma unroll
        for (int e = 0; e < 16; ++e) { hv[e] = (e & 1) ? bfhi(hh[e >> 1]) : bflo(hh[e >> 1]); s1 += hv[e]; s2 += hv[e] * hv[e]; }
#pragma unroll
        for (int o = 1; o < 16; o <<= 1) { s1 += __shfl_xor(s1, o); s2 += __shfl_xor(s2, o); }
        const float mean = s1 * (1.0f / 256.0f), var = fmaxf(s2 * (1.0f / 256.0f) - mean * mean, 0.f), rstd = rsqrtf(var + EPS);
        float y[16];
#pragma unroll
        for (int q = 0; q < 4; ++q) { const f32x4 gg = *(const f32x4*)(gp + 4 * q);
#pragma unroll
            for (int j = 0; j < 4; ++j) { const int e = 4 * q + j; const float z = (e & 1) ? bfhi(zz[e >> 1]) : bflo(zz[e >> 1]); float v = (hv[e] - mean) * rstd * gg[j] * siluf_(z);
                if (!br) { const float o = (e & 1) ? bfhi(oo[e >> 1]) : bflo(oo[e >> 1]); v *= sigmoidf_(o); } y[e] = v; } }
        u32x4 a, c2; a.x = cvt_pk_bf16(y[0], y[1]); a.y = cvt_pk_bf16(y[2], y[3]); a.z = cvt_pk_bf16(y[4], y[5]); a.w = cvt_pk_bf16(y[6], y[7]);
        c2.x = cvt_pk_bf16(y[8], y[9]); c2.y = cvt_pk_bf16(y[10], y[11]); c2.z = cvt_pk_bf16(y[12], y[13]); c2.w = cvt_pk_bf16(y[14], y[15]);
        *(u32x4*)zp = a; *(u32x4*)(zp + 8) = c2;
    }
}

constexpr int AK_P = 528;
constexpr int AV_P = 544;
static_assert(256 * AV_P <= LDS_BYTES - 16, "attn LDS");
DI void attn_unit(const Params& P, LAS unsigned char* lds, int unit) {
    const int tid = opaque_tid(), lane = tid & 63, w = __builtin_amdgcn_readfirstlane(tid >> 6), r = lane & 15, g = lane >> 4, q4 = r >> 2, p4 = r & 3;
    unsigned char* ws = P.ws;
    const int b = unit >> 6, hh = (unit >> 4) & 3, qb = unit & 15;
    const size_t trow = (size_t)b * SEQ + qb * 256 + 32 * w + r;
    const bf16_t* Qp = (const bf16_t*)(ws + WS_Q3) + trow * 1024 + hh * 256;
    bf16_t* Zp = (bf16_t*)(ws + WS_Z3) + trow * 1024 + hh * 256;
    const bf16_t* Kp = (const bf16_t*)(ws + WS_MKV) + (size_t)b * 256 * 2048 + hh * 256;
    const bf16_t* Vp = Kp + 1024;
    const unsigned ldsb = (unsigned)(size_t)lds;
#pragma unroll
    for (int i = 0; i < 16; ++i) { const int pp = tid + 512 * i, row = pp >> 5, ch = pp & 31; *(LAS u32x4*)(lds + row * AK_P + ch * 16) = *(const u32x4*)(Kp + (size_t)row * 2048 + ch * 8); }
    __syncthreads();
    bf16x8 pf[2][8]; float rs[2];
#pragma unroll
    for (int mb = 0; mb < 2; ++mb) {
        bf16x8 qf[8];
#pragma unroll
        for (int ks = 0; ks < 8; ++ks) qf[ks] = *(const bf16x8*)(Qp + (size_t)mb * 16 * 1024 + 32 * ks + 8 * g);
        f32x4 s[16];
#pragma unroll
        for (int nb = 0; nb < 16; ++nb) { s[nb] = (f32x4){0.f, 0.f, 0.f, 0.f};
#pragma unroll
            for (int ks = 0; ks < 8; ++ks) { const bf16x8 kf = *(const LAS bf16x8*)(lds + (16 * nb + r) * AK_P + (32 * ks + 8 * g) * 2); s[nb] = MFMA16(kf, qf[ks], s[nb]); } __builtin_amdgcn_sched_barrier(0); }
        float mx = -3.0e38f;
#pragma unroll
        for (int nb = 0; nb < 16; ++nb) mx = fmaxf(mx, fmaxf(fmaxf(s[nb][0], s[nb][1]), fmaxf(s[nb][2], s[nb][3])));
        mx = fmaxf(mx, __shfl_xor(mx, 16)); mx = fmaxf(mx, __shfl_xor(mx, 32));
        const float sc = 0.0625f * 1.4426950408889634f; float sum = 0.f;
#pragma unroll
        for (int nb = 0; nb < 16; ++nb)
#pragma unroll
            for (int j = 0; j < 4; ++j) { const float e = __builtin_amdgcn_exp2f((s[nb][j] - mx) * sc); s[nb][j] = e; sum += e; }
        sum += __shfl_xor(sum, 16); sum += __shfl_xor(sum, 32);
        rs[mb] = 1.0f / sum;
#pragma unroll
        for (int kk = 0; kk < 8; ++kk) { u32x4 t; t.x = cvt_pk_bf16(s[2 * kk][0], s[2 * kk][1]); t.y = cvt_pk_bf16(s[2 * kk][2], s[2 * kk][3]); t.z = cvt_pk_bf16(s[2 * kk + 1][0], s[2 * kk + 1][1]); t.w = cvt_pk_bf16(s[2 * kk + 1][2], s[2 * kk + 1][3]); pf[mb][kk] = __builtin_bit_cast(bf16x8, t); }
        __builtin_amdgcn_sched_barrier(0);
    }
    __syncthreads();
#pragma unroll
    for (int i = 0; i < 16; ++i) { const int pp = tid + 512 * i, row = pp >> 5, ch = pp & 31; *(LAS u32x4*)(lds + row * AV_P + ch * 16) = *(const u32x4*)(Vp + (size_t)row * 2048 + ch * 8); }
    __syncthreads();
#pragma unroll
    for (int VG = 0; VG < 4; ++VG) {
        unsigned vb = ldsb + (4 * g + q4) * AV_P + (4 * p4) * 2; asm volatile("" : "+v"(vb));
        bf16_t* zp = Zp + 64 * VG + 4 * g;
        u32x2 zl[2][4];
#pragma unroll
        for (int mb = 0; mb < 2; ++mb)
#pragma unroll
            for (int vq = 0; vq < 4; ++vq) zl[mb][vq] = *(const u32x2*)(zp + (size_t)mb * 16 * 1024 + 16 * vq);
        f32x4 o[2][4];
#pragma unroll
        for (int vq = 0; vq < 4; ++vq) { o[0][vq] = (f32x4){0.f, 0.f, 0.f, 0.f}; o[1][vq] = (f32x4){0.f, 0.f, 0.f, 0.f};
#pragma unroll
            for (int kh = 0; kh < 2; ++kh) {
                s16x4 t8[8]; const unsigned a0 = vb + (128 * kh) * AV_P + (64 * VG + 16 * vq) * 2;
                tr_read8(t8, a0, a0 + 16 * AV_P, a0 + 32 * AV_P, a0 + 48 * AV_P, a0 + 64 * AV_P, a0 + 80 * AV_P, a0 + 96 * AV_P, a0 + 112 * AV_P);
#pragma unroll
                for (int k2 = 0; k2 < 4; ++k2) { const bf16x8 vfr = __builtin_shufflevector(t8[2 * k2], t8[2 * k2 + 1], 0, 1, 2, 3, 4, 5, 6, 7);
                    o[0][vq] = MFMA16(vfr, pf[0][4 * kh + k2], o[0][vq]); o[1][vq] = MFMA16(vfr, pf[1][4 * kh + k2], o[1][vq]); }
            } }
#pragma unroll
        for (int mb = 0; mb < 2; ++mb)
#pragma unroll
            for (int vq = 0; vq < 4; ++vq) {
                const u32x2 zz = zl[mb][vq]; const f32x4 ov = o[mb][vq];
                const float y0 = ov[0] * rs[mb] * siluf_(bflo(zz.x)), y1 = ov[1] * rs[mb] * siluf_(bfhi(zz.x)), y2 = ov[2] * rs[mb] * siluf_(bflo(zz.y)), y3 = ov[3] * rs[mb] * siluf_(bfhi(zz.y));
                unsigned st = 0u; st = __builtin_amdgcn_cvt_pk_fp8_f32(y0 * 16.f, y1 * 16.f, st, false); st = __builtin_amdgcn_cvt_pk_fp8_f32(y2 * 16.f, y3 * 16.f, st, true);
                *(unsigned*)((unsigned char*)P.out + DO_XA8 + (trow + 16 * mb) * 1024 + hh * 256 + 64 * VG + 4 * g + 16 * vq) = st;
            }
    }
    __syncthreads();
}

#define XB_TMO      128
#define XB_XCNT(j)  (256  + 64 * (j))
#define XB_XSUB(j)  (1280 + 64 * (j))
#define XB_XGEN(j)  (2304 + 64 * (j))
#define XB_TOP      3328
#define XB_TOPGEN   3392
#define XCD_BAR_WORDS 3456
#define XB_SPIN_CAP (1u << 18)
DI unsigned xb_ld(unsigned* p)              { return __hip_atomic_load(p, __ATOMIC_RELAXED, __HIP_MEMORY_SCOPE_AGENT); }
DI unsigned xb_add(unsigned* p, unsigned v) { return __hip_atomic_fetch_add(p, v, __ATOMIC_RELAXED, __HIP_MEMORY_SCOPE_AGENT); }
DI unsigned xb_xcc_id() { return (unsigned)__builtin_amdgcn_s_getreg((3 << 11) | 20) & 0xFu; }
#define XB_SPIN(cond, bar) do { unsigned _sp = 0; while (cond) { __builtin_amdgcn_s_sleep(1); \
    if ((++_sp & 255u) == 0u) { if (xb_ld(&(bar)[XB_TMO])) break; if (_sp > XB_SPIN_CAP) { atomicAdd(&(bar)[XB_TMO], 1u); break; } } } } while (0)
struct XcdBarrier { unsigned* bar; unsigned x; volatile LAS unsigned* st; };
DI XcdBarrier xcd_barrier_post(unsigned* bar, volatile LAS unsigned* st) {
    XcdBarrier b; b.bar = bar; b.x = xb_xcc_id(); b.st = st;
    if (threadIdx.x == 0) (void)xb_add(&bar[XB_XCNT(b.x)], 1u);
    return b;
}
DI void xcd_barrier_complete(unsigned* bar, unsigned x, unsigned& nloc, unsigned& nx) {
    const unsigned G = gridDim.x * gridDim.y * gridDim.z;
    unsigned sum, cnt, mine, sp = 0u;
    for (;;) {
        sum = 0u; cnt = 0u; mine = 0u;
#pragma unroll
        for (unsigned j = 0; j < 16; ++j) { const unsigned c = xb_ld(&bar[XB_XCNT(j)]); sum += c; cnt += (c > 0u) ? 1u : 0u; mine = (j == x) ? c : mine; }
        if (sum == G) break;
        __builtin_amdgcn_s_sleep(1);
        if ((++sp & 255u) == 0u) { if (xb_ld(&bar[XB_TMO])) break; if (sp > XB_SPIN_CAP) { atomicAdd(&bar[XB_TMO], 1u); break; } }
    }
    nloc = mine > 0u ? mine : 1u; nx = cnt > 0u ? cnt : 1u;
}
DI void xcd_barrier(const XcdBarrier& b) {
    asm volatile("s_waitcnt vmcnt(0)" ::: "memory");
    __syncthreads();
    if (threadIdx.x == 0) {
        unsigned* bar = b.bar;
        __builtin_amdgcn_s_waitcnt(0);
        unsigned nloc = b.st[0], nx = b.st[1];
        if (nloc == 0u) { xcd_barrier_complete(bar, b.x, nloc, nx); b.st[0] = nloc; b.st[1] = nx; }
        const unsigned old = xb_add(&bar[XB_XSUB(b.x)], 1u);
        const unsigned gen = old / nloc;
        if (old + 1u == (gen + 1u) * nloc) {
            __builtin_amdgcn_fence(__ATOMIC_RELEASE, "agent");
            asm volatile("s_waitcnt vmcnt(0)" ::: "memory");
            const unsigned og = xb_add(&bar[XB_TOP], 1u);
            const unsigned tg = og / nx;
            if (og + 1u == (tg + 1u) * nx) xb_add(&bar[XB_TOPGEN], 1u);
            else XB_SPIN(xb_ld(&bar[XB_TOPGEN]) == tg, bar);
            __builtin_amdgcn_fence(__ATOMIC_ACQUIRE, "agent");
            xb_add(&bar[XB_XGEN(b.x)], 1u);
            asm volatile("s_waitcnt vmcnt(0)" ::: "memory");
        } else {
            XB_SPIN(xb_ld(&bar[XB_XGEN(b.x)]) == gen, bar);
            __builtin_amdgcn_fence(__ATOMIC_ACQUIRE, "agent");
            asm volatile("s_waitcnt vmcnt(0)" ::: "memory");
        }
    }
    __syncthreads();
}

__global__ void __launch_bounds__(512) fwd_megakernel(Params P) {
    extern __shared__ __attribute__((aligned(16))) unsigned char smem[];
    LAS unsigned char* lds = (LAS unsigned char*)smem;
    cg::grid_group grid = cg::this_grid();
    unsigned char* ws = P.ws;
    const int G = gridDim.x, bx = blockIdx.x, tid = threadIdx.x;
    bf16_t* H = (bf16_t*)((unsigned char*)P.out + DO_H);

    if (tid < 4) ((LAS unsigned*)(lds + LDS_BYTES - 32))[tid] = 0u;
    __syncthreads();
#ifndef NO_P0
    p0_prologue(P, lds);
#endif
    grid.sync();
    const XcdBarrier xb = xcd_barrier_post((unsigned*)(ws + WS_BAR), (volatile LAS unsigned*)(lds + LDS_BYTES - 32));
    {
        { pg8::Gemm g{H, (const bf16_t*)(ws + WS_WIN), 2048}; pg8::Order S; S.init(128, NT_P1 - 38, G, bx, 0, 64, 128, PN_KV); S.skip0_lo = 0; S.skip0_n = 12; S.skip_lo = 24; S.skip_n = 26;
          pg8::EpiProj E{ws, (const float*)(ws + WS_BIAS), 1 << 20, 0, 0.f};
          pg8::gemm_phase(lds, g, S, E); }
        { pg8::Gemm g{(const bf16_t*)(ws + WS_H8), (const bf16_t*)((unsigned char*)P.out + DO_WO8 - (size_t)24 * 256 * 2048), 1024}; pg8::Order S; S.init(128, 20, G, bx, 24);
          pg8::EpiProj E{ws, (const float*)(ws + WS_BIAS), 40, 6, Q8_DEQ};
          pg8::gemm_phase<2>(lds, g, S, E); }
        { pg8::Gemm g{(const bf16_t*)(ws + WS_H8), (const bf16_t*)((unsigned char*)P.out + DO_QKC), 1024}; pg8::Order S; S.init(128, 6, G, bx, 0);
          pg8::EpiProj E{ws, (const float*)(ws + WS_BIAS), 1 << 20, 0, Q8_DEQ};
          pg8::gemm_phase<2>(lds, g, S, E); }
        { pg8::Gemm g{(const bf16_t*)(ws + WS_H8), (const bf16_t*)(ws + WS_WV8 - (size_t)6 * 256 * 2048), 1024}; pg8::Order S; S.init(128, 6, G, bx, 6);
          pg8::EpiProj E{ws, (const float*)(ws + WS_BIAS), 1 << 20, 0, Q8_DEQ};
          pg8::gemm_phase<2>(lds, g, S, E); }
        { pg8::Gemm g{(const bf16_t*)(ws + WS_H8), (const bf16_t*)(ws + WS_WZ8 - (size_t)40 * 256 * 2048), 1024}; pg8::Order S; S.init(128, 6, G, bx, 40);
          pg8::EpiProj E{ws, (const float*)(ws + WS_BIAS), 1 << 20, 0, Q8_DEQ};
          pg8::gemm_phase<2>(lds, g, S, E); }
    }
    xcd_barrier(xb);
#ifndef NO_P2
    p2_prep(P, lds);
#endif
    xcd_barrier(xb);
    {
#ifndef NO_SCAN
        for (int it = bx; it < 96; it += G) scan_item(P, lds, it);
#endif
        if (bx >= 96 && G > 96) {
            pg8::Gemm g{(const bf16_t*)(ws + WS_H8), (const bf16_t*)((unsigned char*)P.out + DO_WG8), 1024}; pg8::Order S; S.init(128, 8, G - 96, bx - 96, 0);
            pg8::EpiGate E{ws, (const float*)(ws + WS_BIAS), Q8_DEQ};
            pg8::gemm_phase<2>(lds, g, S, E);
        }
        LAS unsigned* slot = (LAS unsigned*)(lds + LDS_BYTES - 16);
        for (;;) {
            if (tid == 0) *slot = atomicAdd((unsigned*)(ws + WS_CTL), 1u);
            __syncthreads();
            const unsigned u = *slot;
            __syncthreads();
            if (u >= 512u) break;
#ifndef NO_ATTN
            attn_unit(P, lds, (int)u);
#endif
        }
    }
    xcd_barrier(xb);
#ifndef NO_P2
    p3b_gate(P);
#endif
    xcd_barrier(xb);
    {
        pg8::Gemm g{(const bf16_t*)(ws + WS_H8), (const bf16_t*)((unsigned char*)P.out + DO_WG8), 1024}; pg8::Order S; S.init(128, 16, G, bx, 8);
        pg8::EpiGate E{ws, (const float*)(ws + WS_BIAS), Q8_DEQ};
        pg8::gemm_phase<2>(lds, g, S, E);
    }
    xcd_barrier(xb);
    {
        pg8::Order S; S.init(128, 8, G, bx, 0);
        { pg8::Gemm g{(const bf16_t*)(ws + WS_Z1), (const bf16_t*)(ws + WS_WML), 1536}; pg8::EpiMerge E{(bf16_t*)(ws + WS_MERGED), (const bf16_t*)(ws + WS_G0), 0}; pg8::gemm_phase(lds, g, S, E); }
        { pg8::Gemm g{(const bf16_t*)(ws + WS_Z2), (const bf16_t*)(ws + WS_WRET), 1536}; pg8::EpiMerge E{(bf16_t*)(ws + WS_MERGED), (const bf16_t*)(ws + WS_G12), 1}; pg8::gemm_phase(lds, g, S, E); }
        { pg8::Gemm g{(const bf16_t*)((unsigned char*)P.out + DO_XA8), (const bf16_t*)((unsigned char*)P.out + DO_WX8), 512, 0, 0x7B7B7B7B}; pg8::EpiMerge E{(bf16_t*)(ws + WS_MERGED), (const bf16_t*)(ws + WS_G12 + SZ20), 2}; pg8::gemm_phase<1>(lds, g, S, E); }
    }
    xcd_barrier(xb);
    {
        pg8::Gemm g{(const bf16_t*)(ws + WS_MERGED), (const bf16_t*)(ws + WS_WOUT), 2048}; pg8::Order S; S.init(128, 8, G, bx, 0);
        pg8::EpiOut E{(bf16_t*)(ws + WS_G0)};
        pg8::gemm_phase(lds, g, S, E);
    }
    xcd_barrier(xb);
    {
        const bf16_t* D = (const bf16_t*)(ws + WS_G0); const int lane = tid & 63, wave = tid >> 6;
        f32x4 gg[8];
#pragma unroll
        for (int i = 0; i < 8; ++i) gg[i] = *(const f32x4*)(P.fin_g + 4 * (lane + 64 * i));
        for (int row = bx * 16 + wave * 2; row < T; row += G * 16) {
            const float* x0 = P.x + (size_t)row * 2048; const float* x1 = x0 + 2048; const bf16_t* d0 = D + (size_t)row * 2048; const bf16_t* d1 = d0 + 2048;
            float* o0 = P.out + (size_t)row * 2048; float* o1 = o0 + 2048;
            f32x4 a[8], b[8]; u32x2 da[8], db[8];
#pragma unroll
            for (int i = 0; i < 8; ++i) { a[i] = *(const f32x4*)(x0 + 4 * (lane + 64 * i)); b[i] = *(const f32x4*)(x1 + 4 * (lane + 64 * i)); da[i] = *(const u32x2*)(d0 + 4 * (lane + 64 * i)); db[i] = *(const u32x2*)(d1 + 4 * (lane + 64 * i)); }
            float s0 = 0.f, s1 = 0.f;
#pragma unroll
            for (int i = 0; i < 8; ++i) {
                a[i] += (f32x4){bflo(da[i].x), bfhi(da[i].x), bflo(da[i].y), bfhi(da[i].y)}; b[i] += (f32x4){bflo(db[i].x), bfhi(db[i].x), bflo(db[i].y), bfhi(db[i].y)};
                s0 += a[i][0] * a[i][0] + a[i][1] * a[i][1] + a[i][2] * a[i][2] + a[i][3] * a[i][3]; s1 += b[i][0] * b[i][0] + b[i][1] * b[i][1] + b[i][2] * b[i][2] + b[i][3] * b[i][3]; }
            s0 = wave_sum(s0); s1 = wave_sum(s1);
            const float c0 = rsqrtf(s0 * (1.0f / 2048.0f) + EPS), c1 = rsqrtf(s1 * (1.0f / 2048.0f) + EPS);
#pragma unroll
            for (int i = 0; i < 8; ++i) { *(f32x4*)(o0 + 4 * (lane + 64 * i)) = a[i] * c0 * gg[i]; *(f32x4*)(o1 + 4 * (lane + 64 * i)) = b[i] * c1 * gg[i]; }
        }
    }
}

extern "C" void kernel_launch(void* const* d_in, const int* in_sizes, int n_in, void* d_out, int out_size, void* d_ws, size_t ws_size, hipStream_t stream) {
    static int grid = 0;
    if (grid == 0) {
        if (n_in != 17 || out_size != T * DM || ws_size < WS_END) { fprintf(stderr, "kernel_launch: unexpected shapes / workspace (%d inputs, out %d, ws %zu, need %zu)\n", n_in, out_size, ws_size, (size_t)WS_END); grid = -1; return; }
        int dev = 0, cus = 0, per_cu = 0;
        hipGetDevice(&dev); hipDeviceGetAttribute(&cus, hipDeviceAttributeMultiprocessorCount, dev);
        if (hipFuncSetAttribute((const void*)fwd_megakernel, hipFuncAttributeMaxDynamicSharedMemorySize, LDS_BYTES) != hipSuccess) { fprintf(stderr, "kernel_launch: hipFuncSetAttribute failed\n"); grid = -1; return; }
        if (hipOccupancyMaxActiveBlocksPerMultiprocessor(&per_cu, (const void*)fwd_megakernel, 512, LDS_BYTES) != hipSuccess || per_cu < 1) { fprintf(stderr, "kernel_launch: occupancy query gave %d\n", per_cu); per_cu = 1; }
        (void)hipGetLastError();
        grid = cus * 1;
    }
    if (grid < 0) return;
    Params p{};
    p.x = (const float*)d_in[0]; p.mem = (const float*)d_in[1]; p.pos = (const int*)d_in[2]; p.ln_g = (const float*)d_in[3]; p.mem_ln_g = (const float*)d_in[4];
    p.w_in = (const float*)d_in[5]; p.b_in = (const float*)d_in[6]; p.conv_w = (const float*)d_in[7]; p.conv_b = (const float*)d_in[8]; p.ml_g = (const float*)d_in[9];
    p.ret_g = (const float*)d_in[10]; p.w_kv = (const float*)d_in[11]; p.w_ml = (const float*)d_in[12]; p.w_ret = (const float*)d_in[13]; p.w_xa = (const float*)d_in[14];
    p.w_out = (const float*)d_in[15]; p.fin_g = (const float*)d_in[16]; p.out = (float*)d_out; p.ws = (unsigned char*)d_ws;
    void* args[] = {&p};
    hipError_t e = hipLaunchCooperativeKernel((const void*)fwd_megakernel, dim3(grid), dim3(512), args, LDS_BYTES, stream);
    if (e != hipSuccess) fprintf(stderr, "cooperative launch failed: %s (grid %d)\n", hipGetErrorString(e), grid);
}
```
